# Optimizing an MI355X kernel written in HIP

```python
import jax, jax.numpy as jnp
from jax import lax
import numpy as np

D_MODEL = 1024
BATCH = 8
SEQ = 4096
DEPTH = 1

CHUNK = 64
Q_BLOCK = 128
POOL_WINDOWS = (2, 4, 8, 16)
POOL_GROUPS = len(POOL_WINDOWS)
POOL_WIDTH = D_MODEL
POOL_GROUP_W = POOL_WIDTH // POOL_GROUPS
MLA_HEADS = 8
QK_NOPE = 128
QK_ROPE = 64
V_HEAD = 128
Q_LORA = 3 * D_MODEL // 4
KV_LORA = D_MODEL // 4
ROPE_THETA = 10000.0
N_BRANCHES = 2
IN_WIDTH = POOL_WIDTH + Q_LORA + KV_LORA + QK_ROPE + N_BRANCHES * D_MODEL
N_EXPERTS = 32
TOP_K = 4
D_EXPERT = D_MODEL
SWIGLU_LIMIT = 7.0
SWIGLU_ALPHA = 1.702
EXPERT_BLOCK = 128
N_MOD = 6
NORM_EPS = 1e-6
NEG_INF = -1e30

kernel_name = 'hybrid_pool_mla_moe_adaln_block'


def rms_norm(x, g):
    xf = x.astype(jnp.float32)
    y = xf * lax.rsqrt(jnp.mean(xf * xf, axis=-1, keepdims=True) + NORM_EPS)
    return (y * g.astype(jnp.float32)).astype(x.dtype)


def modulate(h, shift, scale):
    return h * (1 + scale[:, None, :]) + shift[:, None, :]


def pool_mixer(u, w_grp, scale, w_proj):
    B, S, _ = u.shape
    uf = u.astype(jnp.float32).reshape(B, S, POOL_GROUPS, POOL_GROUP_W)
    csum = jnp.concatenate([jnp.zeros_like(uf[:, :1]), jnp.cumsum(uf, axis=1)], axis=1)
    t = np.arange(S)
    pooled = []
    for g, w in enumerate(POOL_WINDOWS):
        lo = np.maximum(t + 1 - w, 0)
        cnt = np.minimum(t + 1, w).astype(np.float32)
        win = csum[:, 1:, g] - csum[:, lo, g]
        pooled.append(win / cnt[None, :, None])
    pooled = jnp.stack(pooled, axis=2)
    mixed = (pooled - uf).astype(u.dtype)
    y = jnp.einsum('bsgc,gcd->bsgd', mixed, w_grp).reshape(B, S, POOL_WIDTH) * scale
    return y @ w_proj


def rotate(x, cos, sin):
    x1, x2 = jnp.split(x, 2, axis=-1)
    return jnp.concatenate([x1 * cos - x2 * sin, x2 * cos + x1 * sin], axis=-1)


def mla_mixer(q_lat, kv_lat, k_pe_raw, positions, g_q_a, w_q_b, g_kv_a, w_kv_b, w_o):
    B, S, _ = q_lat.shape
    dt = q_lat.dtype
    q = (rms_norm(q_lat, g_q_a) @ w_q_b).reshape(B, S, MLA_HEADS, QK_NOPE + QK_ROPE)
    q_nope, q_pe = q[..., :QK_NOPE], q[..., QK_NOPE:]
    kv = (rms_norm(kv_lat, g_kv_a) @ w_kv_b).reshape(B, S, MLA_HEADS, QK_NOPE + V_HEAD)
    k_nope, v = kv[..., :QK_NOPE], kv[..., QK_NOPE:]
    inv_freq = 1.0 / (ROPE_THETA ** (jnp.arange(0, QK_ROPE, 2, dtype=jnp.float32) / QK_ROPE))
    ang = positions.astype(jnp.float32)[..., None] * inv_freq
    cos, sin = jnp.cos(ang), jnp.sin(ang)
    q_pe = rotate(q_pe.astype(jnp.float32), cos[:, :, None], sin[:, :, None]).astype(dt)
    k_pe = rotate(k_pe_raw.astype(jnp.float32), cos, sin).astype(dt)
    sm_scale = (QK_NOPE + QK_ROPE) ** -0.5
    chunk_id = np.arange(S) // CHUNK
    outs = []
    for qb in range(S // Q_BLOCK):
        q0, q1 = qb * Q_BLOCK, (qb + 1) * Q_BLOCK
        s = (jnp.einsum('bqhd,bkhd->bhqk', q_nope[:, q0:q1], k_nope[:, :q1])
             + jnp.einsum('bqhr,bkr->bhqk', q_pe[:, q0:q1], k_pe[:, :q1])).astype(jnp.float32) * sm_scale
        mask = chunk_id[q0:q1, None] >= chunk_id[None, :q1]
        s = jnp.where(mask, s, NEG_INF)
        p = jax.nn.softmax(s, axis=-1).astype(dt)
        outs.append(jnp.einsum('bhqk,bkhd->bqhd', p, v[:, :q1]))
    o = jnp.concatenate(outs, axis=1).reshape(B, S, MLA_HEADS * V_HEAD)
    return o @ w_o


def clamped_swiglu(gu):
    gate, up = gu[..., 0::2], gu[..., 1::2]
    gate = jnp.minimum(gate, SWIGLU_LIMIT)
    up = jnp.clip(up, -SWIGLU_LIMIT, SWIGLU_LIMIT)
    return (up + 1) * (gate * jax.nn.sigmoid(SWIGLU_ALPHA * gate))


def moe_ffn(h, w_router, b_router, w_gu, b_gu, w_down, b_down):
    B, S, D = h.shape
    T = B * S
    ht = h.reshape(T, D)
    logits = (ht @ w_router + b_router).astype(jnp.float32)
    top_val, top_idx = lax.top_k(logits, TOP_K)
    weights = jax.nn.softmax(top_val, axis=-1)
    flat_e = top_idx.reshape(-1)
    n_slots = T * TOP_K
    order = jnp.argsort(flat_e, stable=True)
    sorted_e = flat_e[order]
    counts = jnp.bincount(flat_e, length=N_EXPERTS)
    padded = (counts + EXPERT_BLOCK - 1) // EXPERT_BLOCK * EXPERT_BLOCK
    pad_end = jnp.cumsum(padded)
    pad_start = pad_end - padded
    grp_start = jnp.cumsum(counts) - counts
    dest = pad_start[sorted_e] + jnp.arange(n_slots, dtype=jnp.int32) - grp_start[sorted_e]
    n_rows = n_slots + N_EXPERTS * EXPERT_BLOCK
    n_blocks = n_rows // EXPERT_BLOCK
    row_tok = jnp.zeros((n_rows,), jnp.int32).at[dest].set((order // TOP_K).astype(jnp.int32))
    xs = ht[row_tok].reshape(n_blocks, EXPERT_BLOCK, D)
    blk_start = jnp.arange(n_blocks, dtype=jnp.int32) * EXPERT_BLOCK
    blk_e = jnp.minimum(jnp.searchsorted(pad_end, blk_start, side='right'), N_EXPERTS - 1)

    def expert_block(args):
        xb, e = args
        gu = xb @ w_gu[e] + b_gu[e]
        return clamped_swiglu(gu) @ w_down[e] + b_down[e]

    ys = lax.map(expert_block, (xs, blk_e)).reshape(n_rows, D)
    slot_row = jnp.zeros((n_slots,), jnp.int32).at[order].set(dest.astype(jnp.int32))
    y_slots = ys[slot_row].reshape(T, TOP_K, D)
    out = jnp.einsum('tk,tkd->td', weights.astype(ys.dtype), y_slots)
    return out.reshape(B, S, D)


def setup_inputs(seed: int = 0) -> dict:
    key = jax.random.key(seed)
    ks = jax.random.split(key, 32)
    f32 = jnp.float32
    L, D = DEPTH, D_MODEL

    def nrm(k, shape, fan_in, mult=1.0):
        return jax.random.normal(k, shape, f32) * (mult * fan_in ** -0.5)

    def gain(k, shape):
        return 1.0 + 0.1 * jax.random.normal(k, shape, f32)

    def bias(k, shape, s=0.01):
        return s * jax.random.normal(k, shape, f32)

    x = jax.random.normal(ks[0], (BATCH, SEQ, D), f32)
    c = jax.random.normal(ks[1], (BATCH, D), f32)
    offsets = jax.random.randint(ks[2], (BATCH, 1), 0, 8192, dtype=jnp.int32)
    positions = offsets + jnp.arange(SEQ, dtype=jnp.int32)[None, :]
    return {
        'x': x,
        'c': c,
        'positions': positions,
        'w_mod': nrm(ks[3], (L, D, N_MOD * D), D, 0.5),
        'b_mod': bias(ks[4], (L, N_MOD * D), 0.05),
        'g_mix': gain(ks[5], (L, D)),
        'w_in': nrm(ks[6], (L, D, IN_WIDTH), D),
        'b_gate': bias(ks[7], (L, N_BRANCHES * D), 0.1),
        'w_pool_grp': nrm(ks[8], (L, POOL_GROUPS, POOL_GROUP_W, POOL_GROUP_W), POOL_GROUP_W),
        'pool_scale': gain(ks[9], (L, POOL_WIDTH)),
        'w_pool_out': nrm(ks[10], (L, POOL_WIDTH, D), POOL_WIDTH),
        'g_q_a': gain(ks[11], (L, Q_LORA)),
        'w_q_b': nrm(ks[12], (L, Q_LORA, MLA_HEADS * (QK_NOPE + QK_ROPE)), Q_LORA),
        'g_kv_a': gain(ks[13], (L, KV_LORA)),
        'w_kv_b': nrm(ks[14], (L, KV_LORA, MLA_HEADS * (QK_NOPE + V_HEAD)), KV_LORA),
        'w_mla_out': nrm(ks[15], (L, MLA_HEADS * V_HEAD, D), MLA_HEADS * V_HEAD),
        'w_out': nrm(ks[16], (L, D, D), D),
        'g_ffn': gain(ks[17], (L, D)),
        'w_router': nrm(ks[18], (L, D, N_EXPERTS), D),
        'b_router': bias(ks[19], (L, N_EXPERTS)),
        'w_gu': nrm(ks[20], (L, N_EXPERTS, D, 2 * D_EXPERT), D),
        'b_gu': bias(ks[21], (L, N_EXPERTS, 2 * D_EXPERT)),
        'w_down': nrm(ks[22], (L, N_EXPERTS, D_EXPERT, D), D_EXPERT),
        'b_down': bias(ks[23], (L, N_EXPERTS, D)),
        'g_final': gain(ks[24], (D,)),
        'w_fmod': nrm(ks[25], (D, 2 * D), D, 0.5),
        'b_fmod': bias(ks[26], (2 * D,), 0.05),
    }


def reference(x, c, positions, w_mod, b_mod, g_mix, w_in, b_gate, w_pool_grp, pool_scale,
              w_pool_out, g_q_a, w_q_b, g_kv_a, w_kv_b, w_mla_out, w_out, g_ffn,
              w_router, b_router, w_gu, b_gu, w_down, b_down, g_final, w_fmod, b_fmod):
    B, S, D = x.shape
    c_act = jax.nn.silu(c)
    splits = np.cumsum([POOL_WIDTH, Q_LORA, KV_LORA, QK_ROPE]).tolist()
    for l in range(DEPTH):
        mod = (c_act @ w_mod[l] + b_mod[l]).reshape(B, N_MOD, D)
        shift1, scale1, gate1 = mod[:, 0], mod[:, 1], mod[:, 2]
        shift2, scale2, gate2 = mod[:, 3], mod[:, 4], mod[:, 5]

        h = modulate(rms_norm(x, g_mix[l]), shift1, scale1)
        z = h @ w_in[l]
        u, q_lat, kv_lat, k_pe, gate_logits = jnp.split(z, splits, axis=-1)
        a = pool_mixer(u, w_pool_grp[l], pool_scale[l], w_pool_out[l])
        m = mla_mixer(q_lat, kv_lat, k_pe, positions, g_q_a[l], w_q_b[l], g_kv_a[l], w_kv_b[l], w_mla_out[l])
        g = jax.nn.sigmoid((gate_logits + b_gate[l]).astype(jnp.float32)).astype(x.dtype)
        g = g.reshape(B, S, N_BRANCHES, D)
        merged = g[:, :, 0] * a + g[:, :, 1] * m
        x = x + gate1[:, None, :] * (merged @ w_out[l])

        h2 = modulate(rms_norm(x, g_ffn[l]), shift2, scale2)
        x = x + gate2[:, None, :] * moe_ffn(h2, w_router[l], b_router[l], w_gu[l], b_gu[l], w_down[l], b_down[l])

    fmod = c_act @ w_fmod + b_fmod
    fshift, fscale = fmod[:, :D], fmod[:, D:]
    return modulate(rms_norm(x, g_final), fshift, fscale)
```

```cpp
#include <hip/hip_runtime.h>
#include <hip/hip_cooperative_groups.h>
#include <cstdio>
#include <cstdint>
namespace cg = cooperative_groups;

#ifndef ONE_LAUNCH
#define ONE_LAUNCH 0
#endif
#ifndef FAST_GEMM
#define FAST_GEMM 0
#endif
#ifndef FAST_ATTN
#define FAST_ATTN 0
#endif

#define LAS __attribute__((address_space(3)))
typedef unsigned short bf16_t;
typedef short bf16x8 __attribute__((ext_vector_type(8)));
typedef float f32x4 __attribute__((ext_vector_type(4)));
typedef float f32x2 __attribute__((ext_vector_type(2)));
typedef unsigned u32x4 __attribute__((ext_vector_type(4)));
typedef unsigned u32x2 __attribute__((ext_vector_type(2)));
typedef __bf16 bf16x2_t __attribute__((ext_vector_type(2)));

constexpr int D = 1024, NB = 8, SEQ = 4096, T = NB * SEQ;
constexpr int QL = 768, KVL = 256, ROPE = 64, NH = 8, NOPE = 128, VH = 128, QKD = NOPE + ROPE;
constexpr int IN_W = 4160, INP = 4352;
constexpr int NE = 32, TOPK = 4, DE = 1024;
constexpr int NSLOT = T * TOPK;
constexpr int RT_MAX = 543;
constexpr float EPS = 1e-6f;
constexpr float QSCALE = 0.07216878364870322f * 1.4426950408889634f;

constexpr size_t MiB = 1u << 20;
constexpr size_t WS_MOD = 1 * MiB;
constexpr size_t WS_FMOD = 1 * MiB + 256 * 1024;
constexpr size_t WS_CS = 2 * MiB;
constexpr size_t WS_PSQQ = 10 * MiB;
constexpr size_t WS_PSQKV = 12 * MiB;
constexpr size_t WS_TKI = 13 * MiB;
constexpr size_t WS_TKW = 13 * MiB + 512 * 1024;
constexpr size_t WS_RANK = 14 * MiB;
constexpr size_t WS_SLOTROW = 14 * MiB + 512 * 1024;
constexpr size_t WS_COUNTS = 15 * MiB;
constexpr size_t WS_ROWW = 16 * MiB;
constexpr size_t WS_TILEE = 17 * MiB;
constexpr size_t WS_WR = 18 * MiB;
constexpr size_t WS_WIN = 32 * MiB;
constexpr size_t WS_WQ = 41 * MiB;
constexpr size_t WS_WK = 44 * MiB;
constexpr size_t WS_WV = 45 * MiB;
constexpr size_t WS_WGRP = 46 * MiB;
constexpr size_t WS_WPO = 47 * MiB;
constexpr size_t WS_WMO = 49 * MiB;
constexpr size_t WS_WOUT = 51 * MiB;
constexpr size_t WS_WGU = 54 * MiB;
constexpr size_t WS_WDN = 182 * MiB;
constexpr size_t WS_S0 = 256 * MiB;
constexpr size_t WS_S1 = 320 * MiB;
constexpr size_t WS_QLAT = 384 * MiB;
constexpr size_t WS_KVLAT = 432 * MiB;
constexpr size_t WS_KPE = 448 * MiB;
constexpr size_t WS_GATES = 452 * MiB;
constexpr size_t WS_Q = 580 * MiB;
constexpr size_t WS_KN = 676 * MiB;
constexpr size_t WS_VT = 740 * MiB;
constexpr size_t WS_O = 804 * MiB;
constexpr size_t WS_XS = 320 * MiB;
constexpr size_t WS_ACT = 592 * MiB;
constexpr size_t WS_END = 864 * MiB;

constexpr int LDS_BYTES = 147456;
constexpr int NTHREADS = 512;

__device__ __forceinline__ unsigned pk2(float lo, float hi) { f32x2 v = {lo, hi}; bf16x2_t b = __builtin_convertvector(v, bf16x2_t); return __builtin_bit_cast(unsigned, b); }
__device__ __forceinline__ float bflo(unsigned u) { return __uint_as_float(u << 16); }
__device__ __forceinline__ float bfhi(unsigned u) { return __uint_as_float(u & 0xffff0000u); }
__device__ __forceinline__ void unpack8(const u32x4 w, float (&f)[8]) { f[0] = bflo(w.x); f[1] = bfhi(w.x); f[2] = bflo(w.y); f[3] = bfhi(w.y); f[4] = bflo(w.z); f[5] = bfhi(w.z); f[6] = bflo(w.w); f[7] = bfhi(w.w); }
__device__ __forceinline__ u32x4 pack8(const float (&f)[8]) { u32x4 w; w.x = pk2(f[0], f[1]); w.y = pk2(f[2], f[3]); w.z = pk2(f[4], f[5]); w.w = pk2(f[6], f[7]); return w; }
__device__ __forceinline__ float wave_sum(float v) {
#pragma unroll
    for (int o = 1; o < 64; o <<= 1) v += __shfl_xor(v, o);
    return v;
}
__device__ __forceinline__ float sigmoidf_(float x) { return 1.0f / (1.0f + __expf(-x)); }

struct Args {
    const float* in[27]; float* out; unsigned char* ws; int ph_lo, ph_hi;
};
enum { I_X = 0, I_C, I_POS, I_WMOD, I_BMOD, I_GMIX, I_WIN, I_BGATE, I_WPG, I_PSCALE, I_WPO, I_GQA, I_WQB, I_GKVA, I_WKVB, I_WMO, I_WOUT, I_GFFN, I_WR, I_BR, I_WGU, I_BGU, I_WDN, I_BDN, I_GFIN, I_WFMOD, I_BFMOD };

struct Unit { int pm, pn, e; unsigned ao, bo; };
struct Gemm { const bf16_t* A; const bf16_t* Bt; int lda, ldb, K; };
constexpr int NXCD = 8, WGM = 8;
__host__ __device__ __forceinline__ int perm32(int rho) { const int n = rho >> 4, i = rho & 15; return 8 * (i >> 2) + 4 * n + (i & 3); }

struct DenseSched {
    int nM, nN, nwg, G, c; unsigned a_tile, a_col, b_tile;
    __device__ void init(int nM_, int nN_, int G_, int c_, int lda, int ldb, unsigned a_col_) { nM = nM_; nN = nN_; nwg = nM * nN; G = G_; c = c_; a_tile = 256u * lda * 2u; b_tile = 256u * ldb * 2u; a_col = a_col_; }
    __device__ bool next(int i, Unit& u) const {
        const long L = (long)i * G + c; if (L >= nwg) return false;
        int wgid = (int)L; { const int q = nwg / NXCD, r = nwg % NXCD, xcd = wgid % NXCD, off = wgid / NXCD; wgid = (xcd < r ? xcd * (q + 1) : r * (q + 1) + (xcd - r) * q) + off; }
        const int nig = WGM * nN, gid = wgid / nig, fm = gid * WGM, gsz = (nM - fm) < WGM ? (nM - fm) : WGM;
        u.pm = fm + ((wgid % nig) % gsz); u.pn = (wgid % nig) / gsz; u.e = 0;
        u.ao = (unsigned)u.pm * a_tile + (unsigned)u.pn * a_col; u.bo = (unsigned)u.pn * b_tile; return true;
    }
};
struct MoeSched {
    const int* tile_e; int R, NT, G, c; unsigned a_tile, b_tile;
    __device__ void init(const int* te, int NT_, int G_, int c_, int lda, int ldb) { tile_e = te; R = te[1023]; NT = NT_; G = G_; c = c_; a_tile = 256u * lda * 2u; b_tile = 256u * ldb * 2u; }
    __device__ bool next(int i, Unit& u) const {
        int rt, pn;
        if (G == 256) { const int x = c & 7, j = c >> 3, rpr = 256 / NT, pxc = rpr / 8; rt = i * rpr + x * pxc + j / NT; pn = j % NT; }
        else { const long L = (long)i * G + c; rt = (int)(L / NT); pn = (int)(L % NT); }
        if (rt >= R) return false;
        const int e = tile_e[rt];
        u.pm = rt; u.pn = pn; u.e = e; u.ao = (unsigned)rt * a_tile; u.bo = (unsigned)(e * NT + pn) * b_tile; return true;
    }
};

template <class Epi>
__device__ __forceinline__ void run_epi(const Epi& E, const f32x4 (&acc)[2][2][4][2], const Unit& u, int wr, int wc, int fr, int fq) {
    typename Epi::ColCtx cc[2];
#pragma unroll
    for (int bj = 0; bj < 2; ++bj) cc[bj] = E.col_ctx(u, bj * 128 + wc * 32 + 8 * fq);
    asm volatile("" ::: "memory");
    const bool wp = Epi::SUMSQ && E.want_partial(u);
#pragma unroll
    for (int ai = 0; ai < 2; ++ai)
#pragma unroll
        for (int m = 0; m < 4; ++m) {
            const int row = u.pm * 256 + ai * 128 + wr * 64 + m * 16 + fr;
            const float rc = E.row_ctx(u, row); float part = 0.f;
#pragma unroll
            for (int bj = 0; bj < 2; ++bj) {
                float v[8];
#pragma unroll
                for (int j = 0; j < 4; ++j) { v[j] = acc[ai][bj][m][0][j]; v[4 + j] = acc[ai][bj][m][1][j]; }
                part += E.apply(u, row, bj * 128 + wc * 32 + 8 * fq, v, rc, cc[bj]);
            }
            if constexpr (Epi::SUMSQ) { if (wp) { float s = part; s += __shfl_xor(s, 16); s += __shfl_xor(s, 32); if (fq == 0) E.partial(u, row, wc, s); } }
            asm volatile("" ::: "memory");
        }
}

template <class Epi, class Sched>
__device__ __forceinline__ void gemm_simple(LAS unsigned char* lds, const Gemm g, const Sched& S, const Epi& E) {
    const int tid = threadIdx.x, wid = __builtin_amdgcn_readfirstlane(tid >> 6), lane = tid & 63, wr = wid >> 2, wc = wid & 3, fr = lane & 15, fq = lane >> 4;
    const int nt = g.K / 64;
    Unit u;
    for (int ui = 0; S.next(ui, u); ++ui) {
        f32x4 acc[2][2][4][2];
#pragma unroll
        for (int a = 0; a < 2; ++a)
#pragma unroll
            for (int b = 0; b < 2; ++b)
#pragma unroll
                for (int m = 0; m < 4; ++m)
#pragma unroll
                    for (int n = 0; n < 2; ++n) acc[a][b][m][n] = (f32x4){0.f, 0.f, 0.f, 0.f};
        const char* cA = (const char*)g.A + u.ao; const char* cB = (const char*)g.Bt + u.bo;
#pragma unroll 1
        for (int kt = 0; kt < nt; ++kt) {
            __syncthreads();
#pragma unroll
            for (int i = 0; i < 4; ++i) { const int c = tid + 512 * i, row = c >> 3, kc = c & 7, rb = (row & ~31) + perm32(row & 31);
                const u32x4 va = *(const u32x4*)(cA + (size_t)row * g.lda * 2 + kt * 128 + kc * 16);
                const u32x4 vb = *(const u32x4*)(cB + (size_t)rb * g.ldb * 2 + kt * 128 + kc * 16);
                *(LAS u32x4*)(lds + row * 144 + kc * 16) = va; *(LAS u32x4*)(lds + 36864 + row * 144 + kc * 16) = vb; }
            __syncthreads();
#pragma unroll
            for (int k = 0; k < 2; ++k) {
                bf16x8 Af[2][4], Bf[2][2];
#pragma unroll
                for (int ai = 0; ai < 2; ++ai)
#pragma unroll
                    for (int m = 0; m < 4; ++m) Af[ai][m] = *(const LAS bf16x8*)(lds + (ai * 128 + wr * 64 + m * 16 + fr) * 144 + (k * 32 + fq * 8) * 2);
#pragma unroll
                for (int bj = 0; bj < 2; ++bj)
#pragma unroll
                    for (int n = 0; n < 2; ++n) Bf[bj][n] = *(const LAS bf16x8*)(lds + 36864 + (bj * 128 + wc * 32 + n * 16 + fr) * 144 + (k * 32 + fq * 8) * 2);
#pragma unroll
                for (int ai = 0; ai < 2; ++ai)
#pragma unroll
                    for (int bj = 0; bj < 2; ++bj)
#pragma unroll
                        for (int m = 0; m < 4; ++m)
#pragma unroll
                            for (int n = 0; n < 2; ++n) acc[ai][bj][m][n] = __builtin_amdgcn_mfma_f32_16x16x32_bf16(Bf[bj][n], Af[ai][m], acc[ai][bj][m][n], 0, 0, 0);
            }
        }
        run_epi(E, acc, u, wr, wc, fr, fq);
    }
    __syncthreads();
}

template <class Epi, class Sched>
__device__ __forceinline__ void gemm_phase(LAS unsigned char* lds, const Gemm g, const Sched& S, const Epi& E) {
    gemm_simple<Epi, Sched>(lds, g, S, E);
}

struct NoCtx {};
struct EpiIn {
    static constexpr bool SUMSQ = true; typedef NoCtx ColCtx;
    bf16_t *U, *QLp, *KVLp, *KPE, *GATES; float *PSQQ, *PSQKV; const float* bgate; const f32x2* CS;
    __device__ __forceinline__ float row_ctx(const Unit&, int) const { return 0.f; }
    __device__ __forceinline__ NoCtx col_ctx(const Unit&, int) const { return NoCtx{}; }
    __device__ __forceinline__ bool want_partial(const Unit& u) const { return u.pn >= 4 && u.pn < 8; }
    __device__ __forceinline__ void partial(const Unit& u, int row, int wc, float s) const {
        if (u.pn < 7) PSQQ[(size_t)row * 12 + (u.pn - 4) * 4 + wc] = s; else PSQKV[(size_t)row * 4 + wc] = s; }
    __device__ __forceinline__ float apply(const Unit& u, int row, int col, float (&v)[8], float, NoCtx) const {
        const int pn = u.pn;
        if (pn < 4) { *(u32x4*)(U + (size_t)row * D + pn * 256 + col) = pack8(v); return 0.f; }
        if (pn < 8) {
            float s = 0.f;
#pragma unroll
            for (int j = 0; j < 8; ++j) s += v[j] * v[j];
            if (pn < 7) *(u32x4*)(QLp + (size_t)row * QL + (pn - 4) * 256 + col) = pack8(v);
            else *(u32x4*)(KVLp + (size_t)row * KVL + col) = pack8(v);
            return s;
        }
        if (pn < 16) {
            const int gc = (pn - 8) * 256 + col; const f32x4 b0 = *(const f32x4*)(bgate + gc), b1 = *(const f32x4*)(bgate + gc + 4);
            float o[8];
#pragma unroll
            for (int j = 0; j < 4; ++j) { o[j] = sigmoidf_(v[j] + b0[j]); o[4 + j] = sigmoidf_(v[4 + j] + b1[j]); }
            *(u32x4*)(GATES + (size_t)row * 2048 + gc) = pack8(o); return 0.f;
        }
        if (col < 64) {
            const int g = col >> 3; float y1[4], y2[4];
#pragma unroll
            for (int i = 0; i < 4; ++i) { const f32x2 cs = CS[(size_t)row * 32 + 4 * g + i]; y1[i] = v[i] * cs.x - v[4 + i] * cs.y; y2[i] = v[4 + i] * cs.x + v[i] * cs.y; }
            u32x2 a, b; a.x = pk2(y1[0], y1[1]); a.y = pk2(y1[2], y1[3]); b.x = pk2(y2[0], y2[1]); b.y = pk2(y2[2], y2[3]);
            *(u32x2*)(KPE + (size_t)row * 64 + 4 * g) = a; *(u32x2*)(KPE + (size_t)row * 64 + 32 + 4 * g) = b;
        }
        return 0.f;
    }
};
struct EpiQ {
    static constexpr bool SUMSQ = false; typedef NoCtx ColCtx;
    bf16_t* Q; const float* PSQQ; const f32x2* CS;
    __device__ __forceinline__ float row_ctx(const Unit&, int row) const {
        const f32x4* p = (const f32x4*)(PSQQ + (size_t)row * 12); const f32x4 a = p[0], b = p[1], c = p[2];
        const float s = ((a[0] + a[1]) + (a[2] + a[3])) + ((b[0] + b[1]) + (b[2] + b[3])) + ((c[0] + c[1]) + (c[2] + c[3]));
        return rsqrtf(s * (1.0f / QL) + EPS) * QSCALE; }
    __device__ __forceinline__ NoCtx col_ctx(const Unit&, int) const { return NoCtx{}; }
    __device__ __forceinline__ bool want_partial(const Unit&) const { return false; }
    __device__ __forceinline__ void partial(const Unit&, int, int, float) const {}
    __device__ __forceinline__ float apply(const Unit& u, int row, int col, float (&v)[8], float rs, NoCtx) const {
#pragma unroll
        for (int j = 0; j < 8; ++j) v[j] *= rs;
        if (u.pn < 4) { const int p = u.pn * 256 + col, hh = p >> 7, d = p & 127; *(u32x4*)(Q + (size_t)row * (NH * QKD) + hh * QKD + d) = pack8(v); }
        else { const int r = (u.pn - 4) * 256 + col, hh = r >> 6, g = (r & 63) >> 3; float y1[4], y2[4];
#pragma unroll
            for (int i = 0; i < 4; ++i) { const f32x2 cs = CS[(size_t)row * 32 + 4 * g + i]; y1[i] = v[i] * cs.x - v[4 + i] * cs.y; y2[i] = v[4 + i] * cs.x + v[i] * cs.y; }
            u32x2 a, b; a.x = pk2(y1[0], y1[1]); a.y = pk2(y1[2], y1[3]); b.x = pk2(y2[0], y2[1]); b.y = pk2(y2[2], y2[3]);
            bf16_t* q = Q + (size_t)row * (NH * QKD) + hh * QKD + NOPE; *(u32x2*)(q + 4 * g) = a; *(u32x2*)(q + 32 + 4 * g) = b; }
        return 0.f;
    }
};
__device__ __forceinline__ float rstd_kv(const float* PSQKV, int t) { const f32x4 a = *(const f32x4*)(PSQKV + (size_t)t * 4); return rsqrtf(((a[0] + a[1]) + (a[2] + a[3])) * (1.0f / KVL) + EPS); }
struct EpiK {
    static constexpr bool SUMSQ = false; typedef NoCtx ColCtx;
    bf16_t* KN; const float* PSQKV;
    __device__ __forceinline__ float row_ctx(const Unit&, int row) const { return rstd_kv(PSQKV, row); }
    __device__ __forceinline__ NoCtx col_ctx(const Unit&, int) const { return NoCtx{}; }
    __device__ __forceinline__ bool want_partial(const Unit&) const { return false; }
    __device__ __forceinline__ void partial(const Unit&, int, int, float) const {}
    __device__ __forceinline__ float apply(const Unit& u, int row, int col, float (&v)[8], float rs, NoCtx) const {
#pragma unroll
        for (int j = 0; j < 8; ++j) v[j] *= rs;
        *(u32x4*)(KN + (size_t)row * D + u.pn * 256 + col) = pack8(v); return 0.f; }
};
struct Ctx8 { float s[8]; };
struct EpiVT {
    static constexpr bool SUMSQ = false; typedef Ctx8 ColCtx;
    bf16_t* VT; const float* PSQKV;
    __device__ __forceinline__ float row_ctx(const Unit&, int) const { return 0.f; }
    __device__ __forceinline__ Ctx8 col_ctx(const Unit& u, int col) const { Ctx8 c; const int t0 = u.pn * 256 + col;
#pragma unroll
        for (int j = 0; j < 8; ++j) c.s[j] = rstd_kv(PSQKV, t0 + j);
        return c; }
    __device__ __forceinline__ bool want_partial(const Unit&) const { return false; }
    __device__ __forceinline__ void partial(const Unit&, int, int, float) const {}
    __device__ __forceinline__ float apply(const Unit& u, int row, int col, float (&v)[8], float, const Ctx8& cc) const {
#pragma unroll
        for (int j = 0; j < 8; ++j) v[j] *= cc.s[j];
        *(u32x4*)(VT + (size_t)row * T + u.pn * 256 + col) = pack8(v); return 0.f; }
};
struct EpiPlain {
    static constexpr bool SUMSQ = false; typedef NoCtx ColCtx;
    bf16_t* O; int ldc;
    __device__ __forceinline__ float row_ctx(const Unit&, int) const { return 0.f; }
    __device__ __forceinline__ NoCtx col_ctx(const Unit&, int) const { return NoCtx{}; }
    __device__ __forceinline__ bool want_partial(const Unit&) const { return false; }
    __device__ __forceinline__ void partial(const Unit&, int, int, float) const {}
    __device__ __forceinline__ float apply(const Unit& u, int row, int col, float (&v)[8], float, NoCtx) const {
        *(u32x4*)(O + (size_t)row * ldc + u.pn * 256 + col) = pack8(v); return 0.f; }
};
template <int MODE> struct EpiMerge {
    static constexpr bool SUMSQ = false; typedef NoCtx ColCtx;
    bf16_t* MG; const bf16_t* GATES;
    __device__ __forceinline__ float row_ctx(const Unit&, int) const { return 0.f; }
    __device__ __forceinline__ NoCtx col_ctx(const Unit&, int) const { return NoCtx{}; }
    __device__ __forceinline__ bool want_partial(const Unit&) const { return false; }
    __device__ __forceinline__ void partial(const Unit&, int, int, float) const {}
    __device__ __forceinline__ float apply(const Unit& u, int row, int col, float (&v)[8], float, NoCtx) const {
        const int c = u.pn * 256 + col; float g[8]; unpack8(*(const u32x4*)(GATES + (size_t)row * 2048 + MODE * 1024 + c), g);
        bf16_t* p = MG + (size_t)row * D + c;
        if (MODE == 0) {
#pragma unroll
            for (int j = 0; j < 8; ++j) v[j] *= g[j];
        } else {
            unsigned long long* p8 = (unsigned long long*)p;
            const unsigned long long lo = __hip_atomic_load(p8, __ATOMIC_RELAXED, __HIP_MEMORY_SCOPE_AGENT), hi = __hip_atomic_load(p8 + 1, __ATOMIC_RELAXED, __HIP_MEMORY_SCOPE_AGENT);
            u32x4 w; w.x = (unsigned)lo; w.y = (unsigned)(lo >> 32); w.z = (unsigned)hi; w.w = (unsigned)(hi >> 32); float a[8]; unpack8(w, a);
#pragma unroll
            for (int j = 0; j < 8; ++j) v[j] = a[j] + v[j] * g[j];
        }
        *(u32x4*)p = pack8(v); return 0.f; }
};
struct EpiOut {
    static constexpr bool SUMSQ = false; typedef NoCtx ColCtx;
    const float* X; float* X1; const float* MOD;
    __device__ __forceinline__ float row_ctx(const Unit&, int) const { return 0.f; }
    __device__ __forceinline__ NoCtx col_ctx(const Unit&, int) const { return NoCtx{}; }
    __device__ __forceinline__ bool want_partial(const Unit&) const { return false; }
    __device__ __forceinline__ void partial(const Unit&, int, int, float) const {}
    __device__ __forceinline__ float apply(const Unit& u, int row, int col, float (&v)[8], float, NoCtx) const {
        const int c = u.pn * 256 + col, b = row >> 12; const float* g1 = MOD + b * 6144 + 2 * 1024 + c; const float* xr = X + (size_t)row * D + c; float* o = X1 + (size_t)row * D + c;
        const f32x4 g0 = *(const f32x4*)g1, g1v = *(const f32x4*)(g1 + 4), x0 = *(const f32x4*)xr, x1v = *(const f32x4*)(xr + 4);
        f32x4 o0, o1;
#pragma unroll
        for (int j = 0; j < 4; ++j) { o0[j] = x0[j] + g0[j] * v[j]; o1[j] = x1v[j] + g1v[j] * v[4 + j]; }
        *(f32x4*)o = o0; *(f32x4*)(o + 4) = o1; return 0.f; }
};
struct EpiGU {
    static constexpr bool SUMSQ = false; typedef NoCtx ColCtx;
    bf16_t* ACT; const float* bgu;
    __device__ __forceinline__ float row_ctx(const Unit&, int) const { return 0.f; }
    __device__ __forceinline__ NoCtx col_ctx(const Unit&, int) const { return NoCtx{}; }
    __device__ __forceinline__ bool want_partial(const Unit&) const { return false; }
    __device__ __forceinline__ void partial(const Unit&, int, int, float) const {}
    __device__ __forceinline__ float apply(const Unit& u, int row, int col, float (&v)[8], float, NoCtx) const {
        const int p = u.pn * 256 + col; const float* bp = bgu + (size_t)u.e * 2048 + p; const f32x4 b0 = *(const f32x4*)bp, b1 = *(const f32x4*)(bp + 4);
        const float bb[8] = {b0[0], b0[1], b0[2], b0[3], b1[0], b1[1], b1[2], b1[3]}; float a[4];
#pragma unroll
        for (int i = 0; i < 4; ++i) { float gt = v[i] + bb[2 * i], up = v[4 + i] + bb[2 * i + 1]; gt = fminf(gt, 7.0f); up = fminf(fmaxf(up, -7.0f), 7.0f);
            a[i] = (up + 1.0f) * (gt * sigmoidf_(1.702f * gt)); }
        u32x2 w; w.x = pk2(a[0], a[1]); w.y = pk2(a[2], a[3]); *(u32x2*)(ACT + (size_t)row * DE + (p >> 1)) = w; return 0.f; }
};
struct EpiDown {
    static constexpr bool SUMSQ = false; typedef NoCtx ColCtx;
    bf16_t* Y; const float* bdn; const float* ROWW;
    __device__ __forceinline__ float row_ctx(const Unit&, int row) const { return ROWW[row]; }
    __device__ __forceinline__ NoCtx col_ctx(const Unit&, int) const { return NoCtx{}; }
    __device__ __forceinline__ bool want_partial(const Unit&) const { return false; }
    __device__ __forceinline__ void partial(const Unit&, int, int, float) const {}
    __device__ __forceinline__ float apply(const Unit& u, int row, int col, float (&v)[8], float rw, NoCtx) const {
        const int c = u.pn * 256 + col; const float* bp = bdn + (size_t)u.e * D + c; const f32x4 b0 = *(const f32x4*)bp, b1 = *(const f32x4*)(bp + 4);
#pragma unroll
        for (int j = 0; j < 4; ++j) { v[j] = (v[j] + b0[j]) * rw; v[4 + j] = (v[4 + j] + b1[j]) * rw; }
        *(u32x4*)(Y + (size_t)row * D + c) = pack8(v); return 0.f; }
};

__device__ __forceinline__ void tr_item(const float* src, int Nsrc, bf16_t* dst, int K, int kb, int pb, int lb, int perm, bool zero, const float* rs, const float* cs, LAS float* scr, int lane) {
    const int k0 = kb * 64;
#pragma unroll 4
    for (int it = 0; it < 16; ++it) {
        const int kk = 4 * it + (lane >> 4), o4 = 4 * (lane & 15);
        f32x4 v = (f32x4){0.f, 0.f, 0.f, 0.f};
        if (!zero) { v = *(const f32x4*)(src + (size_t)(k0 + kk) * Nsrc + lb + o4);
            if (rs) v *= rs[k0 + kk];
            if (cs) v *= *(const f32x4*)(cs + lb + o4); }
        int ph;
        if (perm == 1) ph = 8 * ((o4 & 31) >> 2) + 4 * (o4 >> 5);
        else if (perm == 2) ph = 8 * (o4 >> 3);
        else ph = o4;
        LAS float* s = scr + kk * 65;
        if (perm == 2) { const int w0 = o4 & 7;
            s[ph + 4 * ((w0 + 0) & 1) + ((w0 + 0) >> 1)] = v[0]; s[ph + 4 * ((w0 + 1) & 1) + ((w0 + 1) >> 1)] = v[1];
            s[ph + 4 * ((w0 + 2) & 1) + ((w0 + 2) >> 1)] = v[2]; s[ph + 4 * ((w0 + 3) & 1) + ((w0 + 3) >> 1)] = v[3]; }
        else { s[ph] = v[0]; s[ph + 1] = v[1]; s[ph + 2] = v[2]; s[ph + 3] = v[3]; }
    }
    asm volatile("s_waitcnt lgkmcnt(0)" ::: "memory");
    const int c = lane & 7;
#pragma unroll
    for (int j = 0; j < 8; ++j) { const int p = (lane >> 3) + 8 * j; const LAS float* s = scr + (8 * c) * 65 + p;
        u32x4 o; o.x = pk2(s[0 * 65], s[1 * 65]); o.y = pk2(s[2 * 65], s[3 * 65]); o.z = pk2(s[4 * 65], s[5 * 65]); o.w = pk2(s[6 * 65], s[7 * 65]);
        *(u32x4*)(dst + (size_t)(pb * 64 + p) * K + k0 + 8 * c) = o; }
    asm volatile("s_waitcnt lgkmcnt(0)" ::: "memory");
}

__device__ __forceinline__ void p0_prep(const Args& a, LAS unsigned char* lds, int vcu, int G) {
    const int tid = threadIdx.x, lane = tid & 63, wave = __builtin_amdgcn_readfirstlane(tid >> 6);
    unsigned char* ws = a.ws;
    for (int item = vcu; item < 128; item += G) {
        LAS float* cact = (LAS float*)lds;
        LAS float* part = (LAS float*)(lds + 32768);
        for (int i = tid; i < 8 * 1024; i += NTHREADS) { const float cv = a.in[I_C][i]; cact[i] = cv / (1.0f + __expf(-cv)); }
        __syncthreads();
        const bool isf = item >= 96; const float* W = isf ? a.in[I_WFMOD] : a.in[I_WMOD]; const int N = isf ? 2048 : 6144, j0 = (isf ? item - 96 : item) * 64;
        float acc[8];
#pragma unroll
        for (int b = 0; b < 8; ++b) acc[b] = 0.f;
        for (int k = wave * 128; k < wave * 128 + 128; ++k) { const float w = W[(size_t)k * N + j0 + lane];
#pragma unroll
            for (int b = 0; b < 8; ++b) acc[b] += cact[b * 1024 + k] * w; }
#pragma unroll
        for (int b = 0; b < 8; ++b) part[(wave * 8 + b) * 64 + lane] = acc[b];
        __syncthreads();
        { const int b = tid >> 6, col = tid & 63; float s = 0.f;
#pragma unroll
            for (int w = 0; w < 8; ++w) s += part[(w * 8 + b) * 64 + col];
            if (isf) ((float*)(ws + WS_FMOD))[b * 2048 + j0 + col] = s + a.in[I_BFMOD][j0 + col];
            else ((float*)(ws + WS_MOD))[b * 6144 + j0 + col] = s + a.in[I_BMOD][j0 + col]; }
        __syncthreads();
    }
    { const int* pos = (const int*)a.in[I_POS]; f32x2* CS = (f32x2*)(ws + WS_CS);
        for (int idx = vcu * NTHREADS + tid; idx < T * 32; idx += G * NTHREADS) { const int t = idx >> 5, i = idx & 31;
            const double invf = exp(-(double)i * (9.210340371976184 / 32.0));
            const double ang = (double)pos[t] * invf; const double n = rint(ang * 0.15915494309189535); const float r = (float)(ang - n * 6.283185307179586);
            CS[idx] = (f32x2){__cosf(r), __sinf(r)}; } }
    { bf16_t* WR = (bf16_t*)(ws + WS_WR);
        for (int idx = vcu * NTHREADS + tid; idx < 1024 * 32; idx += G * NTHREADS) { const int e = idx & 31, k = idx >> 5; const float v = a.in[I_WR][idx];
            const unsigned h = pk2(v, 0.f) & 0xffffu; const float lo = v - bflo(h); WR[e * 1024 + k] = (bf16_t)h; WR[32768 + e * 1024 + k] = (bf16_t)(pk2(lo, 0.f) & 0xffffu); } }
    LAS float* scr = (LAS float*)(lds + wave * 16640);
    const int gw = vcu * 8 + wave, NGW = G * 8;
    constexpr int N_IN = 16 * 68, N_Q = 12 * 24, N_K = 4 * 16, N_V = 4 * 16, N_G = 4 * 16, N_SQ = 16 * 16, N_GU = 32 * 16 * 32, N_DN = 32 * 16 * 16;
    constexpr int NITEMS = N_IN + N_Q + N_K + N_V + N_G + 3 * N_SQ + N_GU + N_DN;
    for (int it = gw; it < NITEMS; it += NGW) {
        int r = it;
        if (r < N_IN) { const int pb = r % 68, kb = r / 68; int lb, perm = 0; bool zero = false;
            if (pb < 32) lb = pb * 64; else if (pb < 64) lb = pb * 64 + 64; else if (pb == 64) { lb = 2048; perm = 1; } else { lb = 0; zero = true; }
            tr_item(a.in[I_WIN], IN_W, (bf16_t*)(ws + WS_WIN), 1024, kb, pb, lb, perm, zero, nullptr, nullptr, scr, lane); continue; } r -= N_IN;
        if (r < N_Q) { const int pb = r % 24, kb = r / 24; int lb, perm = 0;
            if (pb < 16) lb = (pb >> 1) * QKD + (pb & 1) * 64; else { lb = (pb - 16) * QKD + NOPE; perm = 1; }
            tr_item(a.in[I_WQB], NH * QKD, (bf16_t*)(ws + WS_WQ), QL, kb, pb, lb, perm, false, a.in[I_GQA], nullptr, scr, lane); continue; } r -= N_Q;
        if (r < N_K) { const int pb = r % 16, kb = r / 16; const int lb = (pb >> 1) * 256 + (pb & 1) * 64;
            tr_item(a.in[I_WKVB], NH * 256, (bf16_t*)(ws + WS_WK), KVL, kb, pb, lb, 0, false, a.in[I_GKVA], nullptr, scr, lane); continue; } r -= N_K;
        if (r < N_V) { const int pb = r % 16, kb = r / 16; const int lb = (pb >> 1) * 256 + 128 + (pb & 1) * 64;
            tr_item(a.in[I_WKVB], NH * 256, (bf16_t*)(ws + WS_WV), KVL, kb, pb, lb, 0, false, a.in[I_GKVA], nullptr, scr, lane); continue; } r -= N_V;
        if (r < N_G) { const int g = r / 16, q = r % 16, pb = q % 4, kb = q / 4;
            tr_item(a.in[I_WPG] + (size_t)g * 65536, 256, (bf16_t*)(ws + WS_WGRP) + (size_t)g * 65536, 256, kb, pb, pb * 64, 0, false, nullptr, a.in[I_PSCALE] + g * 256, scr, lane); continue; } r -= N_G;
        if (r < 3 * N_SQ) { const int which = r / N_SQ, q = r % N_SQ, pb = q % 16, kb = q / 16;
            const float* src = which == 0 ? a.in[I_WPO] : which == 1 ? a.in[I_WMO] : a.in[I_WOUT]; const size_t off = which == 0 ? WS_WPO : which == 1 ? WS_WMO : WS_WOUT;
            tr_item(src, 1024, (bf16_t*)(ws + off), 1024, kb, pb, pb * 64, 0, false, nullptr, nullptr, scr, lane); continue; } r -= 3 * N_SQ;
        if (r < N_GU) { const int e = r / 512, q = r % 512, pb = q % 32, kb = q / 32;
            tr_item(a.in[I_WGU] + (size_t)e * 1024 * 2048, 2048, (bf16_t*)(ws + WS_WGU) + (size_t)e * 2048 * 1024, 1024, kb, pb, pb * 64, 2, false, nullptr, nullptr, scr, lane); continue; } r -= N_GU;
        { const int e = r / 256, q = r % 256, pb = q % 16, kb = q / 16;
            tr_item(a.in[I_WDN] + (size_t)e * 1024 * 1024, 1024, (bf16_t*)(ws + WS_WDN) + (size_t)e * 1024 * 1024, 1024, kb, pb, pb * 64, 0, false, nullptr, nullptr, scr, lane); }
    }
}

__device__ __forceinline__ void p1_hb(const Args& a, int vcu, int G) {
    const int tid = threadIdx.x, lane = tid & 63, wave = tid >> 6;
    const float* MOD = (const float*)(a.ws + WS_MOD); bf16_t* HB = (bf16_t*)(a.ws + WS_S0);
    for (int rb = vcu * 128; rb < T; rb += G * 128) {
        const int b = rb >> 12;
        f32x4 gs[4], sh[4];
#pragma unroll
        for (int j = 0; j < 4; ++j) { const int c = 4 * lane + 256 * j; const f32x4 g = *(const f32x4*)(a.in[I_GMIX] + c), sc = *(const f32x4*)(MOD + b * 6144 + 1024 + c);
            gs[j] = g * (sc + 1.0f); sh[j] = *(const f32x4*)(MOD + b * 6144 + c); }
        for (int i = 0; i < 16; ++i) { const int r = rb + wave * 16 + i; const f32x4* xr = (const f32x4*)(a.in[I_X] + (size_t)r * D) + lane;
            f32x4 v[4]; float s = 0.f;
#pragma unroll
            for (int j = 0; j < 4; ++j) { v[j] = xr[64 * j]; s += (v[j][0] * v[j][0] + v[j][1] * v[j][1]) + (v[j][2] * v[j][2] + v[j][3] * v[j][3]); }
            const float rstd = rsqrtf(wave_sum(s) * (1.0f / D) + EPS);
            u32x2* o = (u32x2*)(HB + (size_t)r * D) + lane;
#pragma unroll
            for (int j = 0; j < 4; ++j) { const f32x4 h = v[j] * rstd * gs[j] + sh[j]; u32x2 w; w.x = pk2(h[0], h[1]); w.y = pk2(h[2], h[3]); o[64 * j] = w; } }
    }
}

__device__ __forceinline__ void p3_mixed(const Args& a, int vcu, int G) {
    const int tid = threadIdx.x; const bf16_t* U = (const bf16_t*)(a.ws + WS_S1); bf16_t* MX = (bf16_t*)(a.ws + WS_S0);
    for (int rb = vcu * 128; rb < T; rb += G * 128) {
        for (int q = 0; q < 2; ++q) { const int item = tid + NTHREADS * q, cgi = item & 127, seg = item >> 7;
            const int w = 2 << (cgi >> 5), row0 = rb + seg * 16, s0 = row0 & (SEQ - 1);
            float sum[8];
#pragma unroll
            for (int j = 0; j < 8; ++j) sum[j] = 0.f;
            for (int k = 1; k < w; ++k) if (s0 - k >= 0) { float f[8]; unpack8(*(const u32x4*)(U + (size_t)(row0 - k) * D + cgi * 8), f);
#pragma unroll
                for (int j = 0; j < 8; ++j) sum[j] += f[j]; }
            for (int i = 0; i < 16; ++i) { const int r = row0 + i, s = s0 + i; float cur[8]; unpack8(*(const u32x4*)(U + (size_t)r * D + cgi * 8), cur);
                const float inv = 1.0f / (float)(s + 1 < w ? s + 1 : w); float o[8];
#pragma unroll
                for (int j = 0; j < 8; ++j) { sum[j] += cur[j]; o[j] = sum[j] * inv - cur[j]; }
                *(u32x4*)(MX + (size_t)r * D + cgi * 8) = pack8(o);
                if (s - (w - 1) >= 0) { float f[8]; unpack8(*(const u32x4*)(U + (size_t)(r - (w - 1)) * D + cgi * 8), f);
#pragma unroll
                    for (int j = 0; j < 8; ++j) sum[j] -= f[j]; } }
        }
    }
}

__device__ __forceinline__ void attn_naive(const Args& a, LAS unsigned char* lds, int vcu, int G) {
    const int tid = threadIdx.x, qi = tid >> 3, part = tid & 7;
    const bf16_t* Q = (const bf16_t*)(a.ws + WS_Q); const bf16_t* KN = (const bf16_t*)(a.ws + WS_KN); const bf16_t* KPE = (const bf16_t*)(a.ws + WS_KPE);
    const bf16_t* VT = (const bf16_t*)(a.ws + WS_VT); bf16_t* O = (bf16_t*)(a.ws + WS_O);
    LAS unsigned char* Qs = lds;
    LAS unsigned char* Ks = lds + 25600;
    LAS unsigned char* Vs = lds + 51200;
    LAS float* Ss = (LAS float*)(lds + 69632);
    for (int it = vcu; it < NB * NH * 64; it += G) {
        const int c = 63 - (it & 63), bh = it >> 6, b = bh >> 3, h = bh & 7; const int t0 = b * SEQ + c * 64;
        __syncthreads();
#pragma unroll
        for (int i = 0; i < 3; ++i) { const int ch = tid + NTHREADS * i, row = ch / 24, kc = ch % 24;
            *(LAS u32x4*)(Qs + row * 400 + kc * 16) = *(const u32x4*)(Q + (size_t)(t0 + row) * (NH * QKD) + h * QKD + kc * 8); }
        float m = -1e30f, l = 0.f, o[16];
#pragma unroll
        for (int dd = 0; dd < 16; ++dd) o[dd] = 0.f;
        for (int kt = 0; kt <= c; ++kt) {
            const int k0 = b * SEQ + kt * 64;
            __syncthreads();
#pragma unroll
            for (int i = 0; i < 2; ++i) { const int ch = tid + NTHREADS * i, row = ch >> 4, kc = ch & 15;
                *(LAS u32x4*)(Ks + row * 400 + kc * 16) = *(const u32x4*)(KN + (size_t)(k0 + row) * D + h * 128 + kc * 8); }
            { const int row = tid >> 3, kc = tid & 7; *(LAS u32x4*)(Ks + row * 400 + 256 + kc * 16) = *(const u32x4*)(KPE + (size_t)(k0 + row) * 64 + kc * 8); }
#pragma unroll
            for (int i = 0; i < 2; ++i) { const int ch = tid + NTHREADS * i, d = ch >> 3, kc = ch & 7;
                *(LAS u32x4*)(Vs + d * 144 + kc * 16) = *(const u32x4*)(VT + (size_t)(h * 128 + d) * T + k0 + kc * 8); }
            __syncthreads();
            float s[8];
#pragma unroll
            for (int j = 0; j < 8; ++j) s[j] = 0.f;
            for (int d8 = 0; d8 < 24; ++d8) { float q8[8]; unpack8(*(const LAS u32x4*)(Qs + qi * 400 + d8 * 16), q8);
#pragma unroll
                for (int j = 0; j < 8; ++j) { float k8[8]; unpack8(*(const LAS u32x4*)(Ks + (part * 8 + j) * 400 + d8 * 16), k8);
#pragma unroll
                    for (int e = 0; e < 8; ++e) s[j] += q8[e] * k8[e]; } }
#pragma unroll
            for (int j = 0; j < 8; ++j) Ss[qi * 65 + part * 8 + j] = s[j];
            __syncthreads();
            float mx = -1e30f;
            for (int k = 0; k < 64; ++k) mx = fmaxf(mx, Ss[qi * 65 + k]);
            const float mn = fmaxf(m, mx), alpha = exp2f(m - mn); float ls = 0.f;
            for (int k = 0; k < 64; ++k) ls += exp2f(Ss[qi * 65 + k] - mn);
            l = l * alpha + ls; m = mn;
#pragma unroll
            for (int dd = 0; dd < 16; ++dd) o[dd] *= alpha;
            for (int k8 = 0; k8 < 8; ++k8) { float p8[8];
#pragma unroll
                for (int e = 0; e < 8; ++e) p8[e] = exp2f(Ss[qi * 65 + k8 * 8 + e] - mn);
#pragma unroll
                for (int dd = 0; dd < 16; ++dd) { float v8[8]; unpack8(*(const LAS u32x4*)(Vs + (part * 16 + dd) * 144 + k8 * 16), v8);
#pragma unroll
                    for (int e = 0; e < 8; ++e) o[dd] += p8[e] * v8[e]; } }
        }
        const float il = 1.0f / l; float o0[8], o1[8];
#pragma unroll
        for (int j = 0; j < 8; ++j) { o0[j] = o[j] * il; o1[j] = o[8 + j] * il; }
        bf16_t* op = O + (size_t)(t0 + qi) * D + h * 128 + part * 16; *(u32x4*)op = pack8(o0); *(u32x4*)(op + 8) = pack8(o1);
    }
    __syncthreads();
}

__device__ __forceinline__ void p7_router(const Args& a, LAS unsigned char* lds, int vcu, int G) {
    const int tid = threadIdx.x, lane = tid & 63, wave = tid >> 6, rr = lane & 15, g = lane >> 4;
    const float* MOD = (const float*)(a.ws + WS_MOD); const float* X1 = a.out; bf16_t* H2 = (bf16_t*)(a.ws + WS_S0);
    int* TKI = (int*)(a.ws + WS_TKI); float* TKW = (float*)(a.ws + WS_TKW); int* RANK = (int*)(a.ws + WS_RANK); int* COUNTS = (int*)(a.ws + WS_COUNTS);
    LAS int* cnt = (LAS int*)(lds + 131072);
    __syncthreads();
    { const u32x4* src = (const u32x4*)(a.ws + WS_WR);
        for (int ch = tid; ch < 8192; ch += NTHREADS) { const int hl = ch >> 12, e = (ch >> 7) & 31, kc = ch & 127;
            *(LAS u32x4*)(lds + hl * 65536 + e * 2048 + ((kc ^ (e & 15)) << 4)) = src[ch]; } }
    for (int rb = vcu * 128; rb < T; rb += G * 128) {
        if (tid < 32) cnt[tid] = 0;
        __syncthreads();
        const int r0 = rb + wave * 16, b = rb >> 12, row = r0 + rr;
        const float* xr = X1 + (size_t)row * D + 8 * g;
        float ss = 0.f;
        for (int s = 0; s < 32; ++s) { const f32x4 x0 = *(const f32x4*)(xr + 32 * s), x1 = *(const f32x4*)(xr + 32 * s + 4);
            ss += (x0[0] * x0[0] + x0[1] * x0[1]) + (x0[2] * x0[2] + x0[3] * x0[3]) + (x1[0] * x1[0] + x1[1] * x1[1]) + (x1[2] * x1[2] + x1[3] * x1[3]); }
        ss += __shfl_xor(ss, 16); ss += __shfl_xor(ss, 32);
        const float rstd = rsqrtf(ss * (1.0f / D) + EPS);
        f32x4 acc0 = (f32x4){0.f, 0.f, 0.f, 0.f}, acc1 = acc0;
        const float* gf = a.in[I_GFFN] + 8 * g; const float* sc2 = MOD + b * 6144 + 4 * 1024 + 8 * g; const float* sh2 = MOD + b * 6144 + 3 * 1024 + 8 * g;
        for (int s = 0; s < 32; ++s) {
            const f32x4 x0 = *(const f32x4*)(xr + 32 * s), x1 = *(const f32x4*)(xr + 32 * s + 4);
            const f32x4 g0 = *(const f32x4*)(gf + 32 * s), g1 = *(const f32x4*)(gf + 32 * s + 4), c0 = *(const f32x4*)(sc2 + 32 * s), c1 = *(const f32x4*)(sc2 + 32 * s + 4);
            const f32x4 h0 = x0 * rstd * g0 * (c0 + 1.0f) + *(const f32x4*)(sh2 + 32 * s), h1 = x1 * rstd * g1 * (c1 + 1.0f) + *(const f32x4*)(sh2 + 32 * s + 4);
            u32x4 hi; hi.x = pk2(h0[0], h0[1]); hi.y = pk2(h0[2], h0[3]); hi.z = pk2(h1[0], h1[1]); hi.w = pk2(h1[2], h1[3]);
            *(u32x4*)(H2 + (size_t)row * D + 32 * s + 8 * g) = hi;
            float hf[8]; unpack8(hi, hf);
            u32x4 lo; lo.x = pk2(h0[0] - hf[0], h0[1] - hf[1]); lo.y = pk2(h0[2] - hf[2], h0[3] - hf[3]); lo.z = pk2(h1[0] - hf[4], h1[1] - hf[5]); lo.w = pk2(h1[2] - hf[6], h1[3] - hf[7]);
            const bf16x8 Ah = __builtin_bit_cast(bf16x8, hi), Al = __builtin_bit_cast(bf16x8, lo);
            const int kc = 4 * s + g;
            const bf16x8 Bh0 = *(const LAS bf16x8*)(lds + rr * 2048 + ((kc ^ rr) << 4)), Bh1 = *(const LAS bf16x8*)(lds + (16 + rr) * 2048 + ((kc ^ rr) << 4));
            const bf16x8 Bl0 = *(const LAS bf16x8*)(lds + 65536 + rr * 2048 + ((kc ^ rr) << 4)), Bl1 = *(const LAS bf16x8*)(lds + 65536 + (16 + rr) * 2048 + ((kc ^ rr) << 4));
            acc0 = __builtin_amdgcn_mfma_f32_16x16x32_bf16(Ah, Bh0, acc0, 0, 0, 0); acc0 = __builtin_amdgcn_mfma_f32_16x16x32_bf16(Al, Bh0, acc0, 0, 0, 0); acc0 = __builtin_amdgcn_mfma_f32_16x16x32_bf16(Ah, Bl0, acc0, 0, 0, 0);
            acc1 = __builtin_amdgcn_mfma_f32_16x16x32_bf16(Ah, Bh1, acc1, 0, 0, 0); acc1 = __builtin_amdgcn_mfma_f32_16x16x32_bf16(Al, Bh1, acc1, 0, 0, 0); acc1 = __builtin_amdgcn_mfma_f32_16x16x32_bf16(Ah, Bl1, acc1, 0, 0, 0);
        }
        const float br0 = a.in[I_BR][rr], br1 = a.in[I_BR][16 + rr];
#pragma unroll
        for (int reg = 0; reg < 4; ++reg) {
            float v0 = acc0[reg] + br0, v1 = acc1[reg] + br1; float tv[4]; int ti[4];
#pragma unroll
            for (int k = 0; k < 4; ++k) {
                float bv = v0; int bi = rr; if (v1 > bv) { bv = v1; bi = 16 + rr; }
#pragma unroll
                for (int o = 1; o < 16; o <<= 1) { const float ov = __shfl_xor(bv, o); const int oi = __shfl_xor(bi, o); if (ov > bv || (ov == bv && oi < bi)) { bv = ov; bi = oi; } }
                tv[k] = bv; ti[k] = bi; if (bi == rr) v0 = -INFINITY; if (bi == 16 + rr) v1 = -INFINITY;
            }
            if (rr == 0) { const int t = r0 + 4 * g + reg;
                const float e1 = __expf(tv[1] - tv[0]), e2 = __expf(tv[2] - tv[0]), e3 = __expf(tv[3] - tv[0]), inv = 1.0f / (1.0f + e1 + e2 + e3);
                *(f32x4*)(TKW + (size_t)t * 4) = (f32x4){inv, e1 * inv, e2 * inv, e3 * inv};
                int rk[4];
#pragma unroll
                for (int k = 0; k < 4; ++k) rk[k] = __hip_atomic_fetch_add(cnt + ti[k], 1, __ATOMIC_RELAXED, __HIP_MEMORY_SCOPE_WORKGROUP);
                *(u32x4*)(TKI + (size_t)t * 4) = (u32x4){(unsigned)ti[0], (unsigned)ti[1], (unsigned)ti[2], (unsigned)ti[3]};
                *(u32x4*)(RANK + (size_t)t * 4) = (u32x4){(unsigned)rk[0], (unsigned)rk[1], (unsigned)rk[2], (unsigned)rk[3]}; }
        }
        __syncthreads();
        if (tid < 32) COUNTS[(rb >> 7) * 32 + tid] = cnt[tid];
        __syncthreads();
    }
}

__device__ __forceinline__ void p8_scatter(const Args& a, LAS unsigned char* lds, int vcu, int G) {
    const int tid = threadIdx.x, lane = tid & 63, wave = tid >> 6;
    const int* COUNTS = (const int*)(a.ws + WS_COUNTS); const int* TKI = (const int*)(a.ws + WS_TKI); const float* TKW = (const float*)(a.ws + WS_TKW); const int* RANK = (const int*)(a.ws + WS_RANK);
    int* SLOTROW = (int*)(a.ws + WS_SLOTROW); float* ROWW = (float*)(a.ws + WS_ROWW); int* TILEE = (int*)(a.ws + WS_TILEE);
    const bf16_t* H2 = (const bf16_t*)(a.ws + WS_S0); bf16_t* XS = (bf16_t*)(a.ws + WS_XS);
    LAS int* ptot = (LAS int*)lds;
    LAS int* pbef = ptot + 512;
    LAS int* base = pbef + 512;
    for (int rb = vcu * 128; rb < T; rb += G * 128) {
        const int blk = rb >> 7;
        __syncthreads();
        { const int e = tid & 31, pt = tid >> 5; int st = 0, sb = 0;
            for (int bb = pt * 16; bb < pt * 16 + 16; ++bb) { const int cv = COUNTS[bb * 32 + e]; st += cv; if (bb < blk) sb += cv; }
            ptot[pt * 32 + e] = st; pbef[pt * 32 + e] = sb; }
        __syncthreads();
        if (tid == 0) { int ps = 0;
            for (int e = 0; e < 32; ++e) { int tot = 0, bef = 0;
                for (int pt = 0; pt < 16; ++pt) { tot += ptot[pt * 32 + e]; bef += pbef[pt * 32 + e]; }
                base[e] = ps + bef;
                const int ntl = (tot + 255) >> 8;
                if (blk == 0) { for (int q = 0; q < ntl; ++q) TILEE[(ps >> 8) + q] = e; }
                ps += ntl << 8; }
            if (blk == 0) TILEE[1023] = ps >> 8; }
        __syncthreads();
        for (int sidx = wave; sidx < 512; sidx += 8) { const int t = rb + (sidx >> 2), k = sidx & 3;
            const int e = TKI[(size_t)t * 4 + k], dest = base[e] + RANK[(size_t)t * 4 + k];
            if (lane == 0) { SLOTROW[(size_t)t * 4 + k] = dest; ROWW[dest] = TKW[(size_t)t * 4 + k]; }
            const u32x4* src = (const u32x4*)(H2 + (size_t)t * D); u32x4* dst = (u32x4*)(XS + (size_t)dest * D);
            dst[lane] = src[lane]; dst[64 + lane] = src[64 + lane]; }
    }
    __syncthreads();
}

__device__ __forceinline__ void p11_final(const Args& a, int vcu, int G) {
    const int tid = threadIdx.x, lane = tid & 63, wave = tid >> 6;
    const float* MOD = (const float*)(a.ws + WS_MOD); const float* FMOD = (const float*)(a.ws + WS_FMOD); const int* SLOTROW = (const int*)(a.ws + WS_SLOTROW);
    const bf16_t* Y = (const bf16_t*)(a.ws + WS_XS); float* OUT = a.out;
    for (int rb = vcu * 128; rb < T; rb += G * 128) {
        const int b = rb >> 12;
        f32x4 g2[4], gs[4], sh[4];
#pragma unroll
        for (int j = 0; j < 4; ++j) { const int c = 4 * lane + 256 * j; g2[j] = *(const f32x4*)(MOD + b * 6144 + 5 * 1024 + c);
            gs[j] = *(const f32x4*)(a.in[I_GFIN] + c) * (*(const f32x4*)(FMOD + b * 2048 + 1024 + c) + 1.0f); sh[j] = *(const f32x4*)(FMOD + b * 2048 + c); }
        for (int i = 0; i < 16; ++i) { const int t = rb + wave * 16 + i; const u32x4 sr = *(const u32x4*)(SLOTROW + (size_t)t * 4);
            f32x4* xr = (f32x4*)(OUT + (size_t)t * D) + lane; f32x4 v[4]; float s = 0.f;
#pragma unroll
            for (int j = 0; j < 4; ++j) { f32x4 mo = (f32x4){0.f, 0.f, 0.f, 0.f};
#pragma unroll
                for (int k = 0; k < 4; ++k) { const u32x2 w = *((const u32x2*)(Y + (size_t)sr[k] * D) + lane + 64 * j); mo[0] += bflo(w.x); mo[1] += bfhi(w.x); mo[2] += bflo(w.y); mo[3] += bfhi(w.y); }
                v[j] = xr[64 * j] + g2[j] * mo; s += (v[j][0] * v[j][0] + v[j][1] * v[j][1]) + (v[j][2] * v[j][2] + v[j][3] * v[j][3]); }
            const float rstd = rsqrtf(wave_sum(s) * (1.0f / D) + EPS);
#pragma unroll
            for (int j = 0; j < 4; ++j) xr[64 * j] = v[j] * rstd * gs[j] + sh[j]; }
    }
}

__global__ void __launch_bounds__(NTHREADS, 2) mk_fwd(Args a) {
    extern __shared__ __attribute__((aligned(16))) unsigned char lds_raw[];
    LAS unsigned char* lds = (LAS unsigned char*)lds_raw;
    const int G = gridDim.x, bx = blockIdx.x; const int vcu = (G % 8 == 0) ? (bx % 8) * (G / 8) + bx / 8 : bx;
    unsigned char* ws = a.ws;
    const int lo = a.ph_lo, hi = a.ph_hi;
#ifndef PHASE_MASK
#define PHASE_MASK 0xFFF
#endif
#define IN(k) ((((PHASE_MASK) >> (k)) & 1) && lo <= (k) && (k) < hi)
#if ONE_LAUNCH
#define SEAM(k) do { if (IN(k) && IN((k) + 1)) cg::this_grid().sync(); } while (0)
#else
#define SEAM(k) do { } while (0)
#endif
    if (IN(0)) { p0_prep(a, lds, vcu, G); } SEAM(0);
    if (IN(1)) { p1_hb(a, vcu, G); } SEAM(1);
    if (IN(2)) {
        Gemm g{(const bf16_t*)(ws + WS_S0), (const bf16_t*)(ws + WS_WIN), D, D, D}; DenseSched S; S.init(T / 256, INP / 256, G, bx, D, D, 0);
        EpiIn E{(bf16_t*)(ws + WS_S1), (bf16_t*)(ws + WS_QLAT), (bf16_t*)(ws + WS_KVLAT), (bf16_t*)(ws + WS_KPE), (bf16_t*)(ws + WS_GATES), (float*)(ws + WS_PSQQ), (float*)(ws + WS_PSQKV), a.in[I_BGATE], (const f32x2*)(ws + WS_CS)};
        gemm_phase(lds, g, S, E);
    } SEAM(2);
    if (IN(3)) {
        p3_mixed(a, vcu, G);
        { Gemm g{(const bf16_t*)(ws + WS_QLAT), (const bf16_t*)(ws + WS_WQ), QL, QL, QL}; DenseSched S; S.init(T / 256, 6, G, bx, QL, QL, 0);
            EpiQ E{(bf16_t*)(ws + WS_Q), (const float*)(ws + WS_PSQQ), (const f32x2*)(ws + WS_CS)}; gemm_phase(lds, g, S, E); }
        { Gemm g{(const bf16_t*)(ws + WS_KVLAT), (const bf16_t*)(ws + WS_WK), KVL, KVL, KVL}; DenseSched S; S.init(T / 256, 4, G, bx, KVL, KVL, 0);
            EpiK E{(bf16_t*)(ws + WS_KN), (const float*)(ws + WS_PSQKV)}; gemm_phase(lds, g, S, E); }
        { Gemm g{(const bf16_t*)(ws + WS_WV), (const bf16_t*)(ws + WS_KVLAT), KVL, KVL, KVL}; DenseSched S; S.init(4, T / 256, G, bx, KVL, KVL, 0);
            EpiVT E{(bf16_t*)(ws + WS_VT), (const float*)(ws + WS_PSQKV)}; gemm_phase(lds, g, S, E); }
    } SEAM(3);
    if (IN(4)) {
        attn_naive(a, lds, vcu, G);
        { Gemm g{(const bf16_t*)(ws + WS_S0), (const bf16_t*)(ws + WS_WGRP), D, 256, 256}; DenseSched S; S.init(T / 256, 4, G, bx, D, 256, 512u);
            EpiPlain E{(bf16_t*)(ws + WS_S1), D}; gemm_phase(lds, g, S, E); }
    } SEAM(4);
    if (IN(5)) {
        DenseSched S; S.init(T / 256, 4, G, bx, D, D, 0);
        { Gemm g{(const bf16_t*)(ws + WS_S1), (const bf16_t*)(ws + WS_WPO), D, D, D}; EpiMerge<0> E{(bf16_t*)(ws + WS_S0), (const bf16_t*)(ws + WS_GATES)}; gemm_phase(lds, g, S, E); }
        { Gemm g{(const bf16_t*)(ws + WS_O), (const bf16_t*)(ws + WS_WMO), D, D, D}; EpiMerge<1> E{(bf16_t*)(ws + WS_S0), (const bf16_t*)(ws + WS_GATES)}; gemm_phase(lds, g, S, E); }
    } SEAM(5);
    if (IN(6)) {
        Gemm g{(const bf16_t*)(ws + WS_S0), (const bf16_t*)(ws + WS_WOUT), D, D, D}; DenseSched S; S.init(T / 256, 4, G, bx, D, D, 0);
        EpiOut E{a.in[I_X], a.out, (const float*)(ws + WS_MOD)}; gemm_phase(lds, g, S, E);
    } SEAM(6);
    if (IN(7)) { p7_router(a, lds, vcu, G); } SEAM(7);
    if (IN(8)) { p8_scatter(a, lds, vcu, G); } SEAM(8);
    if (IN(9)) {
        Gemm g{(const bf16_t*)(ws + WS_XS), (const bf16_t*)(ws + WS_WGU), D, D, D}; MoeSched S; S.init((const int*)(ws + WS_TILEE), 8, G, bx, D, D);
        EpiGU E{(bf16_t*)(ws + WS_ACT), a.in[I_BGU]}; gemm_phase(lds, g, S, E);
    } SEAM(9);
    if (IN(10)) {
        Gemm g{(const bf16_t*)(ws + WS_ACT), (const bf16_t*)(ws + WS_WDN), D, D, D}; MoeSched S; S.init((const int*)(ws + WS_TILEE), 4, G, bx, D, D);
        EpiDown E{(bf16_t*)(ws + WS_XS), a.in[I_BDN], (const float*)(ws + WS_ROWW)}; gemm_phase(lds, g, S, E);
    } SEAM(10);
    if (IN(11)) { p11_final(a, vcu, G); }
#undef IN
#undef SEAM
}

constexpr int NPHASES = 12;
extern "C" void kernel_launch(void* const* d_in, const int* in_sizes, int n_in, void* d_out, int out_size, void* d_ws, size_t ws_size, hipStream_t stream) {
    static int grid = 0;
    if (grid == 0) {
        if (n_in != 27 || out_size != T * D || ws_size < WS_END) { fprintf(stderr, "kernel_launch: unexpected problem (n_in %d out %d ws %zu)\n", n_in, out_size, ws_size); grid = -1; return; }
        int dev = 0, cus = 0, per_cu = 0;
        hipGetDevice(&dev); hipDeviceGetAttribute(&cus, hipDeviceAttributeMultiprocessorCount, dev);
        hipFuncSetAttribute((const void*)mk_fwd, hipFuncAttributeMaxDynamicSharedMemorySize, LDS_BYTES);
        hipOccupancyMaxActiveBlocksPerMultiprocessor(&per_cu, (const void*)mk_fwd, NTHREADS, LDS_BYTES);
        (void)hipGetLastError();
        if (per_cu < 1) { fprintf(stderr, "kernel_launch: occupancy query says %d blocks per CU\n", per_cu); per_cu = 1; }
        grid = cus;
    }
    if (grid < 0) return;
    Args a{};
    for (int i = 0; i < 27; ++i) a.in[i] = (const float*)d_in[i];
    a.out = (float*)d_out; a.ws = (unsigned char*)d_ws;
#if ONE_LAUNCH
    a.ph_lo = 0; a.ph_hi = NPHASES;
    void* args[] = {&a};
    hipError_t e = hipLaunchCooperativeKernel((const void*)mk_fwd, dim3(grid), dim3(NTHREADS), args, LDS_BYTES, stream);
    if (e != hipSuccess) fprintf(stderr, "cooperative launch failed: %s (grid %d)\n", hipGetErrorString(e), grid);
#else
    for (int p = 0; p < NPHASES; ++p) { a.ph_lo = p; a.ph_hi = p + 1; hipLaunchKernelGGL(mk_fwd, dim3(grid), dim3(NTHREADS), LDS_BYTES, stream, a); }
#endif
}
```

```cpp
#include <hip/hip_runtime.h>
#include <hip/hip_cooperative_groups.h>
#include <cstdio>
#include <cstdint>
namespace cg = cooperative_groups;

#ifndef ONE_LAUNCH
#define ONE_LAUNCH 1
#endif
#ifndef FAST_GEMM
#define FAST_GEMM 0
#endif
#ifndef FAST_ATTN
#define FAST_ATTN 0
#endif

#define LAS __attribute__((address_space(3)))
typedef unsigned short bf16_t;
typedef short bf16x8 __attribute__((ext_vector_type(8)));
typedef float f32x4 __attribute__((ext_vector_type(4)));
typedef float f32x2 __attribute__((ext_vector_type(2)));
typedef unsigned u32x4 __attribute__((ext_vector_type(4)));
typedef unsigned u32x2 __attribute__((ext_vector_type(2)));
typedef __bf16 bf16x2_t __attribute__((ext_vector_type(2)));

constexpr int D = 1024, NB = 8, SEQ = 4096, T = NB * SEQ;
constexpr int QL = 768, KVL = 256, ROPE = 64, NH = 8, NOPE = 128, VH = 128, QKD = NOPE + ROPE;
constexpr int IN_W = 4160, INP = 4352;
constexpr int NE = 32, TOPK = 4, DE = 1024;
constexpr int NSLOT = T * TOPK;
constexpr int RT_MAX = 543;
constexpr float EPS = 1e-6f;
constexpr float QSCALE = 0.07216878364870322f * 1.4426950408889634f;

constexpr size_t MiB = 1u << 20;
constexpr size_t WS_MOD = 1 * MiB;
constexpr size_t WS_FMOD = 1 * MiB + 256 * 1024;
constexpr size_t WS_CS = 2 * MiB;
constexpr size_t WS_PSQQ = 10 * MiB;
constexpr size_t WS_PSQKV = 12 * MiB;
constexpr size_t WS_TKI = 13 * MiB;
constexpr size_t WS_TKW = 13 * MiB + 512 * 1024;
constexpr size_t WS_RANK = 14 * MiB;
constexpr size_t WS_SLOTROW = 14 * MiB + 512 * 1024;
constexpr size_t WS_COUNTS = 15 * MiB;
constexpr size_t WS_ROWW = 16 * MiB;
constexpr size_t WS_TILEE = 17 * MiB;
constexpr size_t WS_WR = 18 * MiB;
constexpr size_t WS_WIN = 32 * MiB;
constexpr size_t WS_WQ = 41 * MiB;
constexpr size_t WS_WK = 44 * MiB;
constexpr size_t WS_WV = 45 * MiB;
constexpr size_t WS_WGRP = 46 * MiB;
constexpr size_t WS_WPO = 47 * MiB;
constexpr size_t WS_WMO = 49 * MiB;
constexpr size_t WS_WOUT = 51 * MiB;
constexpr size_t WS_WGU = 54 * MiB;
constexpr size_t WS_WDN = 182 * MiB;
constexpr size_t WS_S0 = 256 * MiB;
constexpr size_t WS_S1 = 320 * MiB;
constexpr size_t WS_QLAT = 384 * MiB;
constexpr size_t WS_KVLAT = 432 * MiB;
constexpr size_t WS_KPE = 448 * MiB;
constexpr size_t WS_GATES = 452 * MiB;
constexpr size_t WS_Q = 580 * MiB;
constexpr size_t WS_KN = 676 * MiB;
constexpr size_t WS_VT = 740 * MiB;
constexpr size_t WS_O = 804 * MiB;
constexpr size_t WS_XS = 320 * MiB;
constexpr size_t WS_ACT = 592 * MiB;
constexpr size_t WS_END = 864 * MiB;

constexpr int LDS_BYTES = 147456;
constexpr int NTHREADS = 512;

__device__ __forceinline__ unsigned pk2(float lo, float hi) { f32x2 v = {lo, hi}; bf16x2_t b = __builtin_convertvector(v, bf16x2_t); return __builtin_bit_cast(unsigned, b); }
__device__ __forceinline__ float bflo(unsigned u) { return __uint_as_float(u << 16); }
__device__ __forceinline__ float bfhi(unsigned u) { return __uint_as_float(u & 0xffff0000u); }
__device__ __forceinline__ void unpack8(const u32x4 w, float (&f)[8]) { f[0] = bflo(w.x); f[1] = bfhi(w.x); f[2] = bflo(w.y); f[3] = bfhi(w.y); f[4] = bflo(w.z); f[5] = bfhi(w.z); f[6] = bflo(w.w); f[7] = bfhi(w.w); }
__device__ __forceinline__ u32x4 pack8(const float (&f)[8]) { u32x4 w; w.x = pk2(f[0], f[1]); w.y = pk2(f[2], f[3]); w.z = pk2(f[4], f[5]); w.w = pk2(f[6], f[7]); return w; }
__device__ __forceinline__ float wave_sum(float v) {
#pragma unroll
    for (int o = 1; o < 64; o <<= 1) v += __shfl_xor(v, o);
    return v;
}
__device__ __forceinline__ float sigmoidf_(float x) { return 1.0f / (1.0f + __expf(-x)); }

struct Args {
    const float* in[27]; float* out; unsigned char* ws; int ph_lo, ph_hi;
};
enum { I_X = 0, I_C, I_POS, I_WMOD, I_BMOD, I_GMIX, I_WIN, I_BGATE, I_WPG, I_PSCALE, I_WPO, I_GQA, I_WQB, I_GKVA, I_WKVB, I_WMO, I_WOUT, I_GFFN, I_WR, I_BR, I_WGU, I_BGU, I_WDN, I_BDN, I_GFIN, I_WFMOD, I_BFMOD };

struct Unit { int pm, pn, e; unsigned ao, bo; };
struct Gemm { const bf16_t* A; const bf16_t* Bt; int lda, ldb, K; };
constexpr int NXCD = 8, WGM = 8;
__host__ __device__ __forceinline__ int perm32(int rho) { const int n = rho >> 4, i = rho & 15; return 8 * (i >> 2) + 4 * n + (i & 3); }

struct DenseSched {
    int nM, nN, nwg, G, c; unsigned a_tile, a_col, b_tile;
    __device__ void init(int nM_, int nN_, int G_, int c_, int lda, int ldb, unsigned a_col_) { nM = nM_; nN = nN_; nwg = nM * nN; G = G_; c = c_; a_tile = 256u * lda * 2u; b_tile = 256u * ldb * 2u; a_col = a_col_; }
    __device__ bool next(int i, Unit& u) const {
        const long L = (long)i * G + c; if (L >= nwg) return false;
        int wgid = (int)L; { const int q = nwg / NXCD, r = nwg % NXCD, xcd = wgid % NXCD, off = wgid / NXCD; wgid = (xcd < r ? xcd * (q + 1) : r * (q + 1) + (xcd - r) * q) + off; }
        const int nig = WGM * nN, gid = wgid / nig, fm = gid * WGM, gsz = (nM - fm) < WGM ? (nM - fm) : WGM;
        u.pm = fm + ((wgid % nig) % gsz); u.pn = (wgid % nig) / gsz; u.e = 0;
        u.ao = (unsigned)u.pm * a_tile + (unsigned)u.pn * a_col; u.bo = (unsigned)u.pn * b_tile; return true;
    }
};
struct MoeSched {
    const int* tile_e; int R, NT, G, c; unsigned a_tile, b_tile;
    __device__ void init(const int* te, int NT_, int G_, int c_, int lda, int ldb) { tile_e = te; R = te[1023]; NT = NT_; G = G_; c = c_; a_tile = 256u * lda * 2u; b_tile = 256u * ldb * 2u; }
    __device__ bool next(int i, Unit& u) const {
        int rt, pn;
        if (G == 256) { const int x = c & 7, j = c >> 3, rpr = 256 / NT, pxc = rpr / 8; rt = i * rpr + x * pxc + j / NT; pn = j % NT; }
        else { const long L = (long)i * G + c; rt = (int)(L / NT); pn = (int)(L % NT); }
        if (rt >= R) return false;
        const int e = tile_e[rt];
        u.pm = rt; u.pn = pn; u.e = e; u.ao = (unsigned)rt * a_tile; u.bo = (unsigned)(e * NT + pn) * b_tile; return true;
    }
};

template <class Epi>
__device__ __forceinline__ void run_epi(const Epi& E, const f32x4 (&acc)[2][2][4][2], const Unit& u, int wr, int wc, int fr, int fq) {
    typename Epi::ColCtx cc[2];
#pragma unroll
    for (int bj = 0; bj < 2; ++bj) cc[bj] = E.col_ctx(u, bj * 128 + wc * 32 + 8 * fq);
    asm volatile("" ::: "memory");
    const bool wp = Epi::SUMSQ && E.want_partial(u);
#pragma unroll
    for (int ai = 0; ai < 2; ++ai)
#pragma unroll
        for (int m = 0; m < 4; ++m) {
            const int row = u.pm * 256 + ai * 128 + wr * 64 + m * 16 + fr;
            const float rc = E.row_ctx(u, row); float part = 0.f;
#pragma unroll
            for (int bj = 0; bj < 2; ++bj) {
                float v[8];
#pragma unroll
                for (int j = 0; j < 4; ++j) { v[j] = acc[ai][bj][m][0][j]; v[4 + j] = acc[ai][bj][m][1][j]; }
                part += E.apply(u, row, bj * 128 + wc * 32 + 8 * fq, v, rc, cc[bj]);
            }
            if constexpr (Epi::SUMSQ) { if (wp) { float s = part; s += __shfl_xor(s, 16); s += __shfl_xor(s, 32); if (fq == 0) E.partial(u, row, wc, s); } }
            asm volatile("" ::: "memory");
        }
}

template <class Epi, class Sched>
__device__ __forceinline__ void gemm_simple(LAS unsigned char* lds, const Gemm g, const Sched& S, const Epi& E) {
    const int tid = threadIdx.x, wid = __builtin_amdgcn_readfirstlane(tid >> 6), lane = tid & 63, wr = wid >> 2, wc = wid & 3, fr = lane & 15, fq = lane >> 4;
    const int nt = g.K / 64;
    Unit u;
    for (int ui = 0; S.next(ui, u); ++ui) {
        f32x4 acc[2][2][4][2];
#pragma unroll
        for (int a = 0; a < 2; ++a)
#pragma unroll
            for (int b = 0; b < 2; ++b)
#pragma unroll
                for (int m = 0; m < 4; ++m)
#pragma unroll
                    for (int n = 0; n < 2; ++n) acc[a][b][m][n] = (f32x4){0.f, 0.f, 0.f, 0.f};
        const char* cA = (const char*)g.A + u.ao; const char* cB = (const char*)g.Bt + u.bo;
#pragma unroll 1
        for (int kt = 0; kt < nt; ++kt) {
            __syncthreads();
#pragma unroll
            for (int i = 0; i < 4; ++i) { const int c = tid + 512 * i, row = c >> 3, kc = c & 7, rb = (row & ~31) + perm32(row & 31);
                const u32x4 va = *(const u32x4*)(cA + (size_t)row * g.lda * 2 + kt * 128 + kc * 16);
                const u32x4 vb = *(const u32x4*)(cB + (size_t)rb * g.ldb * 2 + kt * 128 + kc * 16);
                *(LAS u32x4*)(lds + row * 144 + kc * 16) = va; *(LAS u32x4*)(lds + 36864 + row * 144 + kc * 16) = vb; }
            __syncthreads();
#pragma unroll
            for (int k = 0; k < 2; ++k) {
                bf16x8 Af[2][4], Bf[2][2];
#pragma unroll
                for (int ai = 0; ai < 2; ++ai)
#pragma unroll
                    for (int m = 0; m < 4; ++m) Af[ai][m] = *(const LAS bf16x8*)(lds + (ai * 128 + wr * 64 + m * 16 + fr) * 144 + (k * 32 + fq * 8) * 2);
#pragma unroll
                for (int bj = 0; bj < 2; ++bj)
#pragma unroll
                    for (int n = 0; n < 2; ++n) Bf[bj][n] = *(const LAS bf16x8*)(lds + 36864 + (bj * 128 + wc * 32 + n * 16 + fr) * 144 + (k * 32 + fq * 8) * 2);
#pragma unroll
                for (int ai = 0; ai < 2; ++ai)
#pragma unroll
                    for (int bj = 0; bj < 2; ++bj)
#pragma unroll
                        for (int m = 0; m < 4; ++m)
#pragma unroll
                            for (int n = 0; n < 2; ++n) acc[ai][bj][m][n] = __builtin_amdgcn_mfma_f32_16x16x32_bf16(Bf[bj][n], Af[ai][m], acc[ai][bj][m][n], 0, 0, 0);
            }
        }
        run_epi(E, acc, u, wr, wc, fr, fq);
    }
    __syncthreads();
}

template <class Epi, class Sched>
__device__ __forceinline__ void gemm_phase(LAS unsigned char* lds, const Gemm g, const Sched& S, const Epi& E) {
    gemm_simple<Epi, Sched>(lds, g, S, E);
}

struct NoCtx {};
struct EpiIn {
    static constexpr bool SUMSQ = true; typedef NoCtx ColCtx;
    bf16_t *U, *QLp, *KVLp, *KPE, *GATES; float *PSQQ, *PSQKV; const float* bgate; const f32x2* CS;
    __device__ __forceinline__ float row_ctx(const Unit&, int) const { return 0.f; }
    __device__ __forceinline__ NoCtx col_ctx(const Unit&, int) const { return NoCtx{}; }
    __device__ __forceinline__ bool want_partial(const Unit& u) const { return u.pn >= 4 && u.pn < 8; }
    __device__ __forceinline__ void partial(const Unit& u, int row, int wc, float s) const {
        if (u.pn < 7) PSQQ[(size_t)row * 12 + (u.pn - 4) * 4 + wc] = s; else PSQKV[(size_t)row * 4 + wc] = s; }
    __device__ __forceinline__ float apply(const Unit& u, int row, int col, float (&v)[8], float, NoCtx) const {
        const int pn = u.pn;
        if (pn < 4) { *(u32x4*)(U + (size_t)row * D + pn * 256 + col) = pack8(v); return 0.f; }
        if (pn < 8) {
            float s = 0.f;
#pragma unroll
            for (int j = 0; j < 8; ++j) s += v[j] * v[j];
            if (pn < 7) *(u32x4*)(QLp + (size_t)row * QL + (pn - 4) * 256 + col) = pack8(v);
            else *(u32x4*)(KVLp + (size_t)row * KVL + col) = pack8(v);
            return s;
        }
        if (pn < 16) {
            const int gc = (pn - 8) * 256 + col; const f32x4 b0 = *(const f32x4*)(bgate + gc), b1 = *(const f32x4*)(bgate + gc + 4);
            float o[8];
#pragma unroll
            for (int j = 0; j < 4; ++j) { o[j] = sigmoidf_(v[j] + b0[j]); o[4 + j] = sigmoidf_(v[4 + j] + b1[j]); }
            *(u32x4*)(GATES + (size_t)row * 2048 + gc) = pack8(o); return 0.f;
        }
        if (col < 64) {
            const int g = col >> 3; float y1[4], y2[4];
#pragma unroll
            for (int i = 0; i < 4; ++i) { const f32x2 cs = CS[(size_t)row * 32 + 4 * g + i]; y1[i] = v[i] * cs.x - v[4 + i] * cs.y; y2[i] = v[4 + i] * cs.x + v[i] * cs.y; }
            u32x2 a, b; a.x = pk2(y1[0], y1[1]); a.y = pk2(y1[2], y1[3]); b.x = pk2(y2[0], y2[1]); b.y = pk2(y2[2], y2[3]);
            *(u32x2*)(KPE + (size_t)row * 64 + 4 * g) = a; *(u32x2*)(KPE + (size_t)row * 64 + 32 + 4 * g) = b;
        }
        return 0.f;
    }
};
struct EpiQ {
    static constexpr bool SUMSQ = false; typedef NoCtx ColCtx;
    bf16_t* Q; const float* PSQQ; const f32x2* CS;
    __device__ __forceinline__ float row_ctx(const Unit&, int row) const {
        const f32x4* p = (const f32x4*)(PSQQ + (size_t)row * 12); const f32x4 a = p[0], b = p[1], c = p[2];
        const float s = ((a[0] + a[1]) + (a[2] + a[3])) + ((b[0] + b[1]) + (b[2] + b[3])) + ((c[0] + c[1]) + (c[2] + c[3]));
        return rsqrtf(s * (1.0f / QL) + EPS) * QSCALE; }
    __device__ __forceinline__ NoCtx col_ctx(const Unit&, int) const { return NoCtx{}; }
    __device__ __forceinline__ bool want_partial(const Unit&) const { return false; }
    __device__ __forceinline__ void partial(const Unit&, int, int, float) const {}
    __device__ __forceinline__ float apply(const Unit& u, int row, int col, float (&v)[8], float rs, NoCtx) const {
#pragma unroll
        for (int j = 0; j < 8; ++j) v[j] *= rs;
        if (u.pn < 4) { const int p = u.pn * 256 + col, hh = p >> 7, d = p & 127; *(u32x4*)(Q + (size_t)row * (NH * QKD) + hh * QKD + d) = pack8(v); }
        else { const int r = (u.pn - 4) * 256 + col, hh = r >> 6, g = (r & 63) >> 3; float y1[4], y2[4];
#pragma unroll
            for (int i = 0; i < 4; ++i) { const f32x2 cs = CS[(size_t)row * 32 + 4 * g + i]; y1[i] = v[i] * cs.x - v[4 + i] * cs.y; y2[i] = v[4 + i] * cs.x + v[i] * cs.y; }
            u32x2 a, b; a.x = pk2(y1[0], y1[1]); a.y = pk2(y1[2], y1[3]); b.x = pk2(y2[0], y2[1]); b.y = pk2(y2[2], y2[3]);
            bf16_t* q = Q + (size_t)row * (NH * QKD) + hh * QKD + NOPE; *(u32x2*)(q + 4 * g) = a; *(u32x2*)(q + 32 + 4 * g) = b; }
        return 0.f;
    }
};
__device__ __forceinline__ float rstd_kv(const float* PSQKV, int t) { const f32x4 a = *(const f32x4*)(PSQKV + (size_t)t * 4); return rsqrtf(((a[0] + a[1]) + (a[2] + a[3])) * (1.0f / KVL) + EPS); }
struct EpiK {
    static constexpr bool SUMSQ = false; typedef NoCtx ColCtx;
    bf16_t* KN; const float* PSQKV;
    __device__ __forceinline__ float row_ctx(const Unit&, int row) const { return rstd_kv(PSQKV, row); }
    __device__ __forceinline__ NoCtx col_ctx(const Unit&, int) const { return NoCtx{}; }
    __device__ __forceinline__ bool want_partial(const Unit&) const { return false; }
    __device__ __forceinline__ void partial(const Unit&, int, int, float) const {}
    __device__ __forceinline__ float apply(const Unit& u, int row, int col, float (&v)[8], float rs, NoCtx) const {
#pragma unroll
        for (int j = 0; j < 8; ++j) v[j] *= rs;
        *(u32x4*)(KN + (size_t)row * D + u.pn * 256 + col) = pack8(v); return 0.f; }
};
struct Ctx8 { float s[8]; };
struct EpiVT {
    static constexpr bool SUMSQ = false; typedef Ctx8 ColCtx;
    bf16_t* VT; const float* PSQKV;
    __device__ __forceinline__ float row_ctx(const Unit&, int) const { return 0.f; }
    __device__ __forceinline__ Ctx8 col_ctx(const Unit& u, int col) const { Ctx8 c; const int t0 = u.pn * 256 + col;
#pragma unroll
        for (int j = 0; j < 8; ++j) c.s[j] = rstd_kv(PSQKV, t0 + j);
        return c; }
    __device__ __forceinline__ bool want_partial(const Unit&) const { return false; }
    __device__ __forceinline__ void partial(const Unit&, int, int, float) const {}
    __device__ __forceinline__ float apply(const Unit& u, int row, int col, float (&v)[8], float, const Ctx8& cc) const {
#pragma unroll
        for (int j = 0; j < 8; ++j) v[j] *= cc.s[j];
        *(u32x4*)(VT + (size_t)row * T + u.pn * 256 + col) = pack8(v); return 0.f; }
};
struct EpiPlain {
    static constexpr bool SUMSQ = false; typedef NoCtx ColCtx;
    bf16_t* O; int ldc;
    __device__ __forceinline__ float row_ctx(const Unit&, int) const { return 0.f; }
    __device__ __forceinline__ NoCtx col_ctx(const Unit&, int) const { return NoCtx{}; }
    __device__ __forceinline__ bool want_partial(const Unit&) const { return false; }
    __device__ __forceinline__ void partial(const Unit&, int, int, float) const {}
    __device__ __forceinline__ float apply(const Unit& u, int row, int col, float (&v)[8], float, NoCtx) const {
        *(u32x4*)(O + (size_t)row * ldc + u.pn * 256 + col) = pack8(v); return 0.f; }
};
template <int MODE> struct EpiMerge {
    static constexpr bool SUMSQ = false; typedef NoCtx ColCtx;
    bf16_t* MG; const bf16_t* GATES;
    __device__ __forceinline__ float row_ctx(const Unit&, int) const { return 0.f; }
    __device__ __forceinline__ NoCtx col_ctx(const Unit&, int) const { return NoCtx{}; }
    __device__ __forceinline__ bool want_partial(const Unit&) const { return false; }
    __device__ __forceinline__ void partial(const Unit&, int, int, float) const {}
    __device__ __forceinline__ float apply(const Unit& u, int row, int col, float (&v)[8], float, NoCtx) const {
        const int c = u.pn * 256 + col; float g[8]; unpack8(*(const u32x4*)(GATES + (size_t)row * 2048 + MODE * 1024 + c), g);
        bf16_t* p = MG + (size_t)row * D + c;
        if (MODE == 0) {
#pragma unroll
            for (int j = 0; j < 8; ++j) v[j] *= g[j];
        } else {
            unsigned long long* p8 = (unsigned long long*)p;
            const unsigned long long lo = __hip_atomic_load(p8, __ATOMIC_RELAXED, __HIP_MEMORY_SCOPE_AGENT), hi = __hip_atomic_load(p8 + 1, __ATOMIC_RELAXED, __HIP_MEMORY_SCOPE_AGENT);
            u32x4 w; w.x = (unsigned)lo; w.y = (unsigned)(lo >> 32); w.z = (unsigned)hi; w.w = (unsigned)(hi >> 32); float a[8]; unpack8(w, a);
#pragma unroll
            for (int j = 0; j < 8; ++j) v[j] = a[j] + v[j] * g[j];
        }
        *(u32x4*)p = pack8(v); return 0.f; }
};
struct EpiOut {
    static constexpr bool SUMSQ = false; typedef NoCtx ColCtx;
    const float* X; float* X1; const float* MOD;
    __device__ __forceinline__ float row_ctx(const Unit&, int) const { return 0.f; }
    __device__ __forceinline__ NoCtx col_ctx(const Unit&, int) const { return NoCtx{}; }
    __device__ __forceinline__ bool want_partial(const Unit&) const { return false; }
    __device__ __forceinline__ void partial(const Unit&, int, int, float) const {}
    __device__ __forceinline__ float apply(const Unit& u, int row, int col, float (&v)[8], float, NoCtx) const {
        const int c = u.pn * 256 + col, b = row >> 12; const float* g1 = MOD + b * 6144 + 2 * 1024 + c; const float* xr = X + (size_t)row * D + c; float* o = X1 + (size_t)row * D + c;
        const f32x4 g0 = *(const f32x4*)g1, g1v = *(const f32x4*)(g1 + 4), x0 = *(const f32x4*)xr, x1v = *(const f32x4*)(xr + 4);
        f32x4 o0, o1;
#pragma unroll
        for (int j = 0; j < 4; ++j) { o0[j] = x0[j] + g0[j] * v[j]; o1[j] = x1v[j] + g1v[j] * v[4 + j]; }
        *(f32x4*)o = o0; *(f32x4*)(o + 4) = o1; return 0.f; }
};
struct EpiGU {
    static constexpr bool SUMSQ = false; typedef NoCtx ColCtx;
    bf16_t* ACT; const float* bgu;
    __device__ __forceinline__ float row_ctx(const Unit&, int) const { return 0.f; }
    __device__ __forceinline__ NoCtx col_ctx(const Unit&, int) const { return NoCtx{}; }
    __device__ __forceinline__ bool want_partial(const Unit&) const { return false; }
    __device__ __forceinline__ void partial(const Unit&, int, int, float) const {}
    __device__ __forceinline__ float apply(const Unit& u, int row, int col, float (&v)[8], float, NoCtx) const {
        const int p = u.pn * 256 + col; const float* bp = bgu + (size_t)u.e * 2048 + p; const f32x4 b0 = *(const f32x4*)bp, b1 = *(const f32x4*)(bp + 4);
        const float bb[8] = {b0[0], b0[1], b0[2], b0[3], b1[0], b1[1], b1[2], b1[3]}; float a[4];
#pragma unroll
        for (int i = 0; i < 4; ++i) { float gt = v[i] + bb[2 * i], up = v[4 + i] + bb[2 * i + 1]; gt = fminf(gt, 7.0f); up = fminf(fmaxf(up, -7.0f), 7.0f);
            a[i] = (up + 1.0f) * (gt * sigmoidf_(1.702f * gt)); }
        u32x2 w; w.x = pk2(a[0], a[1]); w.y = pk2(a[2], a[3]); *(u32x2*)(ACT + (size_t)row * DE + (p >> 1)) = w; return 0.f; }
};
struct EpiDown {
    static constexpr bool SUMSQ = false; typedef NoCtx ColCtx;
    bf16_t* Y; const float* bdn; const float* ROWW;
    __device__ __forceinline__ float row_ctx(const Unit&, int row) const { return ROWW[row]; }
    __device__ __forceinline__ NoCtx col_ctx(const Unit&, int) const { return NoCtx{}; }
    __device__ __forceinline__ bool want_partial(const Unit&) const { return false; }
    __device__ __forceinline__ void partial(const Unit&, int, int, float) const {}
    __device__ __forceinline__ float apply(const Unit& u, int row, int col, float (&v)[8], float rw, NoCtx) const {
        const int c = u.pn * 256 + col; const float* bp = bdn + (size_t)u.e * D + c; const f32x4 b0 = *(const f32x4*)bp, b1 = *(const f32x4*)(bp + 4);
#pragma unroll
        for (int j = 0; j < 4; ++j) { v[j] = (v[j] + b0[j]) * rw; v[4 + j] = (v[4 + j] + b1[j]) * rw; }
        *(u32x4*)(Y + (size_t)row * D + c) = pack8(v); return 0.f; }
};

__device__ __forceinline__ void tr_item(const float* src, int Nsrc, bf16_t* dst, int K, int kb, int pb, int lb, int perm, bool zero, const float* rs, const float* cs, LAS float* scr, int lane) {
    const int k0 = kb * 64;
#pragma unroll 4
    for (int it = 0; it < 16; ++it) {
        const int kk = 4 * it + (lane >> 4), o4 = 4 * (lane & 15);
        f32x4 v = (f32x4){0.f, 0.f, 0.f, 0.f};
        if (!zero) { v = *(const f32x4*)(src + (size_t)(k0 + kk) * Nsrc + lb + o4);
            if (rs) v *= rs[k0 + kk];
            if (cs) v *= *(const f32x4*)(cs + lb + o4); }
        int ph;
        if (perm == 1) ph = 8 * ((o4 & 31) >> 2) + 4 * (o4 >> 5);
        else if (perm == 2) ph = 8 * (o4 >> 3);
        else ph = o4;
        LAS float* s = scr + kk * 65;
        if (perm == 2) { const int w0 = o4 & 7;
            s[ph + 4 * ((w0 + 0) & 1) + ((w0 + 0) >> 1)] = v[0]; s[ph + 4 * ((w0 + 1) & 1) + ((w0 + 1) >> 1)] = v[1];
            s[ph + 4 * ((w0 + 2) & 1) + ((w0 + 2) >> 1)] = v[2]; s[ph + 4 * ((w0 + 3) & 1) + ((w0 + 3) >> 1)] = v[3]; }
        else { s[ph] = v[0]; s[ph + 1] = v[1]; s[ph + 2] = v[2]; s[ph + 3] = v[3]; }
    }
    asm volatile("s_waitcnt lgkmcnt(0)" ::: "memory");
    const int c = lane & 7;
#pragma unroll
    for (int j = 0; j < 8; ++j) { const int p = (lane >> 3) + 8 * j; const LAS float* s = scr + (8 * c) * 65 + p;
        u32x4 o; o.x = pk2(s[0 * 65], s[1 * 65]); o.y = pk2(s[2 * 65], s[3 * 65]); o.z = pk2(s[4 * 65], s[5 * 65]); o.w = pk2(s[6 * 65], s[7 * 65]);
        *(u32x4*)(dst + (size_t)(pb * 64 + p) * K + k0 + 8 * c) = o; }
    asm volatile("s_waitcnt lgkmcnt(0)" ::: "memory");
}

__device__ __forceinline__ void p0_prep(const Args& a, LAS unsigned char* lds, int vcu, int G) {
    const int tid = threadIdx.x, lane = tid & 63, wave = __builtin_amdgcn_readfirstlane(tid >> 6);
    unsigned char* ws = a.ws;
    for (int item = vcu; item < 128; item += G) {
        LAS float* cact = (LAS float*)lds;
        LAS float* part = (LAS float*)(lds + 32768);
        for (int i = tid; i < 8 * 1024; i += NTHREADS) { const float cv = a.in[I_C][i]; cact[i] = cv / (1.0f + __expf(-cv)); }
        __syncthreads();
        const bool isf = item >= 96; const float* W = isf ? a.in[I_WFMOD] : a.in[I_WMOD]; const int N = isf ? 2048 : 6144, j0 = (isf ? item - 96 : item) * 64;
        float acc[8];
#pragma unroll
        for (int b = 0; b < 8; ++b) acc[b] = 0.f;
        for (int k = wave * 128; k < wave * 128 + 128; ++k) { const float w = W[(size_t)k * N + j0 + lane];
#pragma unroll
            for (int b = 0; b < 8; ++b) acc[b] += cact[b * 1024 + k] * w; }
#pragma unroll
        for (int b = 0; b < 8; ++b) part[(wave * 8 + b) * 64 + lane] = acc[b];
        __syncthreads();
        { const int b = tid >> 6, col = tid & 63; float s = 0.f;
#pragma unroll
            for (int w = 0; w < 8; ++w) s += part[(w * 8 + b) * 64 + col];
            if (isf) ((float*)(ws + WS_FMOD))[b * 2048 + j0 + col] = s + a.in[I_BFMOD][j0 + col];
            else ((float*)(ws + WS_MOD))[b * 6144 + j0 + col] = s + a.in[I_BMOD][j0 + col]; }
        __syncthreads();
    }
    { const int* pos = (const int*)a.in[I_POS]; f32x2* CS = (f32x2*)(ws + WS_CS);
        for (int idx = vcu * NTHREADS + tid; idx < T * 32; idx += G * NTHREADS) { const int t = idx >> 5, i = idx & 31;
            const double invf = exp(-(double)i * (9.210340371976184 / 32.0));
            const double ang = (double)pos[t] * invf; const double n = rint(ang * 0.15915494309189535); const float r = (float)(ang - n * 6.283185307179586);
            CS[idx] = (f32x2){__cosf(r), __sinf(r)}; } }
    { bf16_t* WR = (bf16_t*)(ws + WS_WR);
        for (int idx = vcu * NTHREADS + tid; idx < 1024 * 32; idx += G * NTHREADS) { const int e = idx & 31, k = idx >> 5; const float v = a.in[I_WR][idx];
            const unsigned h = pk2(v, 0.f) & 0xffffu; const float lo = v - bflo(h); WR[e * 1024 + k] = (bf16_t)h; WR[32768 + e * 1024 + k] = (bf16_t)(pk2(lo, 0.f) & 0xffffu); } }
    LAS float* scr = (LAS float*)(lds + wave * 16640);
    const int gw = vcu * 8 + wave, NGW = G * 8;
    constexpr int N_IN = 16 * 68, N_Q = 12 * 24, N_K = 4 * 16, N_V = 4 * 16, N_G = 4 * 16, N_SQ = 16 * 16, N_GU = 32 * 16 * 32, N_DN = 32 * 16 * 16;
    constexpr int NITEMS = N_IN + N_Q + N_K + N_V + N_G + 3 * N_SQ + N_GU + N_DN;
    for (int it = gw; it < NITEMS; it += NGW) {
        int r = it;
        if (r < N_IN) { const int pb = r % 68, kb = r / 68; int lb, perm = 0; bool zero = false;
            if (pb < 32) lb = pb * 64; else if (pb < 64) lb = pb * 64 + 64; else if (pb == 64) { lb = 2048; perm = 1; } else { lb = 0; zero = true; }
            tr_item(a.in[I_WIN], IN_W, (bf16_t*)(ws + WS_WIN), 1024, kb, pb, lb, perm, zero, nullptr, nullptr, scr, lane); continue; } r -= N_IN;
        if (r < N_Q) { const int pb = r % 24, kb = r / 24; int lb, perm = 0;
            if (pb < 16) lb = (pb >> 1) * QKD + (pb & 1) * 64; else { lb = (pb - 16) * QKD + NOPE; perm = 1; }
            tr_item(a.in[I_WQB], NH * QKD, (bf16_t*)(ws + WS_WQ), QL, kb, pb, lb, perm, false, a.in[I_GQA], nullptr, scr, lane); continue; } r -= N_Q;
        if (r < N_K) { const int pb = r % 16, kb = r / 16; const int lb = (pb >> 1) * 256 + (pb & 1) * 64;
            tr_item(a.in[I_WKVB], NH * 256, (bf16_t*)(ws + WS_WK), KVL, kb, pb, lb, 0, false, a.in[I_GKVA], nullptr, scr, lane); continue; } r -= N_K;
        if (r < N_V) { const int pb = r % 16, kb = r / 16; const int lb = (pb >> 1) * 256 + 128 + (pb & 1) * 64;
            tr_item(a.in[I_WKVB], NH * 256, (bf16_t*)(ws + WS_WV), KVL, kb, pb, lb, 0, false, a.in[I_GKVA], nullptr, scr, lane); continue; } r -= N_V;
        if (r < N_G) { const int g = r / 16, q = r % 16, pb = q % 4, kb = q / 4;
            tr_item(a.in[I_WPG] + (size_t)g * 65536, 256, (bf16_t*)(ws + WS_WGRP) + (size_t)g * 65536, 256, kb, pb, pb * 64, 0, false, nullptr, a.in[I_PSCALE] + g * 256, scr, lane); continue; } r -= N_G;
        if (r < 3 * N_SQ) { const int which = r / N_SQ, q = r % N_SQ, pb = q % 16, kb = q / 16;
            const float* src = which == 0 ? a.in[I_WPO] : which == 1 ? a.in[I_WMO] : a.in[I_WOUT]; const size_t off = which == 0 ? WS_WPO : which == 1 ? WS_WMO : WS_WOUT;
            tr_item(src, 1024, (bf16_t*)(ws + off), 1024, kb, pb, pb * 64, 0, false, nullptr, nullptr, scr, lane); continue; } r -= 3 * N_SQ;
        if (r < N_GU) { const int e = r / 512, q = r % 512, pb = q % 32, kb = q / 32;
            tr_item(a.in[I_WGU] + (size_t)e * 1024 * 2048, 2048, (bf16_t*)(ws + WS_WGU) + (size_t)e * 2048 * 1024, 1024, kb, pb, pb * 64, 2, false, nullptr, nullptr, scr, lane); continue; } r -= N_GU;
        { const int e = r / 256, q = r % 256, pb = q % 16, kb = q / 16;
            tr_item(a.in[I_WDN] + (size_t)e * 1024 * 1024, 1024, (bf16_t*)(ws + WS_WDN) + (size_t)e * 1024 * 1024, 1024, kb, pb, pb * 64, 0, false, nullptr, nullptr, scr, lane); }
    }
}

__device__ __forceinline__ void p1_hb(const Args& a, int vcu, int G) {
    const int tid = threadIdx.x, lane = tid & 63, wave = tid >> 6;
    const float* MOD = (const float*)(a.ws + WS_MOD); bf16_t* HB = (bf16_t*)(a.ws + WS_S0);
    for (int rb = vcu * 128; rb < T; rb += G * 128) {
        const int b = rb >> 12;
        f32x4 gs[4], sh[4];
#pragma unroll
        for (int j = 0; j < 4; ++j) { const int c = 4 * lane + 256 * j; const f32x4 g = *(const f32x4*)(a.in[I_GMIX] + c), sc = *(const f32x4*)(MOD + b * 6144 + 1024 + c);
            gs[j] = g * (sc + 1.0f); sh[j] = *(const f32x4*)(MOD + b * 6144 + c); }
        for (int i = 0; i < 16; ++i) { const int r = rb + wave * 16 + i; const f32x4* xr = (const f32x4*)(a.in[I_X] + (size_t)r * D) + lane;
            f32x4 v[4]; float s = 0.f;
#pragma unroll
            for (int j = 0; j < 4; ++j) { v[j] = xr[64 * j]; s += (v[j][0] * v[j][0] + v[j][1] * v[j][1]) + (v[j][2] * v[j][2] + v[j][3] * v[j][3]); }
            const float rstd = rsqrtf(wave_sum(s) * (1.0f / D) + EPS);
            u32x2* o = (u32x2*)(HB + (size_t)r * D) + lane;
#pragma unroll
            for (int j = 0; j < 4; ++j) { const f32x4 h = v[j] * rstd * gs[j] + sh[j]; u32x2 w; w.x = pk2(h[0], h[1]); w.y = pk2(h[2], h[3]); o[64 * j] = w; } }
    }
}

__device__ __forceinline__ void p3_mixed(const Args& a, int vcu, int G) {
    const int tid = threadIdx.x; const bf16_t* U = (const bf16_t*)(a.ws + WS_S1); bf16_t* MX = (bf16_t*)(a.ws + WS_S0);
    for (int rb = vcu * 128; rb < T; rb += G * 128) {
        for (int q = 0; q < 2; ++q) { const int item = tid + NTHREADS * q, cgi = item & 127, seg = item >> 7;
            const int w = 2 << (cgi >> 5), row0 = rb + seg * 16, s0 = row0 & (SEQ - 1);
            float sum[8];
#pragma unroll
            for (int j = 0; j < 8; ++j) sum[j] = 0.f;
            for (int k = 1; k < w; ++k) if (s0 - k >= 0) { float f[8]; unpack8(*(const u32x4*)(U + (size_t)(row0 - k) * D + cgi * 8), f);
#pragma unroll
                for (int j = 0; j < 8; ++j) sum[j] += f[j]; }
            for (int i = 0; i < 16; ++i) { const int r = row0 + i, s = s0 + i; float cur[8]; unpack8(*(const u32x4*)(U + (size_t)r * D + cgi * 8), cur);
                const float inv = 1.0f / (float)(s + 1 < w ? s + 1 : w); float o[8];
#pragma unroll
                for (int j = 0; j < 8; ++j) { sum[j] += cur[j]; o[j] = sum[j] * inv - cur[j]; }
                *(u32x4*)(MX + (size_t)r * D + cgi * 8) = pack8(o);
                if (s - (w - 1) >= 0) { float f[8]; unpack8(*(const u32x4*)(U + (size_t)(r - (w - 1)) * D + cgi * 8), f);
#pragma unroll
                    for (int j = 0; j < 8; ++j) sum[j] -= f[j]; } }
        }
    }
}

__device__ __forceinline__ void attn_naive(const Args& a, LAS unsigned char* lds, int vcu, int G) {
    const int tid = threadIdx.x, qi = tid >> 3, part = tid & 7;
    const bf16_t* Q = (const bf16_t*)(a.ws + WS_Q); const bf16_t* KN = (const bf16_t*)(a.ws + WS_KN); const bf16_t* KPE = (const bf16_t*)(a.ws + WS_KPE);
    const bf16_t* VT = (const bf16_t*)(a.ws + WS_VT); bf16_t* O = (bf16_t*)(a.ws + WS_O);
    LAS unsigned char* Qs = lds;
    LAS unsigned char* Ks = lds + 25600;
    LAS unsigned char* Vs = lds + 51200;
    LAS float* Ss = (LAS float*)(lds + 69632);
    for (int it = vcu; it < NB * NH * 64; it += G) {
        const int c = 63 - (it & 63), bh = it >> 6, b = bh >> 3, h = bh & 7; const int t0 = b * SEQ + c * 64;
        __syncthreads();
#pragma unroll
        for (int i = 0; i < 3; ++i) { const int ch = tid + NTHREADS * i, row = ch / 24, kc = ch % 24;
            *(LAS u32x4*)(Qs + row * 400 + kc * 16) = *(const u32x4*)(Q + (size_t)(t0 + row) * (NH * QKD) + h * QKD + kc * 8); }
        float m = -1e30f, l = 0.f, o[16];
#pragma unroll
        for (int dd = 0; dd < 16; ++dd) o[dd] = 0.f;
        for (int kt = 0; kt <= c; ++kt) {
            const int k0 = b * SEQ + kt * 64;
            __syncthreads();
#pragma unroll
            for (int i = 0; i < 2; ++i) { const int ch = tid + NTHREADS * i, row = ch >> 4, kc = ch & 15;
                *(LAS u32x4*)(Ks + row * 400 + kc * 16) = *(const u32x4*)(KN + (size_t)(k0 + row) * D + h * 128 + kc * 8); }
            { const int row = tid >> 3, kc = tid & 7; *(LAS u32x4*)(Ks + row * 400 + 256 + kc * 16) = *(const u32x4*)(KPE + (size_t)(k0 + row) * 64 + kc * 8); }
#pragma unroll
            for (int i = 0; i < 2; ++i) { const int ch = tid + NTHREADS * i, d = ch >> 3, kc = ch & 7;
                *(LAS u32x4*)(Vs + d * 144 + kc * 16) = *(const u32x4*)(VT + (size_t)(h * 128 + d) * T + k0 + kc * 8); }
            __syncthreads();
            float s[8];
#pragma unroll
            for (int j = 0; j < 8; ++j) s[j] = 0.f;
            for (int d8 = 0; d8 < 24; ++d8) { float q8[8]; unpack8(*(const LAS u32x4*)(Qs + qi * 400 + d8 * 16), q8);
#pragma unroll
                for (int j = 0; j < 8; ++j) { float k8[8]; unpack8(*(const LAS u32x4*)(Ks + (part * 8 + j) * 400 + d8 * 16), k8);
#pragma unroll
                    for (int e = 0; e < 8; ++e) s[j] += q8[e] * k8[e]; } }
#pragma unroll
            for (int j = 0; j < 8; ++j) Ss[qi * 65 + part * 8 + j] = s[j];
            __syncthreads();
            float mx = -1e30f;
            for (int k = 0; k < 64; ++k) mx = fmaxf(mx, Ss[qi * 65 + k]);
            const float mn = fmaxf(m, mx), alpha = exp2f(m - mn); float ls = 0.f;
            for (int k = 0; k < 64; ++k) ls += exp2f(Ss[qi * 65 + k] - mn);
            l = l * alpha + ls; m = mn;
#pragma unroll
            for (int dd = 0; dd < 16; ++dd) o[dd] *= alpha;
            for (int k8 = 0; k8 < 8; ++k8) { float p8[8];
#pragma unroll
                for (int e = 0; e < 8; ++e) p8[e] = exp2f(Ss[qi * 65 + k8 * 8 + e] - mn);
#pragma unroll
                for (int dd = 0; dd < 16; ++dd) { float v8[8]; unpack8(*(const LAS u32x4*)(Vs + (part * 16 + dd) * 144 + k8 * 16), v8);
#pragma unroll
                    for (int e = 0; e < 8; ++e) o[dd] += p8[e] * v8[e]; } }
        }
        const float il = 1.0f / l; float o0[8], o1[8];
#pragma unroll
        for (int j = 0; j < 8; ++j) { o0[j] = o[j] * il; o1[j] = o[8 + j] * il; }
        bf16_t* op = O + (size_t)(t0 + qi) * D + h * 128 + part * 16; *(u32x4*)op = pack8(o0); *(u32x4*)(op + 8) = pack8(o1);
    }
    __syncthreads();
}

__device__ __forceinline__ void p7_router(const Args& a, LAS unsigned char* lds, int vcu, int G) {
    const int tid = threadIdx.x, lane = tid & 63, wave = tid >> 6, rr = lane & 15, g = lane >> 4;
    const float* MOD = (const float*)(a.ws + WS_MOD); const float* X1 = a.out; bf16_t* H2 = (bf16_t*)(a.ws + WS_S0);
    int* TKI = (int*)(a.ws + WS_TKI); float* TKW = (float*)(a.ws + WS_TKW); int* RANK = (int*)(a.ws + WS_RANK); int* COUNTS = (int*)(a.ws + WS_COUNTS);
    LAS int* cnt = (LAS int*)(lds + 131072);
    __syncthreads();
    { const u32x4* src = (const u32x4*)(a.ws + WS_WR);
        for (int ch = tid; ch < 8192; ch += NTHREADS) { const int hl = ch >> 12, e = (ch >> 7) & 31, kc = ch & 127;
            *(LAS u32x4*)(lds + hl * 65536 + e * 2048 + ((kc ^ (e & 15)) << 4)) = src[ch]; } }
    for (int rb = vcu * 128; rb < T; rb += G * 128) {
        if (tid < 32) cnt[tid] = 0;
        __syncthreads();
        const int r0 = rb + wave * 16, b = rb >> 12, row = r0 + rr;
        const float* xr = X1 + (size_t)row * D + 8 * g;
        float ss = 0.f;
        for (int s = 0; s < 32; ++s) { const f32x4 x0 = *(const f32x4*)(xr + 32 * s), x1 = *(const f32x4*)(xr + 32 * s + 4);
            ss += (x0[0] * x0[0] + x0[1] * x0[1]) + (x0[2] * x0[2] + x0[3] * x0[3]) + (x1[0] * x1[0] + x1[1] * x1[1]) + (x1[2] * x1[2] + x1[3] * x1[3]); }
        ss += __shfl_xor(ss, 16); ss += __shfl_xor(ss, 32);
        const float rstd = rsqrtf(ss * (1.0f / D) + EPS);
        f32x4 acc0 = (f32x4){0.f, 0.f, 0.f, 0.f}, acc1 = acc0;
        const float* gf = a.in[I_GFFN] + 8 * g; const float* sc2 = MOD + b * 6144 + 4 * 1024 + 8 * g; const float* sh2 = MOD + b * 6144 + 3 * 1024 + 8 * g;
        for (int s = 0; s < 32; ++s) {
            const f32x4 x0 = *(const f32x4*)(xr + 32 * s), x1 = *(const f32x4*)(xr + 32 * s + 4);
            const f32x4 g0 = *(const f32x4*)(gf + 32 * s), g1 = *(const f32x4*)(gf + 32 * s + 4), c0 = *(const f32x4*)(sc2 + 32 * s), c1 = *(const f32x4*)(sc2 + 32 * s + 4);
            const f32x4 h0 = x0 * rstd * g0 * (c0 + 1.0f) + *(const f32x4*)(sh2 + 32 * s), h1 = x1 * rstd * g1 * (c1 + 1.0f) + *(const f32x4*)(sh2 + 32 * s + 4);
            u32x4 hi; hi.x = pk2(h0[0], h0[1]); hi.y = pk2(h0[2], h0[3]); hi.z = pk2(h1[0], h1[1]); hi.w = pk2(h1[2], h1[3]);
            *(u32x4*)(H2 + (size_t)row * D + 32 * s + 8 * g) = hi;
            float hf[8]; unpack8(hi, hf);
            u32x4 lo; lo.x = pk2(h0[0] - hf[0], h0[1] - hf[1]); lo.y = pk2(h0[2] - hf[2], h0[3] - hf[3]); lo.z = pk2(h1[0] - hf[4], h1[1] - hf[5]); lo.w = pk2(h1[2] - hf[6], h1[3] - hf[7]);
            const bf16x8 Ah = __builtin_bit_cast(bf16x8, hi), Al = __builtin_bit_cast(bf16x8, lo);
            const int kc = 4 * s + g;
            const bf16x8 Bh0 = *(const LAS bf16x8*)(lds + rr * 2048 + ((kc ^ rr) << 4)), Bh1 = *(const LAS bf16x8*)(lds + (16 + rr) * 2048 + ((kc ^ rr) << 4));
            const bf16x8 Bl0 = *(const LAS bf16x8*)(lds + 65536 + rr * 2048 + ((kc ^ rr) << 4)), Bl1 = *(const LAS bf16x8*)(lds + 65536 + (16 + rr) * 2048 + ((kc ^ rr) << 4));
            acc0 = __builtin_amdgcn_mfma_f32_16x16x32_bf16(Ah, Bh0, acc0, 0, 0, 0); acc0 = __builtin_amdgcn_mfma_f32_16x16x32_bf16(Al, Bh0, acc0, 0, 0, 0); acc0 = __builtin_amdgcn_mfma_f32_16x16x32_bf16(Ah, Bl0, acc0, 0, 0, 0);
            acc1 = __builtin_amdgcn_mfma_f32_16x16x32_bf16(Ah, Bh1, acc1, 0, 0, 0); acc1 = __builtin_amdgcn_mfma_f32_16x16x32_bf16(Al, Bh1, acc1, 0, 0, 0); acc1 = __builtin_amdgcn_mfma_f32_16x16x32_bf16(Ah, Bl1, acc1, 0, 0, 0);
        }
        const float br0 = a.in[I_BR][rr], br1 = a.in[I_BR][16 + rr];
#pragma unroll
        for (int reg = 0; reg < 4; ++reg) {
            float v0 = acc0[reg] + br0, v1 = acc1[reg] + br1; float tv[4]; int ti[4];
#pragma unroll
            for (int k = 0; k < 4; ++k) {
                float bv = v0; int bi = rr; if (v1 > bv) { bv = v1; bi = 16 + rr; }
#pragma unroll
                for (int o = 1; o < 16; o <<= 1) { const float ov = __shfl_xor(bv, o); const int oi = __shfl_xor(bi, o); if (ov > bv || (ov == bv && oi < bi)) { bv = ov; bi = oi; } }
                tv[k] = bv; ti[k] = bi; if (bi == rr) v0 = -INFINITY; if (bi == 16 + rr) v1 = -INFINITY;
            }
            if (rr == 0) { const int t = r0 + 4 * g + reg;
                const float e1 = __expf(tv[1] - tv[0]), e2 = __expf(tv[2] - tv[0]), e3 = __expf(tv[3] - tv[0]), inv = 1.0f / (1.0f + e1 + e2 + e3);
                *(f32x4*)(TKW + (size_t)t * 4) = (f32x4){inv, e1 * inv, e2 * inv, e3 * inv};
                int rk[4];
#pragma unroll
                for (int k = 0; k < 4; ++k) rk[k] = __hip_atomic_fetch_add(cnt + ti[k], 1, __ATOMIC_RELAXED, __HIP_MEMORY_SCOPE_WORKGROUP);
                *(u32x4*)(TKI + (size_t)t * 4) = (u32x4){(unsigned)ti[0], (unsigned)ti[1], (unsigned)ti[2], (unsigned)ti[3]};
                *(u32x4*)(RANK + (size_t)t * 4) = (u32x4){(unsigned)rk[0], (unsigned)rk[1], (unsigned)rk[2], (unsigned)rk[3]}; }
        }
        __syncthreads();
        if (tid < 32) COUNTS[(rb >> 7) * 32 + tid] = cnt[tid];
        __syncthreads();
    }
}

__device__ __forceinline__ void p8_scatter(const Args& a, LAS unsigned char* lds, int vcu, int G) {
    const int tid = threadIdx.x, lane = tid & 63, wave = tid >> 6;
    const int* COUNTS = (const int*)(a.ws + WS_COUNTS); const int* TKI = (const int*)(a.ws + WS_TKI); const float* TKW = (const float*)(a.ws + WS_TKW); const int* RANK = (const int*)(a.ws + WS_RANK);
    int* SLOTROW = (int*)(a.ws + WS_SLOTROW); float* ROWW = (float*)(a.ws + WS_ROWW); int* TILEE = (int*)(a.ws + WS_TILEE);
    const bf16_t* H2 = (const bf16_t*)(a.ws + WS_S0); bf16_t* XS = (bf16_t*)(a.ws + WS_XS);
    LAS int* ptot = (LAS int*)lds;
    LAS int* pbef = ptot + 512;
    LAS int* base = pbef + 512;
    for (int rb = vcu * 128; rb < T; rb += G * 128) {
        const int blk = rb >> 7;
        __syncthreads();
        { const int e = tid & 31, pt = tid >> 5; int st = 0, sb = 0;
            for (int bb = pt * 16; bb < pt * 16 + 16; ++bb) { const int cv = COUNTS[bb * 32 + e]; st += cv; if (bb < blk) sb += cv; }
            ptot[pt * 32 + e] = st; pbef[pt * 32 + e] = sb; }
        __syncthreads();
        if (tid == 0) { int ps = 0;
            for (int e = 0; e < 32; ++e) { int tot = 0, bef = 0;
                for (int pt = 0; pt < 16; ++pt) { tot += ptot[pt * 32 + e]; bef += pbef[pt * 32 + e]; }
                base[e] = ps + bef;
                const int ntl = (tot + 255) >> 8;
                if (blk == 0) { for (int q = 0; q < ntl; ++q) TILEE[(ps >> 8) + q] = e; }
                ps += ntl << 8; }
            if (blk == 0) TILEE[1023] = ps >> 8; }
        __syncthreads();
        for (int sidx = wave; sidx < 512; sidx += 8) { const int t = rb + (sidx >> 2), k = sidx & 3;
            const int e = TKI[(size_t)t * 4 + k], dest = base[e] + RANK[(size_t)t * 4 + k];
            if (lane == 0) { SLOTROW[(size_t)t * 4 + k] = dest; ROWW[dest] = TKW[(size_t)t * 4 + k]; }
            const u32x4* src = (const u32x4*)(H2 + (size_t)t * D); u32x4* dst = (u32x4*)(XS + (size_t)dest * D);
            dst[lane] = src[lane]; dst[64 + lane] = src[64 + lane]; }
    }
    __syncthreads();
}

__device__ __forceinline__ void p11_final(const Args& a, int vcu, int G) {
    const int tid = threadIdx.x, lane = tid & 63, wave = tid >> 6;
    const float* MOD = (const float*)(a.ws + WS_MOD); const float* FMOD = (const float*)(a.ws + WS_FMOD); const int* SLOTROW = (const int*)(a.ws + WS_SLOTROW);
    const bf16_t* Y = (const bf16_t*)(a.ws + WS_XS); float* OUT = a.out;
    for (int rb = vcu * 128; rb < T; rb += G * 128) {
        const int b = rb >> 12;
        f32x4 g2[4], gs[4], sh[4];
#pragma unroll
        for (int j = 0; j < 4; ++j) { const int c = 4 * lane + 256 * j; g2[j] = *(const f32x4*)(MOD + b * 6144 + 5 * 1024 + c);
            gs[j] = *(const f32x4*)(a.in[I_GFIN] + c) * (*(const f32x4*)(FMOD + b * 2048 + 1024 + c) + 1.0f); sh[j] = *(const f32x4*)(FMOD + b * 2048 + c); }
        for (int i = 0; i < 16; ++i) { const int t = rb + wave * 16 + i; const u32x4 sr = *(const u32x4*)(SLOTROW + (size_t)t * 4);
            f32x4* xr = (f32x4*)(OUT + (size_t)t * D) + lane; f32x4 v[4]; float s = 0.f;
#pragma unroll
            for (int j = 0; j < 4; ++j) { f32x4 mo = (f32x4){0.f, 0.f, 0.f, 0.f};
#pragma unroll
                for (int k = 0; k < 4; ++k) { const u32x2 w = *((const u32x2*)(Y + (size_t)sr[k] * D) + lane + 64 * j); mo[0] += bflo(w.x); mo[1] += bfhi(w.x); mo[2] += bflo(w.y); mo[3] += bfhi(w.y); }
                v[j] = xr[64 * j] + g2[j] * mo; s += (v[j][0] * v[j][0] + v[j][1] * v[j][1]) + (v[j][2] * v[j][2] + v[j][3] * v[j][3]); }
            const float rstd = rsqrtf(wave_sum(s) * (1.0f / D) + EPS);
#pragma unroll
            for (int j = 0; j < 4; ++j) xr[64 * j] = v[j] * rstd * gs[j] + sh[j]; }
    }
}

__global__ void __launch_bounds__(NTHREADS, 2) mk_fwd(Args a) {
    extern __shared__ __attribute__((aligned(16))) unsigned char lds_raw[];
    LAS unsigned char* lds = (LAS unsigned char*)lds_raw;
    const int G = gridDim.x, bx = blockIdx.x; const int vcu = (G % 8 == 0) ? (bx % 8) * (G / 8) + bx / 8 : bx;
    unsigned char* ws = a.ws;
    const int lo = a.ph_lo, hi = a.ph_hi;
#ifndef PHASE_MASK
#define PHASE_MASK 0xFFF
#endif
#define IN(k) ((((PHASE_MASK) >> (k)) & 1) && lo <= (k) && (k) < hi)
#if ONE_LAUNCH
#define SEAM(k) do { if (IN(k) && IN((k) + 1)) cg::this_grid().sync(); } while (0)
#else
#define SEAM(k) do { } while (0)
#endif
    if (IN(0)) { p0_prep(a, lds, vcu, G); } SEAM(0);
    if (IN(1)) { p1_hb(a, vcu, G); } SEAM(1);
    if (IN(2)) {
        Gemm g{(const bf16_t*)(ws + WS_S0), (const bf16_t*)(ws + WS_WIN), D, D, D}; DenseSched S; S.init(T / 256, INP / 256, G, bx, D, D, 0);
        EpiIn E{(bf16_t*)(ws + WS_S1), (bf16_t*)(ws + WS_QLAT), (bf16_t*)(ws + WS_KVLAT), (bf16_t*)(ws + WS_KPE), (bf16_t*)(ws + WS_GATES), (float*)(ws + WS_PSQQ), (float*)(ws + WS_PSQKV), a.in[I_BGATE], (const f32x2*)(ws + WS_CS)};
        gemm_phase(lds, g, S, E);
    } SEAM(2);
    if (IN(3)) {
        p3_mixed(a, vcu, G);
        { Gemm g{(const bf16_t*)(ws + WS_QLAT), (const bf16_t*)(ws + WS_WQ), QL, QL, QL}; DenseSched S; S.init(T / 256, 6, G, bx, QL, QL, 0);
            EpiQ E{(bf16_t*)(ws + WS_Q), (const float*)(ws + WS_PSQQ), (const f32x2*)(ws + WS_CS)}; gemm_phase(lds, g, S, E); }
        { Gemm g{(const bf16_t*)(ws + WS_KVLAT), (const bf16_t*)(ws + WS_WK), KVL, KVL, KVL}; DenseSched S; S.init(T / 256, 4, G, bx, KVL, KVL, 0);
            EpiK E{(bf16_t*)(ws + WS_KN), (const float*)(ws + WS_PSQKV)}; gemm_phase(lds, g, S, E); }
        { Gemm g{(const bf16_t*)(ws + WS_WV), (const bf16_t*)(ws + WS_KVLAT), KVL, KVL, KVL}; DenseSched S; S.init(4, T / 256, G, bx, KVL, KVL, 0);
            EpiVT E{(bf16_t*)(ws + WS_VT), (const float*)(ws + WS_PSQKV)}; gemm_phase(lds, g, S, E); }
    } SEAM(3);
    if (IN(4)) {
        attn_naive(a, lds, vcu, G);
        { Gemm g{(const bf16_t*)(ws + WS_S0), (const bf16_t*)(ws + WS_WGRP), D, 256, 256}; DenseSched S; S.init(T / 256, 4, G, bx, D, 256, 512u);
            EpiPlain E{(bf16_t*)(ws + WS_S1), D}; gemm_phase(lds, g, S, E); }
    } SEAM(4);
    if (IN(5)) {
        DenseSched S; S.init(T / 256, 4, G, bx, D, D, 0);
        { Gemm g{(const bf16_t*)(ws + WS_S1), (const bf16_t*)(ws + WS_WPO), D, D, D}; EpiMerge<0> E{(bf16_t*)(ws + WS_S0), (const bf16_t*)(ws + WS_GATES)}; gemm_phase(lds, g, S, E); }
        { Gemm g{(const bf16_t*)(ws + WS_O), (const bf16_t*)(ws + WS_WMO), D, D, D}; EpiMerge<1> E{(bf16_t*)(ws + WS_S0), (const bf16_t*)(ws + WS_GATES)}; gemm_phase(lds, g, S, E); }
    } SEAM(5);
    if (IN(6)) {
        Gemm g{(const bf16_t*)(ws + WS_S0), (const bf16_t*)(ws + WS_WOUT), D, D, D}; DenseSched S; S.init(T / 256, 4, G, bx, D, D, 0);
        EpiOut E{a.in[I_X], a.out, (const float*)(ws + WS_MOD)}; gemm_phase(lds, g, S, E);
    } SEAM(6);
    if (IN(7)) { p7_router(a, lds, vcu, G); } SEAM(7);
    if (IN(8)) { p8_scatter(a, lds, vcu, G); } SEAM(8);
    if (IN(9)) {
        Gemm g{(const bf16_t*)(ws + WS_XS), (const bf16_t*)(ws + WS_WGU), D, D, D}; MoeSched S; S.init((const int*)(ws + WS_TILEE), 8, G, bx, D, D);
        EpiGU E{(bf16_t*)(ws + WS_ACT), a.in[I_BGU]}; gemm_phase(lds, g, S, E);
    } SEAM(9);
    if (IN(10)) {
        Gemm g{(const bf16_t*)(ws + WS_ACT), (const bf16_t*)(ws + WS_WDN), D, D, D}; MoeSched S; S.init((const int*)(ws + WS_TILEE), 4, G, bx, D, D);
        EpiDown E{(bf16_t*)(ws + WS_XS), a.in[I_BDN], (const float*)(ws + WS_ROWW)}; gemm_phase(lds, g, S, E);
    } SEAM(10);
    if (IN(11)) { p11_final(a, vcu, G); }
#undef IN
#undef SEAM
}

constexpr int NPHASES = 12;
extern "C" void kernel_launch(void* const* d_in, const int* in_sizes, int n_in, void* d_out, int out_size, void* d_ws, size_t ws_size, hipStream_t stream) {
    static int grid = 0;
    if (grid == 0) {
        if (n_in != 27 || out_size != T * D || ws_size < WS_END) { fprintf(stderr, "kernel_launch: unexpected problem (n_in %d out %d ws %zu)\n", n_in, out_size, ws_size); grid = -1; return; }
        int dev = 0, cus = 0, per_cu = 0;
        hipGetDevice(&dev); hipDeviceGetAttribute(&cus, hipDeviceAttributeMultiprocessorCount, dev);
        hipFuncSetAttribute((const void*)mk_fwd, hipFuncAttributeMaxDynamicSharedMemorySize, LDS_BYTES);
        hipOccupancyMaxActiveBlocksPerMultiprocessor(&per_cu, (const void*)mk_fwd, NTHREADS, LDS_BYTES);
        (void)hipGetLastError();
        if (per_cu < 1) { fprintf(stderr, "kernel_launch: occupancy query says %d blocks per CU\n", per_cu); per_cu = 1; }
        grid = cus;
    }
    if (grid < 0) return;
    Args a{};
    for (int i = 0; i < 27; ++i) a.in[i] = (const float*)d_in[i];
    a.out = (float*)d_out; a.ws = (unsigned char*)d_ws;
#if ONE_LAUNCH
    a.ph_lo = 0; a.ph_hi = NPHASES;
    void* args[] = {&a};
    hipError_t e = hipLaunchCooperativeKernel((const void*)mk_fwd, dim3(grid), dim3(NTHREADS), args, LDS_BYTES, stream);
    if (e != hipSuccess) fprintf(stderr, "cooperative launch failed: %s (grid %d)\n", hipGetErrorString(e), grid);
#else
    for (int p = 0; p < NPHASES; ++p) { a.ph_lo = p; a.ph_hi = p + 1; hipLaunchKernelGGL(mk_fwd, dim3(grid), dim3(NTHREADS), LDS_BYTES, stream, a); }
#endif
}
```

```cpp
#include <hip/hip_runtime.h>
#include <hip/hip_cooperative_groups.h>
#include <cstdio>
#include <cstdint>
namespace cg = cooperative_groups;

#ifndef ONE_LAUNCH
#define ONE_LAUNCH 1
#endif
#ifndef FAST_GEMM
#define FAST_GEMM 1
#endif
#ifndef FAST_ATTN
#define FAST_ATTN 1
#endif

#define LAS __attribute__((address_space(3)))
typedef unsigned short bf16_t;
typedef short bf16x8 __attribute__((ext_vector_type(8)));
typedef float f32x4 __attribute__((ext_vector_type(4)));
typedef float f32x2 __attribute__((ext_vector_type(2)));
typedef unsigned u32x4 __attribute__((ext_vector_type(4)));
typedef unsigned u32x2 __attribute__((ext_vector_type(2)));
typedef __bf16 bf16x2_t __attribute__((ext_vector_type(2)));

constexpr int D = 1024, NB = 8, SEQ = 4096, T = NB * SEQ;
constexpr int QL = 768, KVL = 256, ROPE = 64, NH = 8, NOPE = 128, VH = 128, QKD = NOPE + ROPE;
constexpr int IN_W = 4160, INP = 4352;
constexpr int NE = 32, TOPK = 4, DE = 1024;
constexpr int NSLOT = T * TOPK;
constexpr int RT_MAX = 543;
constexpr float EPS = 1e-6f;
constexpr float QSCALE = 0.07216878364870322f * 1.4426950408889634f;

constexpr size_t MiB = 1u << 20;
constexpr size_t WS_MOD = 1 * MiB;
constexpr size_t WS_FMOD = 1 * MiB + 256 * 1024;
constexpr size_t WS_CS = 2 * MiB;
constexpr size_t WS_PSQQ = 10 * MiB;
constexpr size_t WS_PSQKV = 12 * MiB;
constexpr size_t WS_TKI = 13 * MiB;
constexpr size_t WS_TKW = 13 * MiB + 512 * 1024;
constexpr size_t WS_RANK = 14 * MiB;
constexpr size_t WS_SLOTROW = 14 * MiB + 512 * 1024;
constexpr size_t WS_COUNTS = 15 * MiB;
constexpr size_t WS_ROWW = 16 * MiB;
constexpr size_t WS_TILEE = 17 * MiB;
constexpr size_t WS_WR = 18 * MiB;
constexpr size_t WS_WIN = 32 * MiB;
constexpr size_t WS_WQ = 41 * MiB;
constexpr size_t WS_WK = 44 * MiB;
constexpr size_t WS_WV = 45 * MiB;
constexpr size_t WS_WGRP = 46 * MiB;
constexpr size_t WS_WPO = 47 * MiB;
constexpr size_t WS_WMO = 49 * MiB;
constexpr size_t WS_WOUT = 51 * MiB;
constexpr size_t WS_WGU = 54 * MiB;
constexpr size_t WS_WDN = 182 * MiB;
constexpr size_t WS_S0 = 256 * MiB;
constexpr size_t WS_S1 = 320 * MiB;
constexpr size_t WS_QLAT = 384 * MiB;
constexpr size_t WS_KVLAT = 432 * MiB;
constexpr size_t WS_KPE = 448 * MiB;
constexpr size_t WS_GATES = 452 * MiB;
constexpr size_t WS_Q = 580 * MiB;
constexpr size_t WS_KN = 676 * MiB;
constexpr size_t WS_VT = 740 * MiB;
constexpr size_t WS_O = 804 * MiB;
constexpr size_t WS_XS = 320 * MiB;
constexpr size_t WS_ACT = 592 * MiB;
constexpr size_t WS_END = 864 * MiB;

constexpr int LDS_BYTES = 147456;
constexpr int NTHREADS = 512;

__device__ __forceinline__ unsigned pk2(float lo, float hi) { f32x2 v = {lo, hi}; bf16x2_t b = __builtin_convertvector(v, bf16x2_t); return __builtin_bit_cast(unsigned, b); }
__device__ __forceinline__ float bflo(unsigned u) { return __uint_as_float(u << 16); }
__device__ __forceinline__ float bfhi(unsigned u) { return __uint_as_float(u & 0xffff0000u); }
__device__ __forceinline__ void unpack8(const u32x4 w, float (&f)[8]) { f[0] = bflo(w.x); f[1] = bfhi(w.x); f[2] = bflo(w.y); f[3] = bfhi(w.y); f[4] = bflo(w.z); f[5] = bfhi(w.z); f[6] = bflo(w.w); f[7] = bfhi(w.w); }
__device__ __forceinline__ u32x4 pack8(const float (&f)[8]) { u32x4 w; w.x = pk2(f[0], f[1]); w.y = pk2(f[2], f[3]); w.z = pk2(f[4], f[5]); w.w = pk2(f[6], f[7]); return w; }
__device__ __forceinline__ float wave_sum(float v) {
#pragma unroll
    for (int o = 1; o < 64; o <<= 1) v += __shfl_xor(v, o);
    return v;
}
__device__ __forceinline__ float sigmoidf_(float x) { return 1.0f / (1.0f + __expf(-x)); }

struct Args {
    const float* in[27]; float* out; unsigned char* ws; int ph_lo, ph_hi;
};
enum { I_X = 0, I_C, I_POS, I_WMOD, I_BMOD, I_GMIX, I_WIN, I_BGATE, I_WPG, I_PSCALE, I_WPO, I_GQA, I_WQB, I_GKVA, I_WKVB, I_WMO, I_WOUT, I_GFFN, I_WR, I_BR, I_WGU, I_BGU, I_WDN, I_BDN, I_GFIN, I_WFMOD, I_BFMOD };

struct Unit { int pm, pn, e; unsigned ao, bo; };
struct Gemm { const bf16_t* A; const bf16_t* Bt; int lda, ldb, K; };
constexpr int NXCD = 8, WGM = 8;
__host__ __device__ __forceinline__ int perm32(int rho) { const int n = rho >> 4, i = rho & 15; return 8 * (i >> 2) + 4 * n + (i & 3); }

struct DenseSched {
    int nM, nN, nwg, G, c; unsigned a_tile, a_col, b_tile;
    __device__ void init(int nM_, int nN_, int G_, int c_, int lda, int ldb, unsigned a_col_) { nM = nM_; nN = nN_; nwg = nM * nN; G = G_; c = c_; a_tile = 256u * lda * 2u; b_tile = 256u * ldb * 2u; a_col = a_col_; }
    __device__ bool next(int i, Unit& u) const {
        const long L = (long)i * G + c; if (L >= nwg) return false;
        int wgid = (int)L; { const int q = nwg / NXCD, r = nwg % NXCD, xcd = wgid % NXCD, off = wgid / NXCD; wgid = (xcd < r ? xcd * (q + 1) : r * (q + 1) + (xcd - r) * q) + off; }
        const int nig = WGM * nN, gid = wgid / nig, fm = gid * WGM, gsz = (nM - fm) < WGM ? (nM - fm) : WGM;
        u.pm = fm + ((wgid % nig) % gsz); u.pn = (wgid % nig) / gsz; u.e = 0;
        u.ao = (unsigned)u.pm * a_tile + (unsigned)u.pn * a_col; u.bo = (unsigned)u.pn * b_tile; return true;
    }
};
struct MoeSched {
    const int* tile_e; int R, NT, G, c; unsigned a_tile, b_tile;
    __device__ void init(const int* te, int NT_, int G_, int c_, int lda, int ldb) { tile_e = te; R = te[1023]; NT = NT_; G = G_; c = c_; a_tile = 256u * lda * 2u; b_tile = 256u * ldb * 2u; }
    __device__ bool next(int i, Unit& u) const {
        int rt, pn;
        if (G == 256) { const int x = c & 7, j = c >> 3, rpr = 256 / NT, pxc = rpr / 8; rt = i * rpr + x * pxc + j / NT; pn = j % NT; }
        else { const long L = (long)i * G + c; rt = (int)(L / NT); pn = (int)(L % NT); }
        if (rt >= R) return false;
        const int e = tile_e[rt];
        u.pm = rt; u.pn = pn; u.e = e; u.ao = (unsigned)rt * a_tile; u.bo = (unsigned)(e * NT + pn) * b_tile; return true;
    }
};

template <class Epi>
__device__ __forceinline__ void run_epi(const Epi& E, const f32x4 (&acc)[2][2][4][2], const Unit& u, int wr, int wc, int fr, int fq) {
    if constexpr (Epi::COLMAJOR) {
#pragma unroll
        for (int bj = 0; bj < 2; ++bj) {
            const int col = bj * 128 + wc * 32 + 8 * fq;
            const typename Epi::ColCtx cc = E.col_ctx(u, col);
            asm volatile("" ::: "memory");
#pragma unroll
            for (int ai = 0; ai < 2; ++ai)
#pragma unroll
                for (int m = 0; m < 4; ++m) {
                    float v[8];
#pragma unroll
                    for (int j = 0; j < 4; ++j) { v[j] = acc[ai][bj][m][0][j]; v[4 + j] = acc[ai][bj][m][1][j]; }
                    E.apply(u, u.pm * 256 + ai * 128 + wr * 64 + m * 16 + fr, col, v, 0.f, cc);
                }
            asm volatile("" ::: "memory");
        }
    } else {
        const bool wp = Epi::SUMSQ && E.want_partial(u);
#pragma unroll
        for (int ai = 0; ai < 2; ++ai)
#pragma unroll
            for (int m = 0; m < 4; ++m) {
                const int row = u.pm * 256 + ai * 128 + wr * 64 + m * 16 + fr;
                const float rc = E.row_ctx(u, row); float part = 0.f;
#pragma unroll
                for (int bj = 0; bj < 2; ++bj) {
                    const int col = bj * 128 + wc * 32 + 8 * fq;
                    float v[8];
#pragma unroll
                    for (int j = 0; j < 4; ++j) { v[j] = acc[ai][bj][m][0][j]; v[4 + j] = acc[ai][bj][m][1][j]; }
                    part += E.apply(u, row, col, v, rc, E.col_ctx(u, col));
                }
                if constexpr (Epi::SUMSQ) { if (wp) { float s = part; s += __shfl_xor(s, 16); s += __shfl_xor(s, 32); if (fq == 0) E.partial(u, row, wc, s); } }
                asm volatile("" ::: "memory");
            }
    }
}

template <class Epi, class Sched>
__device__ __forceinline__ void gemm_simple(LAS unsigned char* lds, const Gemm g, const Sched& S, const Epi& E) {
    const int tid = threadIdx.x, wid = __builtin_amdgcn_readfirstlane(tid >> 6), lane = tid & 63, wr = wid >> 2, wc = wid & 3, fr = lane & 15, fq = lane >> 4;
    const int nt = g.K / 64;
    Unit u;
    for (int ui = 0; S.next(ui, u); ++ui) {
        f32x4 acc[2][2][4][2];
#pragma unroll
        for (int a = 0; a < 2; ++a)
#pragma unroll
            for (int b = 0; b < 2; ++b)
#pragma unroll
                for (int m = 0; m < 4; ++m)
#pragma unroll
                    for (int n = 0; n < 2; ++n) acc[a][b][m][n] = (f32x4){0.f, 0.f, 0.f, 0.f};
        const char* cA = (const char*)g.A + u.ao; const char* cB = (const char*)g.Bt + u.bo;
#pragma unroll 1
        for (int kt = 0; kt < nt; ++kt) {
            __syncthreads();
#pragma unroll
            for (int i = 0; i < 4; ++i) { const int c = tid + 512 * i, row = c >> 3, kc = c & 7, rb = (row & ~31) + perm32(row & 31);
                const u32x4 va = *(const u32x4*)(cA + (size_t)row * g.lda * 2 + kt * 128 + kc * 16);
                const u32x4 vb = *(const u32x4*)(cB + (size_t)rb * g.ldb * 2 + kt * 128 + kc * 16);
                *(LAS u32x4*)(lds + row * 144 + kc * 16) = va; *(LAS u32x4*)(lds + 36864 + row * 144 + kc * 16) = vb; }
            __syncthreads();
#pragma unroll
            for (int k = 0; k < 2; ++k) {
                bf16x8 Af[2][4], Bf[2][2];
#pragma unroll
                for (int ai = 0; ai < 2; ++ai)
#pragma unroll
                    for (int m = 0; m < 4; ++m) Af[ai][m] = *(const LAS bf16x8*)(lds + (ai * 128 + wr * 64 + m * 16 + fr) * 144 + (k * 32 + fq * 8) * 2);
#pragma unroll
                for (int bj = 0; bj < 2; ++bj)
#pragma unroll
                    for (int n = 0; n < 2; ++n) Bf[bj][n] = *(const LAS bf16x8*)(lds + 36864 + (bj * 128 + wc * 32 + n * 16 + fr) * 144 + (k * 32 + fq * 8) * 2);
#pragma unroll
                for (int ai = 0; ai < 2; ++ai)
#pragma unroll
                    for (int bj = 0; bj < 2; ++bj)
#pragma unroll
                        for (int m = 0; m < 4; ++m)
#pragma unroll
                            for (int n = 0; n < 2; ++n) acc[ai][bj][m][n] = __builtin_amdgcn_mfma_f32_16x16x32_bf16(Bf[bj][n], Af[ai][m], acc[ai][bj][m][n], 0, 0, 0);
            }
        }
        run_epi(E, acc, u, wr, wc, fr, fq);
    }
    __syncthreads();
}

namespace pg8 {
constexpr int BK = 64, HALF = 128, HTB = HALF * BK * 2  , STAGE_BYTES = 8 * HTB;
__device__ __forceinline__ int lds_byte(int r, int c) { const int st = (r >> 4) * 2 + (c >> 5), rr = r & 15, cc = c & 31, ob = rr * 64 + cc * 2; return st * 1024 + (ob ^ (((ob >> 9) & 1) << 5)); }
__device__ __forceinline__ void stage_rc(int b, int& R, int& C) { const int st = b / 1024, sb = b % 1024, swz = sb ^ (((sb >> 9) & 1) << 5); R = (st >> 1) * 16 + swz / 64; C = (st & 1) * 32 + (swz % 64) / 2; }

template <class Epi, class Sched>
__device__ __forceinline__ void gemm_fast(LAS unsigned char* lds, const Gemm g, const Sched& S, const Epi& E) {
    const int tid = threadIdx.x, wid = __builtin_amdgcn_readfirstlane(tid >> 6), lane = tid & 63, wr = wid >> 2, wc = wid & 3, fr = lane & 15, fq = lane >> 4;
    const int nt = g.K / BK;
    unsigned voffA[2], voffB[2];
#pragma unroll
    for (int i = 0; i < 2; ++i) { int R, C; stage_rc(tid * 16 + i * 8192, R, C); const int Rb = (R & ~31) + perm32(R & 31);
        voffA[i] = (unsigned)(R * g.lda + C) * 2u; voffB[i] = (unsigned)(Rb * g.ldb + C) * 2u; }
    const size_t kstep = (size_t)(BK * 2);
    const size_t hstepA = (size_t)HALF * g.lda * 2, hstepB = (size_t)HALF * g.ldb * 2;
    const unsigned ldsw = (unsigned)wid * 1024u;
    const int aoff = lds_byte(wr * 64 + fr, fq * 8), boff = lds_byte(wc * 32 + fr, fq * 8);
#define PG8_SA(b, h) (((b) * 2 + (h)) * HTB)
#define PG8_SB(b, h) ((4 + (b) * 2 + (h)) * HTB)
#define PG8_STAGE(bufoff, gbase, voff) do { _Pragma("unroll") for (int _i = 0; _i < 2; ++_i) \
        __builtin_amdgcn_global_load_lds((const unsigned*)((const char*)(gbase) + (voff)[_i]), (LAS unsigned*)(lds + (bufoff) + ldsw + _i * 8192), 16, 0, 0); } while (0)
#define PG8_LDA(dst, b, h) do { _Pragma("unroll") for (int m = 0; m < 4; ++m) _Pragma("unroll") for (int k = 0; k < 2; ++k) dst[m][k] = *(const LAS bf16x8*)(lds + PG8_SA(b, h) + aoff + m * 2048 + k * 1024); } while (0)
#define PG8_LDB(dst, b, h) do { _Pragma("unroll") for (int n = 0; n < 2; ++n) _Pragma("unroll") for (int k = 0; k < 2; ++k) dst[n][k] = *(const LAS bf16x8*)(lds + PG8_SB(b, h) + boff + n * 2048 + k * 1024); } while (0)
#define PG8_MMA(ai, bj, At, Bt) do { __builtin_amdgcn_s_setprio(1); _Pragma("unroll") for (int m = 0; m < 4; ++m) _Pragma("unroll") for (int n = 0; n < 2; ++n) _Pragma("unroll") for (int k = 0; k < 2; ++k) \
        acc[ai][bj][m][n] = __builtin_amdgcn_mfma_f32_16x16x32_bf16(Bt[n][k], At[m][k], acc[ai][bj][m][n], 0, 0, 0); __builtin_amdgcn_s_setprio(0); } while (0)
#define PG8_WAIT_V(n) asm volatile("s_waitcnt vmcnt(" #n ")" ::: "memory")
#define PG8_WAIT_L(n) asm volatile("s_waitcnt lgkmcnt(" #n ")" ::: "memory")
#define PG8_BAR __builtin_amdgcn_s_barrier()
#define PG8_SCHED __builtin_amdgcn_sched_barrier(0)
    Unit cur, nxt; int ui = 0;
    if (!S.next(0, cur)) return;
    f32x4 acc[2][2][4][2];
#pragma unroll
    for (int a = 0; a < 2; ++a)
#pragma unroll
        for (int b = 0; b < 2; ++b)
#pragma unroll
            for (int m = 0; m < 4; ++m)
#pragma unroll
                for (int n = 0; n < 2; ++n) acc[a][b][m][n] = (f32x4){0.f, 0.f, 0.f, 0.f};
    bf16x8 At[4][2], B0[2][2], B1[2][2];
    const char* cA = (const char*)g.A + cur.ao; const char* cB = (const char*)g.Bt + cur.bo;
    PG8_STAGE(PG8_SB(0, 0), cB, voffB); PG8_STAGE(PG8_SB(0, 1), cB + hstepB, voffB); PG8_STAGE(PG8_SA(0, 0), cA, voffA); PG8_STAGE(PG8_SA(0, 1), cA + hstepA, voffA);
    if (wr == 1) PG8_BAR;
    PG8_WAIT_V(2); PG8_BAR;
    PG8_STAGE(PG8_SB(1, 0), cB + kstep, voffB); PG8_STAGE(PG8_SA(1, 0), cA + kstep, voffA); PG8_STAGE(PG8_SB(1, 1), cB + hstepB + kstep, voffB);
    PG8_WAIT_V(6); PG8_BAR;
    for (;;) {
        const bool has_next = S.next(ui + 1, nxt);
        const char* nA = has_next ? (const char*)g.A + nxt.ao : cA; const char* nB = has_next ? (const char*)g.Bt + nxt.bo : cB;
#pragma unroll 1
        for (int t = 0; t < nt; t += 2) {
            const bool last = (t == nt - 2);
            const char* a1 = cA + (size_t)(t + 1) * kstep;
            const char* a2 = last ? nA : cA + (size_t)(t + 2) * kstep; const char* b2 = last ? nB : cB + (size_t)(t + 2) * kstep;
            const char* a3 = a2 + kstep; const char* b3 = b2 + kstep;
            PG8_LDB(B0, 0, 0); PG8_LDB(B1, 0, 1); PG8_SCHED; PG8_LDA(At, 0, 0); PG8_STAGE(PG8_SA(1, 1), a1 + hstepA, voffA);
            PG8_WAIT_V(8); PG8_WAIT_L(0); PG8_BAR; PG8_MMA(0, 0, At, B0); PG8_MMA(0, 1, At, B1); PG8_BAR; PG8_SCHED;
            PG8_LDA(At, 0, 1); PG8_STAGE(PG8_SB(0, 0), b2, voffB); PG8_STAGE(PG8_SB(0, 1), b2 + hstepB, voffB); PG8_STAGE(PG8_SA(0, 0), a2, voffA);
            PG8_WAIT_V(8); PG8_WAIT_L(0); PG8_BAR; PG8_MMA(1, 0, At, B0); PG8_MMA(1, 1, At, B1); PG8_BAR; PG8_SCHED;
            PG8_LDB(B0, 1, 0); PG8_LDB(B1, 1, 1); PG8_SCHED; PG8_LDA(At, 1, 0); PG8_STAGE(PG8_SA(0, 1), a2 + hstepA, voffA);
            PG8_WAIT_V(8); PG8_WAIT_L(0); PG8_BAR; PG8_MMA(0, 0, At, B0); PG8_MMA(0, 1, At, B1); PG8_BAR; PG8_SCHED;
            PG8_LDA(At, 1, 1); PG8_STAGE(PG8_SB(1, 0), b3, voffB); PG8_STAGE(PG8_SB(1, 1), b3 + hstepB, voffB); PG8_STAGE(PG8_SA(1, 0), a3, voffA);
            PG8_WAIT_V(8); PG8_WAIT_L(0); PG8_BAR; PG8_MMA(1, 0, At, B0); PG8_MMA(1, 1, At, B1); PG8_BAR; PG8_SCHED;
        }
        if (wr == 0) PG8_BAR;
        run_epi(E, acc, cur, wr, wc, fr, fq);
        if (!has_next) break;
#pragma unroll
        for (int a = 0; a < 2; ++a)
#pragma unroll
            for (int b = 0; b < 2; ++b)
#pragma unroll
                for (int m = 0; m < 4; ++m)
#pragma unroll
                    for (int n = 0; n < 2; ++n) acc[a][b][m][n] = (f32x4){0.f, 0.f, 0.f, 0.f};
        cur = nxt; cA = nA; cB = nB; ++ui;
        if (wr == 1) PG8_BAR;
    }
    PG8_WAIT_V(0);
    PG8_BAR;
#undef PG8_SA
#undef PG8_SB
#undef PG8_STAGE
#undef PG8_LDA
#undef PG8_LDB
#undef PG8_MMA
#undef PG8_WAIT_V
#undef PG8_WAIT_L
#undef PG8_BAR
#undef PG8_SCHED
}
}

template <class Epi, class Sched>
__device__ __forceinline__ void gemm_phase(LAS unsigned char* lds, const Gemm g, const Sched& S, const Epi& E) {
#if FAST_GEMM
    pg8::gemm_fast<Epi, Sched>(lds, g, S, E);
#else
    gemm_simple<Epi, Sched>(lds, g, S, E);
#endif
}

struct NoCtx {};
struct EpiIn {
    static constexpr bool SUMSQ = true, COLMAJOR = false; typedef NoCtx ColCtx;
    bf16_t *U, *QLp, *KVLp, *KPE, *GATES; float *PSQQ, *PSQKV; const float* bgate; const f32x2* CS;
    __device__ __forceinline__ float row_ctx(const Unit&, int) const { return 0.f; }
    __device__ __forceinline__ NoCtx col_ctx(const Unit&, int) const { return NoCtx{}; }
    __device__ __forceinline__ bool want_partial(const Unit& u) const { return u.pn >= 4 && u.pn < 8; }
    __device__ __forceinline__ void partial(const Unit& u, int row, int wc, float s) const {
        if (u.pn < 7) PSQQ[(size_t)row * 12 + (u.pn - 4) * 4 + wc] = s; else PSQKV[(size_t)row * 4 + wc] = s; }
    __device__ __forceinline__ float apply(const Unit& u, int row, int col, float (&v)[8], float, NoCtx) const {
        const int pn = u.pn;
        if (pn < 4) { *(u32x4*)(U + (size_t)row * D + pn * 256 + col) = pack8(v); return 0.f; }
        if (pn < 8) {
            float s = 0.f;
#pragma unroll
            for (int j = 0; j < 8; ++j) s += v[j] * v[j];
            if (pn < 7) *(u32x4*)(QLp + (size_t)row * QL + (pn - 4) * 256 + col) = pack8(v);
            else *(u32x4*)(KVLp + (size_t)row * KVL + col) = pack8(v);
            return s;
        }
        if (pn < 16) {
            const int gc = (pn - 8) * 256 + col; const f32x4 b0 = *(const f32x4*)(bgate + gc), b1 = *(const f32x4*)(bgate + gc + 4);
            float o[8];
#pragma unroll
            for (int j = 0; j < 4; ++j) { o[j] = sigmoidf_(v[j] + b0[j]); o[4 + j] = sigmoidf_(v[4 + j] + b1[j]); }
            *(u32x4*)(GATES + (size_t)row * 2048 + gc) = pack8(o); return 0.f;
        }
        if (col < 64) {
            const int g = col >> 3; float y1[4], y2[4];
#pragma unroll
            for (int i = 0; i < 4; ++i) { const f32x2 cs = CS[(size_t)row * 32 + 4 * g + i]; y1[i] = v[i] * cs.x - v[4 + i] * cs.y; y2[i] = v[4 + i] * cs.x + v[i] * cs.y; }
            u32x2 a, b; a.x = pk2(y1[0], y1[1]); a.y = pk2(y1[2], y1[3]); b.x = pk2(y2[0], y2[1]); b.y = pk2(y2[2], y2[3]);
            *(u32x2*)(KPE + (size_t)row * 64 + 4 * g) = a; *(u32x2*)(KPE + (size_t)row * 64 + 32 + 4 * g) = b;
        }
        return 0.f;
    }
};
struct EpiQ {
    static constexpr bool SUMSQ = false, COLMAJOR = false; typedef NoCtx ColCtx;
    bf16_t* Q; const float* PSQQ; const f32x2* CS;
    __device__ __forceinline__ float row_ctx(const Unit&, int row) const {
        const f32x4* p = (const f32x4*)(PSQQ + (size_t)row * 12); const f32x4 a = p[0], b = p[1], c = p[2];
        const float s = ((a[0] + a[1]) + (a[2] + a[3])) + ((b[0] + b[1]) + (b[2] + b[3])) + ((c[0] + c[1]) + (c[2] + c[3]));
        return rsqrtf(s * (1.0f / QL) + EPS) * QSCALE; }
    __device__ __forceinline__ NoCtx col_ctx(const Unit&, int) const { return NoCtx{}; }
    __device__ __forceinline__ bool want_partial(const Unit&) const { return false; }
    __device__ __forceinline__ void partial(const Unit&, int, int, float) const {}
    __device__ __forceinline__ float apply(const Unit& u, int row, int col, float (&v)[8], float rs, NoCtx) const {
#pragma unroll
        for (int j = 0; j < 8; ++j) v[j] *= rs;
        if (u.pn < 4) { const int p = u.pn * 256 + col, hh = p >> 7, d = p & 127; *(u32x4*)(Q + (size_t)row * (NH * QKD) + hh * QKD + d) = pack8(v); }
        else { const int r = (u.pn - 4) * 256 + col, hh = r >> 6, g = (r & 63) >> 3; float y1[4], y2[4];
#pragma unroll
            for (int i = 0; i < 4; ++i) { const f32x2 cs = CS[(size_t)row * 32 + 4 * g + i]; y1[i] = v[i] * cs.x - v[4 + i] * cs.y; y2[i] = v[4 + i] * cs.x + v[i] * cs.y; }
            u32x2 a, b; a.x = pk2(y1[0], y1[1]); a.y = pk2(y1[2], y1[3]); b.x = pk2(y2[0], y2[1]); b.y = pk2(y2[2], y2[3]);
            bf16_t* q = Q + (size_t)row * (NH * QKD) + hh * QKD + NOPE; *(u32x2*)(q + 4 * g) = a; *(u32x2*)(q + 32 + 4 * g) = b; }
        return 0.f;
    }
};
__device__ __forceinline__ float rstd_kv(const float* PSQKV, int t) { const f32x4 a = *(const f32x4*)(PSQKV + (size_t)t * 4); return rsqrtf(((a[0] + a[1]) + (a[2] + a[3])) * (1.0f / KVL) + EPS); }
struct EpiK {
    static constexpr bool SUMSQ = false, COLMAJOR = false; typedef NoCtx ColCtx;
    bf16_t* KN; const float* PSQKV;
    __device__ __forceinline__ float row_ctx(const Unit&, int row) const { return rstd_kv(PSQKV, row); }
    __device__ __forceinline__ NoCtx col_ctx(const Unit&, int) const { return NoCtx{}; }
    __device__ __forceinline__ bool want_partial(const Unit&) const { return false; }
    __device__ __forceinline__ void partial(const Unit&, int, int, float) const {}
    __device__ __forceinline__ float apply(const Unit& u, int row, int col, float (&v)[8], float rs, NoCtx) const {
#pragma unroll
        for (int j = 0; j < 8; ++j) v[j] *= rs;
        *(u32x4*)(KN + (size_t)row * D + u.pn * 256 + col) = pack8(v); return 0.f; }
};
struct Ctx8 { float s[8]; };
struct EpiVT {
    static constexpr bool SUMSQ = false, COLMAJOR = true; typedef Ctx8 ColCtx;
    bf16_t* VT; const float* PSQKV;
    __device__ __forceinline__ float row_ctx(const Unit&, int) const { return 0.f; }
    __device__ __forceinline__ Ctx8 col_ctx(const Unit& u, int col) const { Ctx8 c; const int t0 = u.pn * 256 + col;
#pragma unroll
        for (int j = 0; j < 8; ++j) c.s[j] = rstd_kv(PSQKV, t0 + j);
        return c; }
    __device__ __forceinline__ bool want_partial(const Unit&) const { return false; }
    __device__ __forceinline__ void partial(const Unit&, int, int, float) const {}
    __device__ __forceinline__ float apply(const Unit& u, int row, int col, float (&v)[8], float, const Ctx8& cc) const {
#pragma unroll
        for (int j = 0; j < 8; ++j) v[j] *= cc.s[j];
        *(u32x4*)(VT + (size_t)row * T + u.pn * 256 + col) = pack8(v); return 0.f; }
};
struct EpiPlain {
    static constexpr bool SUMSQ = false, COLMAJOR = false; typedef NoCtx ColCtx;
    bf16_t* O; int ldc;
    __device__ __forceinline__ float row_ctx(const Unit&, int) const { return 0.f; }
    __device__ __forceinline__ NoCtx col_ctx(const Unit&, int) const { return NoCtx{}; }
    __device__ __forceinline__ bool want_partial(const Unit&) const { return false; }
    __device__ __forceinline__ void partial(const Unit&, int, int, float) const {}
    __device__ __forceinline__ float apply(const Unit& u, int row, int col, float (&v)[8], float, NoCtx) const {
        *(u32x4*)(O + (size_t)row * ldc + u.pn * 256 + col) = pack8(v); return 0.f; }
};
template <int MODE> struct EpiMerge {
    static constexpr bool SUMSQ = false, COLMAJOR = false; typedef NoCtx ColCtx;
    bf16_t* MG; const bf16_t* GATES;
    __device__ __forceinline__ float row_ctx(const Unit&, int) const { return 0.f; }
    __device__ __forceinline__ NoCtx col_ctx(const Unit&, int) const { return NoCtx{}; }
    __device__ __forceinline__ bool want_partial(const Unit&) const { return false; }
    __device__ __forceinline__ void partial(const Unit&, int, int, float) const {}
    __device__ __forceinline__ float apply(const Unit& u, int row, int col, float (&v)[8], float, NoCtx) const {
        const int c = u.pn * 256 + col; float g[8]; unpack8(*(const u32x4*)(GATES + (size_t)row * 2048 + MODE * 1024 + c), g);
        bf16_t* p = MG + (size_t)row * D + c;
        if (MODE == 0) {
#pragma unroll
            for (int j = 0; j < 8; ++j) v[j] *= g[j];
        } else {
            unsigned long long* p8 = (unsigned long long*)p;
            const unsigned long long lo = __hip_atomic_load(p8, __ATOMIC_RELAXED, __HIP_MEMORY_SCOPE_AGENT), hi = __hip_atomic_load(p8 + 1, __ATOMIC_RELAXED, __HIP_MEMORY_SCOPE_AGENT);
            u32x4 w; w.x = (unsigned)lo; w.y = (unsigned)(lo >> 32); w.z = (unsigned)hi; w.w = (unsigned)(hi >> 32); float a[8]; unpack8(w, a);
#pragma unroll
            for (int j = 0; j < 8; ++j) v[j] = a[j] + v[j] * g[j];
        }
        *(u32x4*)p = pack8(v); return 0.f; }
};
struct EpiOut {
    static constexpr bool SUMSQ = false, COLMAJOR = false; typedef NoCtx ColCtx;
    const float* X; float* X1; const float* MOD;
    __device__ __forceinline__ float row_ctx(const Unit&, int) const { return 0.f; }
    __device__ __forceinline__ NoCtx col_ctx(const Unit&, int) const { return NoCtx{}; }
    __device__ __forceinline__ bool want_partial(const Unit&) const { return false; }
    __device__ __forceinline__ void partial(const Unit&, int, int, float) const {}
    __device__ __forceinline__ float apply(const Unit& u, int row, int col, float (&v)[8], float, NoCtx) const {
        const int c = u.pn * 256 + col, b = row >> 12; const float* g1 = MOD + b * 6144 + 2 * 1024 + c; const float* xr = X + (size_t)row * D + c; float* o = X1 + (size_t)row * D + c;
        const f32x4 g0 = *(const f32x4*)g1, g1v = *(const f32x4*)(g1 + 4), x0 = *(const f32x4*)xr, x1v = *(const f32x4*)(xr + 4);
        f32x4 o0, o1;
#pragma unroll
        for (int j = 0; j < 4; ++j) { o0[j] = x0[j] + g0[j] * v[j]; o1[j] = x1v[j] + g1v[j] * v[4 + j]; }
        *(f32x4*)o = o0; *(f32x4*)(o + 4) = o1; return 0.f; }
};
struct EpiGU {
    static constexpr bool SUMSQ = false, COLMAJOR = false; typedef NoCtx ColCtx;
    bf16_t* ACT; const float* bgu;
    __device__ __forceinline__ float row_ctx(const Unit&, int) const { return 0.f; }
    __device__ __forceinline__ NoCtx col_ctx(const Unit&, int) const { return NoCtx{}; }
    __device__ __forceinline__ bool want_partial(const Unit&) const { return false; }
    __device__ __forceinline__ void partial(const Unit&, int, int, float) const {}
    __device__ __forceinline__ float apply(const Unit& u, int row, int col, float (&v)[8], float, NoCtx) const {
        const int p = u.pn * 256 + col; const float* bp = bgu + (size_t)u.e * 2048 + p; const f32x4 b0 = *(const f32x4*)bp, b1 = *(const f32x4*)(bp + 4);
        const float bb[8] = {b0[0], b0[1], b0[2], b0[3], b1[0], b1[1], b1[2], b1[3]}; float a[4];
#pragma unroll
        for (int i = 0; i < 4; ++i) { float gt = v[i] + bb[2 * i], up = v[4 + i] + bb[2 * i + 1]; gt = fminf(gt, 7.0f); up = fminf(fmaxf(up, -7.0f), 7.0f);
            a[i] = (up + 1.0f) * (gt * sigmoidf_(1.702f * gt)); }
        u32x2 w; w.x = pk2(a[0], a[1]); w.y = pk2(a[2], a[3]); *(u32x2*)(ACT + (size_t)row * DE + (p >> 1)) = w; return 0.f; }
};
struct EpiDown {
    static constexpr bool SUMSQ = false, COLMAJOR = false; typedef NoCtx ColCtx;
    bf16_t* Y; const float* bdn; const float* ROWW;
    __device__ __forceinline__ float row_ctx(const Unit&, int row) const { return ROWW[row]; }
    __device__ __forceinline__ NoCtx col_ctx(const Unit&, int) const { return NoCtx{}; }
    __device__ __forceinline__ bool want_partial(const Unit&) const { return false; }
    __device__ __forceinline__ void partial(const Unit&, int, int, float) const {}
    __device__ __forceinline__ float apply(const Unit& u, int row, int col, float (&v)[8], float rw, NoCtx) const {
        const int c = u.pn * 256 + col; const float* bp = bdn + (size_t)u.e * D + c; const f32x4 b0 = *(const f32x4*)bp, b1 = *(const f32x4*)(bp + 4);
#pragma unroll
        for (int j = 0; j < 4; ++j) { v[j] = (v[j] + b0[j]) * rw; v[4 + j] = (v[4 + j] + b1[j]) * rw; }
        *(u32x4*)(Y + (size_t)row * D + c) = pack8(v); return 0.f; }
};

__device__ __forceinline__ void tr_item(const float* src, int Nsrc, bf16_t* dst, int K, int kb, int pb, int lb, int perm, bool zero, const float* rs, const float* cs, LAS float* scr, int lane) {
    const int k0 = kb * 64;
#pragma unroll 4
    for (int it = 0; it < 16; ++it) {
        const int kk = 4 * it + (lane >> 4), o4 = 4 * (lane & 15);
        f32x4 v = (f32x4){0.f, 0.f, 0.f, 0.f};
        if (!zero) { v = *(const f32x4*)(src + (size_t)(k0 + kk) * Nsrc + lb + o4);
            if (rs) v *= rs[k0 + kk];
            if (cs) v *= *(const f32x4*)(cs + lb + o4); }
        int ph;
        if (perm == 1) ph = 8 * ((o4 & 31) >> 2) + 4 * (o4 >> 5);
        else if (perm == 2) ph = 8 * (o4 >> 3);
        else ph = o4;
        LAS float* s = scr + kk * 65;
        if (perm == 2) { const int w0 = o4 & 7;
            s[ph + 4 * ((w0 + 0) & 1) + ((w0 + 0) >> 1)] = v[0]; s[ph + 4 * ((w0 + 1) & 1) + ((w0 + 1) >> 1)] = v[1];
            s[ph + 4 * ((w0 + 2) & 1) + ((w0 + 2) >> 1)] = v[2]; s[ph + 4 * ((w0 + 3) & 1) + ((w0 + 3) >> 1)] = v[3]; }
        else { s[ph] = v[0]; s[ph + 1] = v[1]; s[ph + 2] = v[2]; s[ph + 3] = v[3]; }
    }
    asm volatile("s_waitcnt lgkmcnt(0)" ::: "memory");
    const int c = lane & 7;
#pragma unroll
    for (int j = 0; j < 8; ++j) { const int p = (lane >> 3) + 8 * j; const LAS float* s = scr + (8 * c) * 65 + p;
        u32x4 o; o.x = pk2(s[0 * 65], s[1 * 65]); o.y = pk2(s[2 * 65], s[3 * 65]); o.z = pk2(s[4 * 65], s[5 * 65]); o.w = pk2(s[6 * 65], s[7 * 65]);
        *(u32x4*)(dst + (size_t)(pb * 64 + p) * K + k0 + 8 * c) = o; }
    asm volatile("s_waitcnt lgkmcnt(0)" ::: "memory");
}

__device__ __forceinline__ void p0_prep(const Args& a, LAS unsigned char* lds, int vcu, int G) {
    const int tid = threadIdx.x, lane = tid & 63, wave = __builtin_amdgcn_readfirstlane(tid >> 6);
    unsigned char* ws = a.ws;
    for (int item = vcu; item < 128; item += G) {
        LAS float* cact = (LAS float*)lds;
        LAS float* part = (LAS float*)(lds + 32768);
        for (int i = tid; i < 8 * 1024; i += NTHREADS) { const float cv = a.in[I_C][i]; cact[i] = cv / (1.0f + __expf(-cv)); }
        __syncthreads();
        const bool isf = item >= 96; const float* W = isf ? a.in[I_WFMOD] : a.in[I_WMOD]; const int N = isf ? 2048 : 6144, j0 = (isf ? item - 96 : item) * 64;
        float acc[8];
#pragma unroll
        for (int b = 0; b < 8; ++b) acc[b] = 0.f;
        for (int k = wave * 128; k < wave * 128 + 128; ++k) { const float w = W[(size_t)k * N + j0 + lane];
#pragma unroll
            for (int b = 0; b < 8; ++b) acc[b] += cact[b * 1024 + k] * w; }
#pragma unroll
        for (int b = 0; b < 8; ++b) part[(wave * 8 + b) * 64 + lane] = acc[b];
        __syncthreads();
        { const int b = tid >> 6, col = tid & 63; float s = 0.f;
#pragma unroll
            for (int w = 0; w < 8; ++w) s += part[(w * 8 + b) * 64 + col];
            if (isf) ((float*)(ws + WS_FMOD))[b * 2048 + j0 + col] = s + a.in[I_BFMOD][j0 + col];
            else ((float*)(ws + WS_MOD))[b * 6144 + j0 + col] = s + a.in[I_BMOD][j0 + col]; }
        __syncthreads();
    }
    { const int* pos = (const int*)a.in[I_POS]; f32x2* CS = (f32x2*)(ws + WS_CS);
        for (int idx = vcu * NTHREADS + tid; idx < T * 32; idx += G * NTHREADS) { const int t = idx >> 5, i = idx & 31;
            const double invf = exp(-(double)i * (9.210340371976184 / 32.0));
            const double ang = (double)pos[t] * invf; const double n = rint(ang * 0.15915494309189535); const float r = (float)(ang - n * 6.283185307179586);
            CS[idx] = (f32x2){__cosf(r), __sinf(r)}; } }
    { bf16_t* WR = (bf16_t*)(ws + WS_WR);
        for (int idx = vcu * NTHREADS + tid; idx < 1024 * 32; idx += G * NTHREADS) { const int e = idx & 31, k = idx >> 5; const float v = a.in[I_WR][idx];
            const unsigned h = pk2(v, 0.f) & 0xffffu; const float lo = v - bflo(h); WR[e * 1024 + k] = (bf16_t)h; WR[32768 + e * 1024 + k] = (bf16_t)(pk2(lo, 0.f) & 0xffffu); } }
    LAS float* scr = (LAS float*)(lds + wave * 16640);
    const int gw = vcu * 8 + wave, NGW = G * 8;
    constexpr int N_IN = 16 * 68, N_Q = 12 * 24, N_K = 4 * 16, N_V = 4 * 16, N_G = 4 * 16, N_SQ = 16 * 16, N_GU = 32 * 16 * 32, N_DN = 32 * 16 * 16;
    constexpr int NITEMS = N_IN + N_Q + N_K + N_V + N_G + 3 * N_SQ + N_GU + N_DN;
    for (int it = gw; it < NITEMS; it += NGW) {
        int r = it;
        if (r < N_IN) { const int pb = r % 68, kb = r / 68; int lb, perm = 0; bool zero = false;
            if (pb < 32) lb = pb * 64; else if (pb < 64) lb = pb * 64 + 64; else if (pb == 64) { lb = 2048; perm = 1; } else { lb = 0; zero = true; }
            tr_item(a.in[I_WIN], IN_W, (bf16_t*)(ws + WS_WIN), 1024, kb, pb, lb, perm, zero, nullptr, nullptr, scr, lane); continue; } r -= N_IN;
        if (r < N_Q) { const int pb = r % 24, kb = r / 24; int lb, perm = 0;
            if (pb < 16) lb = (pb >> 1) * QKD + (pb & 1) * 64; else { lb = (pb - 16) * QKD + NOPE; perm = 1; }
            tr_item(a.in[I_WQB], NH * QKD, (bf16_t*)(ws + WS_WQ), QL, kb, pb, lb, perm, false, a.in[I_GQA], nullptr, scr, lane); continue; } r -= N_Q;
        if (r < N_K) { const int pb = r % 16, kb = r / 16; const int lb = (pb >> 1) * 256 + (pb & 1) * 64;
            tr_item(a.in[I_WKVB], NH * 256, (bf16_t*)(ws + WS_WK), KVL, kb, pb, lb, 0, false, a.in[I_GKVA], nullptr, scr, lane); continue; } r -= N_K;
        if (r < N_V) { const int pb = r % 16, kb = r / 16; const int lb = (pb >> 1) * 256 + 128 + (pb & 1) * 64;
            tr_item(a.in[I_WKVB], NH * 256, (bf16_t*)(ws + WS_WV), KVL, kb, pb, lb, 0, false, a.in[I_GKVA], nullptr, scr, lane); continue; } r -= N_V;
        if (r < N_G) { const int g = r / 16, q = r % 16, pb = q % 4, kb = q / 4;
            tr_item(a.in[I_WPG] + (size_t)g * 65536, 256, (bf16_t*)(ws + WS_WGRP) + (size_t)g * 65536, 256, kb, pb, pb * 64, 0, false, nullptr, a.in[I_PSCALE] + g * 256, scr, lane); continue; } r -= N_G;
        if (r < 3 * N_SQ) { const int which = r / N_SQ, q = r % N_SQ, pb = q % 16, kb = q / 16;
            const float* src = which == 0 ? a.in[I_WPO] : which == 1 ? a.in[I_WMO] : a.in[I_WOUT]; const size_t off = which == 0 ? WS_WPO : which == 1 ? WS_WMO : WS_WOUT;
            tr_item(src, 1024, (bf16_t*)(ws + off), 1024, kb, pb, pb * 64, 0, false, nullptr, nullptr, scr, lane); continue; } r -= 3 * N_SQ;
        if (r < N_GU) { const int e = r / 512, q = r % 512, pb = q % 32, kb = q / 32;
            tr_item(a.in[I_WGU] + (size_t)e * 1024 * 2048, 2048, (bf16_t*)(ws + WS_WGU) + (size_t)e * 2048 * 1024, 1024, kb, pb, pb * 64, 2, false, nullptr, nullptr, scr, lane); continue; } r -= N_GU;
        { const int e = r / 256, q = r % 256, pb = q % 16, kb = q / 16;
            tr_item(a.in[I_WDN] + (size_t)e * 1024 * 1024, 1024, (bf16_t*)(ws + WS_WDN) + (size_t)e * 1024 * 1024, 1024, kb, pb, pb * 64, 0, false, nullptr, nullptr, scr, lane); }
    }
}

__device__ __forceinline__ void p1_hb(const Args& a, int vcu, int G) {
    const int tid = threadIdx.x, lane = tid & 63, wave = tid >> 6;
    const float* MOD = (const float*)(a.ws + WS_MOD); bf16_t* HB = (bf16_t*)(a.ws + WS_S0);
    for (int rb = vcu * 128; rb < T; rb += G * 128) {
        const int b = rb >> 12;
        f32x4 gs[4], sh[4];
#pragma unroll
        for (int j = 0; j < 4; ++j) { const int c = 4 * lane + 256 * j; const f32x4 g = *(const f32x4*)(a.in[I_GMIX] + c), sc = *(const f32x4*)(MOD + b * 6144 + 1024 + c);
            gs[j] = g * (sc + 1.0f); sh[j] = *(const f32x4*)(MOD + b * 6144 + c); }
        for (int i = 0; i < 16; ++i) { const int r = rb + wave * 16 + i; const f32x4* xr = (const f32x4*)(a.in[I_X] + (size_t)r * D) + lane;
            f32x4 v[4]; float s = 0.f;
#pragma unroll
            for (int j = 0; j < 4; ++j) { v[j] = xr[64 * j]; s += (v[j][0] * v[j][0] + v[j][1] * v[j][1]) + (v[j][2] * v[j][2] + v[j][3] * v[j][3]); }
            const float rstd = rsqrtf(wave_sum(s) * (1.0f / D) + EPS);
            u32x2* o = (u32x2*)(HB + (size_t)r * D) + lane;
#pragma unroll
            for (int j = 0; j < 4; ++j) { const f32x4 h = v[j] * rstd * gs[j] + sh[j]; u32x2 w; w.x = pk2(h[0], h[1]); w.y = pk2(h[2], h[3]); o[64 * j] = w; } }
    }
}

__device__ __forceinline__ void p3_mixed(const Args& a, int vcu, int G) {
    const int tid = threadIdx.x; const bf16_t* U = (const bf16_t*)(a.ws + WS_S1); bf16_t* MX = (bf16_t*)(a.ws + WS_S0);
    for (int rb = vcu * 128; rb < T; rb += G * 128) {
        for (int q = 0; q < 2; ++q) { const int item = tid + NTHREADS * q, cgi = item & 127, seg = item >> 7;
            const int w = 2 << (cgi >> 5), row0 = rb + seg * 16, s0 = row0 & (SEQ - 1);
            float sum[8];
#pragma unroll
            for (int j = 0; j < 8; ++j) sum[j] = 0.f;
            for (int k = 1; k < w; ++k) if (s0 - k >= 0) { float f[8]; unpack8(*(const u32x4*)(U + (size_t)(row0 - k) * D + cgi * 8), f);
#pragma unroll
                for (int j = 0; j < 8; ++j) sum[j] += f[j]; }
            for (int i = 0; i < 16; ++i) { const int r = row0 + i, s = s0 + i; float cur[8]; unpack8(*(const u32x4*)(U + (size_t)r * D + cgi * 8), cur);
                const float inv = 1.0f / (float)(s + 1 < w ? s + 1 : w); float o[8];
#pragma unroll
                for (int j = 0; j < 8; ++j) { sum[j] += cur[j]; o[j] = sum[j] * inv - cur[j]; }
                *(u32x4*)(MX + (size_t)r * D + cgi * 8) = pack8(o);
                if (s - (w - 1) >= 0) { float f[8]; unpack8(*(const u32x4*)(U + (size_t)(r - (w - 1)) * D + cgi * 8), f);
#pragma unroll
                    for (int j = 0; j < 8; ++j) sum[j] -= f[j]; } }
        }
    }
}

__device__ __forceinline__ void attn_naive(const Args& a, LAS unsigned char* lds, int vcu, int G) {
    const int tid = threadIdx.x, qi = tid >> 3, part = tid & 7;
    const bf16_t* Q = (const bf16_t*)(a.ws + WS_Q); const bf16_t* KN = (const bf16_t*)(a.ws + WS_KN); const bf16_t* KPE = (const bf16_t*)(a.ws + WS_KPE);
    const bf16_t* VT = (const bf16_t*)(a.ws + WS_VT); bf16_t* O = (bf16_t*)(a.ws + WS_O);
    LAS unsigned char* Qs = lds;
    LAS unsigned char* Ks = lds + 25600;
    LAS unsigned char* Vs = lds + 51200;
    LAS float* Ss = (LAS float*)(lds + 69632);
    for (int it = vcu; it < NB * NH * 64; it += G) {
        const int c = 63 - (it & 63), bh = it >> 6, b = bh >> 3, h = bh & 7; const int t0 = b * SEQ + c * 64;
        __syncthreads();
#pragma unroll
        for (int i = 0; i < 3; ++i) { const int ch = tid + NTHREADS * i, row = ch / 24, kc = ch % 24;
            *(LAS u32x4*)(Qs + row * 400 + kc * 16) = *(const u32x4*)(Q + (size_t)(t0 + row) * (NH * QKD) + h * QKD + kc * 8); }
        float m = -1e30f, l = 0.f, o[16];
#pragma unroll
        for (int dd = 0; dd < 16; ++dd) o[dd] = 0.f;
        for (int kt = 0; kt <= c; ++kt) {
            const int k0 = b * SEQ + kt * 64;
            __syncthreads();
#pragma unroll
            for (int i = 0; i < 2; ++i) { const int ch = tid + NTHREADS * i, row = ch >> 4, kc = ch & 15;
                *(LAS u32x4*)(Ks + row * 400 + kc * 16) = *(const u32x4*)(KN + (size_t)(k0 + row) * D + h * 128 + kc * 8); }
            { const int row = tid >> 3, kc = tid & 7; *(LAS u32x4*)(Ks + row * 400 + 256 + kc * 16) = *(const u32x4*)(KPE + (size_t)(k0 + row) * 64 + kc * 8); }
#pragma unroll
            for (int i = 0; i < 2; ++i) { const int ch = tid + NTHREADS * i, d = ch >> 3, kc = ch & 7;
                *(LAS u32x4*)(Vs + d * 144 + kc * 16) = *(const u32x4*)(VT + (size_t)(h * 128 + d) * T + k0 + kc * 8); }
            __syncthreads();
            float s[8];
#pragma unroll
            for (int j = 0; j < 8; ++j) s[j] = 0.f;
            for (int d8 = 0; d8 < 24; ++d8) { float q8[8]; unpack8(*(const LAS u32x4*)(Qs + qi * 400 + d8 * 16), q8);
#pragma unroll
                for (int j = 0; j < 8; ++j) { float k8[8]; unpack8(*(const LAS u32x4*)(Ks + (part * 8 + j) * 400 + d8 * 16), k8);
#pragma unroll
                    for (int e = 0; e < 8; ++e) s[j] += q8[e] * k8[e]; } }
#pragma unroll
            for (int j = 0; j < 8; ++j) Ss[qi * 65 + part * 8 + j] = s[j];
            __syncthreads();
            float mx = -1e30f;
            for (int k = 0; k < 64; ++k) mx = fmaxf(mx, Ss[qi * 65 + k]);
            const float mn = fmaxf(m, mx), alpha = exp2f(m - mn); float ls = 0.f;
            for (int k = 0; k < 64; ++k) ls += exp2f(Ss[qi * 65 + k] - mn);
            l = l * alpha + ls; m = mn;
#pragma unroll
            for (int dd = 0; dd < 16; ++dd) o[dd] *= alpha;
            for (int k8 = 0; k8 < 8; ++k8) { float p8[8];
#pragma unroll
                for (int e = 0; e < 8; ++e) p8[e] = exp2f(Ss[qi * 65 + k8 * 8 + e] - mn);
#pragma unroll
                for (int dd = 0; dd < 16; ++dd) { float v8[8]; unpack8(*(const LAS u32x4*)(Vs + (part * 16 + dd) * 144 + k8 * 16), v8);
#pragma unroll
                    for (int e = 0; e < 8; ++e) o[dd] += p8[e] * v8[e]; } }
        }
        const float il = 1.0f / l; float o0[8], o1[8];
#pragma unroll
        for (int j = 0; j < 8; ++j) { o0[j] = o[j] * il; o1[j] = o[8 + j] * il; }
        bf16_t* op = O + (size_t)(t0 + qi) * D + h * 128 + part * 16; *(u32x4*)op = pack8(o0); *(u32x4*)(op + 8) = pack8(o1);
    }
    __syncthreads();
}

typedef float f32x16 __attribute__((ext_vector_type(16)));
__device__ __forceinline__ int kperm(int r) { return (r & ~12) | ((r & 4) << 1) | ((r & 8) >> 1); }
__device__ __forceinline__ void attn_fast(const Args& a, LAS unsigned char* lds, int vcu, int G) {
    const int tid = threadIdx.x, lane = tid & 63, wid = __builtin_amdgcn_readfirstlane(tid >> 6), i32 = lane & 31, hi = lane >> 5;
    const bf16_t* Q = (const bf16_t*)(a.ws + WS_Q); const bf16_t* KN = (const bf16_t*)(a.ws + WS_KN); const bf16_t* KPE = (const bf16_t*)(a.ws + WS_KPE);
    const bf16_t* VT = (const bf16_t*)(a.ws + WS_VT); bf16_t* O = (bf16_t*)(a.ws + WS_O);
    constexpr int BUF = 40960, KP_OFF = 16384, VT_OFF = 24576;
    const int rK = 4 * wid + (lane >> 4); const unsigned srcK = (unsigned)(kperm(rK) * 1024 + (((lane & 15) ^ (rK & 15)) * 8));
    const int rP = 8 * wid + (lane >> 3); const unsigned srcP = (unsigned)(kperm(rP) * 64 + (((lane & 7) ^ ((rP >> 1) & 7)) * 8));
    const int dV = 8 * wid + (lane >> 3); const size_t srcV = (size_t)dV * T + (size_t)(((lane & 7) ^ ((dV >> 1) & 7)) * 8);
    const int xk = i32 & 15, xp = (i32 >> 1) & 7;
    int koff[8], poff[4], voff[4];
#pragma unroll
    for (int ds = 0; ds < 8; ++ds) koff[ds] = i32 * 256 + (((2 * ds + hi) ^ xk) << 4);
#pragma unroll
    for (int ds = 0; ds < 4; ++ds) poff[ds] = KP_OFF + i32 * 128 + (((2 * ds + hi) ^ xp) << 4);
#pragma unroll
    for (int c = 0; c < 4; ++c) voff[c] = VT_OFF + i32 * 128 + (((2 * c + hi) ^ xp) << 4);
    const int nun = (G == 256) ? 4 : (NB * NH * 16 + G - 1) / G;
    for (int ui = 0; ui < nun; ++ui) {
        int bh, qb;
        if (G == 256) { const int s4 = vcu & 3; bh = vcu >> 2; qb = ui == 0 ? 15 - s4 : ui == 1 ? s4 : ui == 2 ? 11 - s4 : 4 + s4; }
        else { const int it = vcu + ui * G; if (it >= NB * NH * 16) break; bh = it >> 4; qb = 15 - (it & 15); }
        const int b = bh >> 3, h = bh & 7, t0 = b * SEQ + qb * 256, NT = 4 * qb + 4, myjmax = 4 * qb + (wid >> 1);
        const bf16_t* gK = KN + (size_t)b * SEQ * 1024 + h * 128 + srcK; const bf16_t* gP = KPE + (size_t)b * SEQ * 64 + srcP; const bf16_t* gV = VT + (size_t)(h * 128) * T + (size_t)b * SEQ + srcV;
#define ATT_STAGE(j, bo) do { \
        __builtin_amdgcn_global_load_lds((const unsigned*)(gK + (size_t)(j) * 65536), (LAS unsigned*)(lds + (bo) + wid * 1024), 16, 0, 0); \
        __builtin_amdgcn_global_load_lds((const unsigned*)(gK + (size_t)(j) * 65536 + 32768), (LAS unsigned*)(lds + (bo) + 8192 + wid * 1024), 16, 0, 0); \
        __builtin_amdgcn_global_load_lds((const unsigned*)(gP + (size_t)(j) * 4096), (LAS unsigned*)(lds + (bo) + KP_OFF + wid * 1024), 16, 0, 0); \
        __builtin_amdgcn_global_load_lds((const unsigned*)(gV + (size_t)(j) * 64), (LAS unsigned*)(lds + (bo) + VT_OFF + wid * 1024), 16, 0, 0); \
        __builtin_amdgcn_global_load_lds((const unsigned*)(gV + (size_t)(j) * 64 + (size_t)64 * T), (LAS unsigned*)(lds + (bo) + VT_OFF + 8192 + wid * 1024), 16, 0, 0); } while (0)
        ATT_STAGE(0, 0);
        bf16x8 qf[12];
        { const bf16_t* qp = Q + (size_t)(t0 + 32 * wid + i32) * (NH * QKD) + h * QKD + 8 * hi;
#pragma unroll
            for (int ds = 0; ds < 12; ++ds) qf[ds] = *(const bf16x8*)(qp + 16 * ds); }
        f32x16 o[4];
#pragma unroll
        for (int d = 0; d < 4; ++d)
#pragma unroll
            for (int r = 0; r < 16; ++r) o[d][r] = 0.f;
        float m = -1e30f, l = 0.f;
        asm volatile("s_waitcnt vmcnt(0)" ::: "memory");
        __syncthreads();
        for (int j = 0; j < NT; ++j) {
            const int bo = (j & 1) * BUF;
            if (j + 1 < NT) ATT_STAGE(j + 1, BUF - bo);
            if (j <= myjmax) {
                const LAS unsigned char* kb = lds + bo;
                f32x16 p0, p1;
#pragma unroll
                for (int r = 0; r < 16; ++r) { p0[r] = 0.f; p1[r] = 0.f; }
#pragma unroll
                for (int ds = 0; ds < 8; ++ds) { const bf16x8 k0 = *(const LAS bf16x8*)(kb + koff[ds]), k1 = *(const LAS bf16x8*)(kb + koff[ds] + 8192);
                    p0 = __builtin_amdgcn_mfma_f32_32x32x16_bf16(k0, qf[ds], p0, 0, 0, 0); p1 = __builtin_amdgcn_mfma_f32_32x32x16_bf16(k1, qf[ds], p1, 0, 0, 0); }
#pragma unroll
                for (int ds = 0; ds < 4; ++ds) { const bf16x8 k0 = *(const LAS bf16x8*)(kb + poff[ds]), k1 = *(const LAS bf16x8*)(kb + poff[ds] + 4096);
                    p0 = __builtin_amdgcn_mfma_f32_32x32x16_bf16(k0, qf[8 + ds], p0, 0, 0, 0); p1 = __builtin_amdgcn_mfma_f32_32x32x16_bf16(k1, qf[8 + ds], p1, 0, 0, 0); }
                float mx = fmaxf(p0[0], p1[0]);
#pragma unroll
                for (int r = 1; r < 16; ++r) mx = fmaxf(mx, fmaxf(p0[r], p1[r]));
                mx = fmaxf(mx, __shfl_xor(mx, 32));
                const float mn = fmaxf(m, mx), alpha = __builtin_amdgcn_exp2f(m - mn); m = mn;
                float ls = 0.f;
#pragma unroll
                for (int r = 0; r < 16; ++r) { p0[r] = __builtin_amdgcn_exp2f(p0[r] - mn); p1[r] = __builtin_amdgcn_exp2f(p1[r] - mn); ls += p0[r] + p1[r]; }
                l = l * alpha + ls;
                if (__any(alpha != 1.0f)) {
#pragma unroll
                    for (int d = 0; d < 4; ++d)
#pragma unroll
                        for (int r = 0; r < 16; ++r) o[d][r] *= alpha;
                }
                bf16x8 pk[4];
#pragma unroll
                for (int s = 0; s < 2; ++s) {
                    u32x4 w0, w1;
                    w0.x = pk2(p0[8 * s + 0], p0[8 * s + 1]); w0.y = pk2(p0[8 * s + 2], p0[8 * s + 3]); w0.z = pk2(p0[8 * s + 4], p0[8 * s + 5]); w0.w = pk2(p0[8 * s + 6], p0[8 * s + 7]);
                    w1.x = pk2(p1[8 * s + 0], p1[8 * s + 1]); w1.y = pk2(p1[8 * s + 2], p1[8 * s + 3]); w1.z = pk2(p1[8 * s + 4], p1[8 * s + 5]); w1.w = pk2(p1[8 * s + 6], p1[8 * s + 7]);
                    pk[s] = __builtin_bit_cast(bf16x8, w0); pk[2 + s] = __builtin_bit_cast(bf16x8, w1);
                }
#pragma unroll
                for (int d = 0; d < 4; ++d)
#pragma unroll
                    for (int c = 0; c < 4; ++c) { const bf16x8 vf = *(const LAS bf16x8*)(kb + voff[c] + d * 4096);
                        o[d] = __builtin_amdgcn_mfma_f32_32x32x16_bf16(vf, pk[c], o[d], 0, 0, 0); }
            }
            asm volatile("s_waitcnt vmcnt(0)" ::: "memory");
            __syncthreads();
        }
#undef ATT_STAGE
        l += __shfl_xor(l, 32);
        const float il = 1.0f / l;
        bf16_t* op = O + (size_t)(t0 + 32 * wid + i32) * D + h * 128 + 4 * hi;
#pragma unroll
        for (int d = 0; d < 4; ++d)
#pragma unroll
            for (int g4 = 0; g4 < 4; ++g4) { u32x2 w; w.x = pk2(o[d][4 * g4] * il, o[d][4 * g4 + 1] * il); w.y = pk2(o[d][4 * g4 + 2] * il, o[d][4 * g4 + 3] * il);
                *(u32x2*)(op + 32 * d + 8 * g4) = w; }
    }
    __syncthreads();
}

__device__ __forceinline__ void p7_router(const Args& a, LAS unsigned char* lds, int vcu, int G) {
    const int tid = threadIdx.x, lane = tid & 63, wave = tid >> 6, rr = lane & 15, g = lane >> 4;
    const float* MOD = (const float*)(a.ws + WS_MOD); const float* X1 = a.out; bf16_t* H2 = (bf16_t*)(a.ws + WS_S0);
    int* TKI = (int*)(a.ws + WS_TKI); float* TKW = (float*)(a.ws + WS_TKW); int* RANK = (int*)(a.ws + WS_RANK); int* COUNTS = (int*)(a.ws + WS_COUNTS);
    LAS int* cnt = (LAS int*)(lds + 131072);
    __syncthreads();
    { const u32x4* src = (const u32x4*)(a.ws + WS_WR);
        for (int ch = tid; ch < 8192; ch += NTHREADS) { const int hl = ch >> 12, e = (ch >> 7) & 31, kc = ch & 127;
            *(LAS u32x4*)(lds + hl * 65536 + e * 2048 + ((kc ^ (e & 15)) << 4)) = src[ch]; } }
    for (int rb = vcu * 128; rb < T; rb += G * 128) {
        if (tid < 32) cnt[tid] = 0;
        __syncthreads();
        const int r0 = rb + wave * 16, b = rb >> 12, row = r0 + rr;
        const float* xr = X1 + (size_t)row * D + 8 * g;
        float ss = 0.f;
        for (int s = 0; s < 32; ++s) { const f32x4 x0 = *(const f32x4*)(xr + 32 * s), x1 = *(const f32x4*)(xr + 32 * s + 4);
            ss += (x0[0] * x0[0] + x0[1] * x0[1]) + (x0[2] * x0[2] + x0[3] * x0[3]) + (x1[0] * x1[0] + x1[1] * x1[1]) + (x1[2] * x1[2] + x1[3] * x1[3]); }
        ss += __shfl_xor(ss, 16); ss += __shfl_xor(ss, 32);
        const float rstd = rsqrtf(ss * (1.0f / D) + EPS);
        f32x4 acc0 = (f32x4){0.f, 0.f, 0.f, 0.f}, acc1 = acc0;
        const float* gf = a.in[I_GFFN] + 8 * g; const float* sc2 = MOD + b * 6144 + 4 * 1024 + 8 * g; const float* sh2 = MOD + b * 6144 + 3 * 1024 + 8 * g;
        for (int s = 0; s < 32; ++s) {
            const f32x4 x0 = *(const f32x4*)(xr + 32 * s), x1 = *(const f32x4*)(xr + 32 * s + 4);
            const f32x4 g0 = *(const f32x4*)(gf + 32 * s), g1 = *(const f32x4*)(gf + 32 * s + 4), c0 = *(const f32x4*)(sc2 + 32 * s), c1 = *(const f32x4*)(sc2 + 32 * s + 4);
            const f32x4 h0 = x0 * rstd * g0 * (c0 + 1.0f) + *(const f32x4*)(sh2 + 32 * s), h1 = x1 * rstd * g1 * (c1 + 1.0f) + *(const f32x4*)(sh2 + 32 * s + 4);
            u32x4 hi; hi.x = pk2(h0[0], h0[1]); hi.y = pk2(h0[2], h0[3]); hi.z = pk2(h1[0], h1[1]); hi.w = pk2(h1[2], h1[3]);
            *(u32x4*)(H2 + (size_t)row * D + 32 * s + 8 * g) = hi;
            float hf[8]; unpack8(hi, hf);
            u32x4 lo; lo.x = pk2(h0[0] - hf[0], h0[1] - hf[1]); lo.y = pk2(h0[2] - hf[2], h0[3] - hf[3]); lo.z = pk2(h1[0] - hf[4], h1[1] - hf[5]); lo.w = pk2(h1[2] - hf[6], h1[3] - hf[7]);
            const bf16x8 Ah = __builtin_bit_cast(bf16x8, hi), Al = __builtin_bit_cast(bf16x8, lo);
            const int kc = 4 * s + g;
            const bf16x8 Bh0 = *(const LAS bf16x8*)(lds + rr * 2048 + ((kc ^ rr) << 4)), Bh1 = *(const LAS bf16x8*)(lds + (16 + rr) * 2048 + ((kc ^ rr) << 4));
            const bf16x8 Bl0 = *(const LAS bf16x8*)(lds + 65536 + rr * 2048 + ((kc ^ rr) << 4)), Bl1 = *(const LAS bf16x8*)(lds + 65536 + (16 + rr) * 2048 + ((kc ^ rr) << 4));
            acc0 = __builtin_amdgcn_mfma_f32_16x16x32_bf16(Ah, Bh0, acc0, 0, 0, 0); acc0 = __builtin_amdgcn_mfma_f32_16x16x32_bf16(Al, Bh0, acc0, 0, 0, 0); acc0 = __builtin_amdgcn_mfma_f32_16x16x32_bf16(Ah, Bl0, acc0, 0, 0, 0);
            acc1 = __builtin_amdgcn_mfma_f32_16x16x32_bf16(Ah, Bh1, acc1, 0, 0, 0); acc1 = __builtin_amdgcn_mfma_f32_16x16x32_bf16(Al, Bh1, acc1, 0, 0, 0); acc1 = __builtin_amdgcn_mfma_f32_16x16x32_bf16(Ah, Bl1, acc1, 0, 0, 0);
        }
        const float br0 = a.in[I_BR][rr], br1 = a.in[I_BR][16 + rr];
#pragma unroll
        for (int reg = 0; reg < 4; ++reg) {
            float v0 = acc0[reg] + br0, v1 = acc1[reg] + br1; float tv[4]; int ti[4];
#pragma unroll
            for (int k = 0; k < 4; ++k) {
                float bv = v0; int bi = rr; if (v1 > bv) { bv = v1; bi = 16 + rr; }
#pragma unroll
                for (int o = 1; o < 16; o <<= 1) { const float ov = __shfl_xor(bv, o); const int oi = __shfl_xor(bi, o); if (ov > bv || (ov == bv && oi < bi)) { bv = ov; bi = oi; } }
                tv[k] = bv; ti[k] = bi; if (bi == rr) v0 = -INFINITY; if (bi == 16 + rr) v1 = -INFINITY;
            }
            if (rr == 0) { const int t = r0 + 4 * g + reg;
                const float e1 = __expf(tv[1] - tv[0]), e2 = __expf(tv[2] - tv[0]), e3 = __expf(tv[3] - tv[0]), inv = 1.0f / (1.0f + e1 + e2 + e3);
                *(f32x4*)(TKW + (size_t)t * 4) = (f32x4){inv, e1 * inv, e2 * inv, e3 * inv};
                int rk[4];
#pragma unroll
                for (int k = 0; k < 4; ++k) rk[k] = __hip_atomic_fetch_add(cnt + ti[k], 1, __ATOMIC_RELAXED, __HIP_MEMORY_SCOPE_WORKGROUP);
                *(u32x4*)(TKI + (size_t)t * 4) = (u32x4){(unsigned)ti[0], (unsigned)ti[1], (unsigned)ti[2], (unsigned)ti[3]};
                *(u32x4*)(RANK + (size_t)t * 4) = (u32x4){(unsigned)rk[0], (unsigned)rk[1], (unsigned)rk[2], (unsigned)rk[3]}; }
        }
        __syncthreads();
        if (tid < 32) COUNTS[(rb >> 7) * 32 + tid] = cnt[tid];
        __syncthreads();
    }
}

__device__ __forceinline__ void p8_scatter(const Args& a, LAS unsigned char* lds, int vcu, int G) {
    const int tid = threadIdx.x, lane = tid & 63, wave = tid >> 6;
    const int* COUNTS = (const int*)(a.ws + WS_COUNTS); const int* TKI = (const int*)(a.ws + WS_TKI); const float* TKW = (const float*)(a.ws + WS_TKW); const int* RANK = (const int*)(a.ws + WS_RANK);
    int* SLOTROW = (int*)(a.ws + WS_SLOTROW); float* ROWW = (float*)(a.ws + WS_ROWW); int* TILEE = (int*)(a.ws + WS_TILEE);
    const bf16_t* H2 = (const bf16_t*)(a.ws + WS_S0); bf16_t* XS = (bf16_t*)(a.ws + WS_XS);
    LAS int* ptot = (LAS int*)lds;
    LAS int* pbef = ptot + 512;
    LAS int* base = pbef + 512;
    for (int rb = vcu * 128; rb < T; rb += G * 128) {
        const int blk = rb >> 7;
        __syncthreads();
        { const int e = tid & 31, pt = tid >> 5; int st = 0, sb = 0;
            for (int bb = pt * 16; bb < pt * 16 + 16; ++bb) { const int cv = COUNTS[bb * 32 + e]; st += cv; if (bb < blk) sb += cv; }
            ptot[pt * 32 + e] = st; pbef[pt * 32 + e] = sb; }
        __syncthreads();
        if (tid == 0) { int ps = 0;
            for (int e = 0; e < 32; ++e) { int tot = 0, bef = 0;
                for (int pt = 0; pt < 16; ++pt) { tot += ptot[pt * 32 + e]; bef += pbef[pt * 32 + e]; }
                base[e] = ps + bef;
                const int ntl = (tot + 255) >> 8;
                if (blk == 0) { for (int q = 0; q < ntl; ++q) TILEE[(ps >> 8) + q] = e; }
                ps += ntl << 8; }
            if (blk == 0) TILEE[1023] = ps >> 8; }
        __syncthreads();
        for (int sidx = wave; sidx < 512; sidx += 8) { const int t = rb + (sidx >> 2), k = sidx & 3;
            const int e = TKI[(size_t)t * 4 + k], dest = base[e] + RANK[(size_t)t * 4 + k];
            if (lane == 0) { SLOTROW[(size_t)t * 4 + k] = dest; ROWW[dest] = TKW[(size_t)t * 4 + k]; }
            const u32x4* src = (const u32x4*)(H2 + (size_t)t * D); u32x4* dst = (u32x4*)(XS + (size_t)dest * D);
            dst[lane] = src[lane]; dst[64 + lane] = src[64 + lane]; }
    }
    __syncthreads();
}

__device__ __forceinline__ void p11_final(const Args& a, int vcu, int G) {
    const int tid = threadIdx.x, lane = tid & 63, wave = tid >> 6;
    const float* MOD = (const float*)(a.ws + WS_MOD); const float* FMOD = (const float*)(a.ws + WS_FMOD); const int* SLOTROW = (const int*)(a.ws + WS_SLOTROW);
    const bf16_t* Y = (const bf16_t*)(a.ws + WS_XS); float* OUT = a.out;
    for (int rb = vcu * 128; rb < T; rb += G * 128) {
        const int b = rb >> 12;
        f32x4 g2[4], gs[4], sh[4];
#pragma unroll
        for (int j = 0; j < 4; ++j) { const int c = 4 * lane + 256 * j; g2[j] = *(const f32x4*)(MOD + b * 6144 + 5 * 1024 + c);
            gs[j] = *(const f32x4*)(a.in[I_GFIN] + c) * (*(const f32x4*)(FMOD + b * 2048 + 1024 + c) + 1.0f); sh[j] = *(const f32x4*)(FMOD + b * 2048 + c); }
        for (int i = 0; i < 16; ++i) { const int t = rb + wave * 16 + i; const u32x4 sr = *(const u32x4*)(SLOTROW + (size_t)t * 4);
            f32x4* xr = (f32x4*)(OUT + (size_t)t * D) + lane; f32x4 v[4]; float s = 0.f;
#pragma unroll
            for (int j = 0; j < 4; ++j) { f32x4 mo = (f32x4){0.f, 0.f, 0.f, 0.f};
#pragma unroll
                for (int k = 0; k < 4; ++k) { const u32x2 w = *((const u32x2*)(Y + (size_t)sr[k] * D) + lane + 64 * j); mo[0] += bflo(w.x); mo[1] += bfhi(w.x); mo[2] += bflo(w.y); mo[3] += bfhi(w.y); }
                v[j] = xr[64 * j] + g2[j] * mo; s += (v[j][0] * v[j][0] + v[j][1] * v[j][1]) + (v[j][2] * v[j][2] + v[j][3] * v[j][3]); }
            const float rstd = rsqrtf(wave_sum(s) * (1.0f / D) + EPS);
#pragma unroll
            for (int j = 0; j < 4; ++j) xr[64 * j] = v[j] * rstd * gs[j] + sh[j]; }
    }
}

__global__ void __launch_bounds__(NTHREADS, 2) mk_fwd(Args a) {
    extern __shared__ __attribute__((aligned(16))) unsigned char lds_raw[];
    LAS unsigned char* lds = (LAS unsigned char*)lds_raw;
    const int G = gridDim.x, bx = blockIdx.x; const int vcu = (G % 8 == 0) ? (bx % 8) * (G / 8) + bx / 8 : bx;
    unsigned char* ws = a.ws;
    const int lo = a.ph_lo, hi = a.ph_hi;
#ifndef PHASE_MASK
#define PHASE_MASK 0xFFF
#endif
#define IN(k) ((((PHASE_MASK) >> (k)) & 1) && lo <= (k) && (k) < hi)
#if ONE_LAUNCH
#define SEAM(k) do { if (IN(k) && IN((k) + 1)) cg::this_grid().sync(); } while (0)
#else
#define SEAM(k) do { } while (0)
#endif
    if (IN(0)) { p0_prep(a, lds, vcu, G); } SEAM(0);
    if (IN(1)) { p1_hb(a, vcu, G); } SEAM(1);
    if (IN(2)) {
        Gemm g{(const bf16_t*)(ws + WS_S0), (const bf16_t*)(ws + WS_WIN), D, D, D}; DenseSched S; S.init(T / 256, INP / 256, G, bx, D, D, 0);
        EpiIn E{(bf16_t*)(ws + WS_S1), (bf16_t*)(ws + WS_QLAT), (bf16_t*)(ws + WS_KVLAT), (bf16_t*)(ws + WS_KPE), (bf16_t*)(ws + WS_GATES), (float*)(ws + WS_PSQQ), (float*)(ws + WS_PSQKV), a.in[I_BGATE], (const f32x2*)(ws + WS_CS)};
        gemm_phase(lds, g, S, E);
    } SEAM(2);
    if (IN(3)) {
        p3_mixed(a, vcu, G);
        { Gemm g{(const bf16_t*)(ws + WS_QLAT), (const bf16_t*)(ws + WS_WQ), QL, QL, QL}; DenseSched S; S.init(T / 256, 6, G, bx, QL, QL, 0);
            EpiQ E{(bf16_t*)(ws + WS_Q), (const float*)(ws + WS_PSQQ), (const f32x2*)(ws + WS_CS)}; gemm_phase(lds, g, S, E); }
        { Gemm g{(const bf16_t*)(ws + WS_KVLAT), (const bf16_t*)(ws + WS_WK), KVL, KVL, KVL}; DenseSched S; S.init(T / 256, 4, G, bx, KVL, KVL, 0);
            EpiK E{(bf16_t*)(ws + WS_KN), (const float*)(ws + WS_PSQKV)}; gemm_phase(lds, g, S, E); }
        { Gemm g{(const bf16_t*)(ws + WS_WV), (const bf16_t*)(ws + WS_KVLAT), KVL, KVL, KVL}; DenseSched S; S.init(4, T / 256, G, bx, KVL, KVL, 0);
            EpiVT E{(bf16_t*)(ws + WS_VT), (const float*)(ws + WS_PSQKV)}; gemm_phase(lds, g, S, E); }
    } SEAM(3);
    if (IN(4)) {
#if FAST_ATTN
        attn_fast(a, lds, vcu, G);
#else
        attn_naive(a, lds, vcu, G);
#endif
        { Gemm g{(const bf16_t*)(ws + WS_S0), (const bf16_t*)(ws + WS_WGRP), D, 256, 256}; DenseSched S; S.init(T / 256, 4, G, bx, D, 256, 512u);
            EpiPlain E{(bf16_t*)(ws + WS_S1), D}; gemm_phase(lds, g, S, E); }
    } SEAM(4);
    if (IN(5)) {
        DenseSched S; S.init(T / 256, 4, G, bx, D, D, 0);
        { Gemm g{(const bf16_t*)(ws + WS_S1), (const bf16_t*)(ws + WS_WPO), D, D, D}; EpiMerge<0> E{(bf16_t*)(ws + WS_S0), (const bf16_t*)(ws + WS_GATES)}; gemm_phase(lds, g, S, E); }
        { Gemm g{(const bf16_t*)(ws + WS_O), (const bf16_t*)(ws + WS_WMO), D, D, D}; EpiMerge<1> E{(bf16_t*)(ws + WS_S0), (const bf16_t*)(ws + WS_GATES)}; gemm_phase(lds, g, S, E); }
    } SEAM(5);
    if (IN(6)) {
        Gemm g{(const bf16_t*)(ws + WS_S0), (const bf16_t*)(ws + WS_WOUT), D, D, D}; DenseSched S; S.init(T / 256, 4, G, bx, D, D, 0);
        EpiOut E{a.in[I_X], a.out, (const float*)(ws + WS_MOD)}; gemm_phase(lds, g, S, E);
    } SEAM(6);
    if (IN(7)) { p7_router(a, lds, vcu, G); } SEAM(7);
    if (IN(8)) { p8_scatter(a, lds, vcu, G); } SEAM(8);
    if (IN(9)) {
        Gemm g{(const bf16_t*)(ws + WS_XS), (const bf16_t*)(ws + WS_WGU), D, D, D}; MoeSched S; S.init((const int*)(ws + WS_TILEE), 8, G, bx, D, D);
        EpiGU E{(bf16_t*)(ws + WS_ACT), a.in[I_BGU]}; gemm_phase(lds, g, S, E);
    } SEAM(9);
    if (IN(10)) {
        Gemm g{(const bf16_t*)(ws + WS_ACT), (const bf16_t*)(ws + WS_WDN), D, D, D}; MoeSched S; S.init((const int*)(ws + WS_TILEE), 4, G, bx, D, D);
        EpiDown E{(bf16_t*)(ws + WS_XS), a.in[I_BDN], (const float*)(ws + WS_ROWW)}; gemm_phase(lds, g, S, E);
    } SEAM(10);
    if (IN(11)) { p11_final(a, vcu, G); }
#undef IN
#undef SEAM
}

constexpr int NPHASES = 12;
extern "C" void kernel_launch(void* const* d_in, const int* in_sizes, int n_in, void* d_out, int out_size, void* d_ws, size_t ws_size, hipStream_t stream) {
    static int grid = 0;
    if (grid == 0) {
        if (n_in != 27 || out_size != T * D || ws_size < WS_END) { fprintf(stderr, "kernel_launch: unexpected problem (n_in %d out %d ws %zu)\n", n_in, out_size, ws_size); grid = -1; return; }
        int dev = 0, cus = 0, per_cu = 0;
        hipGetDevice(&dev); hipDeviceGetAttribute(&cus, hipDeviceAttributeMultiprocessorCount, dev);
        hipFuncSetAttribute((const void*)mk_fwd, hipFuncAttributeMaxDynamicSharedMemorySize, LDS_BYTES);
        hipOccupancyMaxActiveBlocksPerMultiprocessor(&per_cu, (const void*)mk_fwd, NTHREADS, LDS_BYTES);
        (void)hipGetLastError();
        if (per_cu < 1) { fprintf(stderr, "kernel_launch: occupancy query says %d blocks per CU\n", per_cu); per_cu = 1; }
        grid = cus;
    }
    if (grid < 0) return;
    Args a{};
    for (int i = 0; i < 27; ++i) a.in[i] = (const float*)d_in[i];
    a.out = (float*)d_out; a.ws = (unsigned char*)d_ws;
#if ONE_LAUNCH
    a.ph_lo = 0; a.ph_hi = NPHASES;
    void* args[] = {&a};
    hipError_t e = hipLaunchCooperativeKernel((const void*)mk_fwd, dim3(grid), dim3(NTHREADS), args, LDS_BYTES, stream);
    if (e != hipSuccess) fprintf(stderr, "cooperative launch failed: %s (grid %d)\n", hipGetErrorString(e), grid);
#else
    for (int p = 0; p < NPHASES; ++p) { a.ph_lo = p; a.ph_hi = p + 1; hipLaunchKernelGGL(mk_fwd, dim3(grid), dim3(NTHREADS), LDS_BYTES, stream, a); }
#endif
}
```

```cpp
#include <hip/hip_runtime.h>
#include <hip/hip_cooperative_groups.h>
#include <cstdio>
#include <cstdint>
namespace cg = cooperative_groups;

#ifndef ONE_LAUNCH
#define ONE_LAUNCH 1
#endif
#ifndef FAST_GEMM
#define FAST_GEMM 1
#endif
#ifndef FAST_ATTN
#define FAST_ATTN 1
#endif

#define LAS __attribute__((address_space(3)))
typedef unsigned short bf16_t;
typedef short bf16x8 __attribute__((ext_vector_type(8)));
typedef float f32x4 __attribute__((ext_vector_type(4)));
typedef float f32x2 __attribute__((ext_vector_type(2)));
typedef unsigned u32x4 __attribute__((ext_vector_type(4)));
typedef unsigned u32x2 __attribute__((ext_vector_type(2)));
typedef __bf16 bf16x2_t __attribute__((ext_vector_type(2)));

constexpr int D = 1024, NB = 8, SEQ = 4096, T = NB * SEQ;
constexpr int QL = 768, KVL = 256, ROPE = 64, NH = 8, NOPE = 128, VH = 128, QKD = NOPE + ROPE;
constexpr int IN_W = 4160, INP = 4352;
constexpr int NE = 32, TOPK = 4, DE = 1024;
constexpr int NSLOT = T * TOPK;
constexpr int RT_MAX = 543;
constexpr float EPS = 1e-6f;
constexpr float QSCALE = 0.07216878364870322f * 1.4426950408889634f;

constexpr size_t MiB = 1u << 20;
constexpr size_t WS_MOD = 1 * MiB;
constexpr size_t WS_FMOD = 1 * MiB + 256 * 1024;
constexpr size_t WS_CS = 2 * MiB;
constexpr size_t WS_PSQQ = 10 * MiB;
constexpr size_t WS_PSQKV = 12 * MiB;
constexpr size_t WS_TKI = 13 * MiB;
constexpr size_t WS_TKW = 13 * MiB + 512 * 1024;
constexpr size_t WS_RANK = 14 * MiB;
constexpr size_t WS_SLOTROW = 14 * MiB + 512 * 1024;
constexpr size_t WS_COUNTS = 15 * MiB;
constexpr size_t WS_ROWW = 16 * MiB;
constexpr size_t WS_TILEE = 17 * MiB;
constexpr size_t WS_WR = 18 * MiB;
constexpr size_t WS_WIN = 32 * MiB;
constexpr size_t WS_WQ = 41 * MiB;
constexpr size_t WS_WK = 44 * MiB;
constexpr size_t WS_WV = 45 * MiB;
constexpr size_t WS_WGRP = 46 * MiB;
constexpr size_t WS_WPO = 47 * MiB;
constexpr size_t WS_WMO = 49 * MiB;
constexpr size_t WS_WOUT = 51 * MiB;
constexpr size_t WS_WGU = 54 * MiB;
constexpr size_t WS_WDN = 182 * MiB;
constexpr size_t WS_S0 = 256 * MiB;
constexpr size_t WS_S1 = 320 * MiB;
constexpr size_t WS_QLAT = 384 * MiB;
constexpr size_t WS_KVLAT = 432 * MiB;
constexpr size_t WS_KPE = 448 * MiB;
constexpr size_t WS_GATES = 452 * MiB;
constexpr size_t WS_Q = 580 * MiB;
constexpr size_t WS_KN = 676 * MiB;
constexpr size_t WS_VT = 740 * MiB;
constexpr size_t WS_O = 804 * MiB;
constexpr size_t WS_XS = 320 * MiB;
constexpr size_t WS_ACT = 592 * MiB;
constexpr size_t WS_END = 864 * MiB;

constexpr int LDS_BYTES = 147456;
constexpr int NTHREADS = 512;

__device__ __forceinline__ unsigned pk2(float lo, float hi) { f32x2 v = {lo, hi}; bf16x2_t b = __builtin_convertvector(v, bf16x2_t); return __builtin_bit_cast(unsigned, b); }
__device__ __forceinline__ float bflo(unsigned u) { return __uint_as_float(u << 16); }
__device__ __forceinline__ float bfhi(unsigned u) { return __uint_as_float(u & 0xffff0000u); }
__device__ __forceinline__ void unpack8(const u32x4 w, float (&f)[8]) { f[0] = bflo(w.x); f[1] = bfhi(w.x); f[2] = bflo(w.y); f[3] = bfhi(w.y); f[4] = bflo(w.z); f[5] = bfhi(w.z); f[6] = bflo(w.w); f[7] = bfhi(w.w); }
__device__ __forceinline__ u32x4 pack8(const float (&f)[8]) { u32x4 w; w.x = pk2(f[0], f[1]); w.y = pk2(f[2], f[3]); w.z = pk2(f[4], f[5]); w.w = pk2(f[6], f[7]); return w; }
__device__ __forceinline__ float wave_sum(float v) {
#pragma unroll
    for (int o = 1; o < 64; o <<= 1) v += __shfl_xor(v, o);
    return v;
}
__device__ __forceinline__ int tid_fresh() { int t = threadIdx.x; asm volatile("" : "+v"(t)); return t; }
__device__ __forceinline__ float sigmoidf_(float x) { return 1.0f / (1.0f + __expf(-x)); }

struct Args {
    const float* in[27]; float* out; unsigned char* ws; int ph_lo, ph_hi;
};
typedef const Args __attribute__((address_space(4)))* KArgP;
enum { I_X = 0, I_C, I_POS, I_WMOD, I_BMOD, I_GMIX, I_WIN, I_BGATE, I_WPG, I_PSCALE, I_WPO, I_GQA, I_WQB, I_GKVA, I_WKVB, I_WMO, I_WOUT, I_GFFN, I_WR, I_BR, I_WGU, I_BGU, I_WDN, I_BDN, I_GFIN, I_WFMOD, I_BFMOD };

struct Unit { int pm, pn, e; unsigned ao, bo; };
struct Gemm { const bf16_t* A; const bf16_t* Bt; int lda, ldb, K; };
constexpr int NXCD = 8, WGM = 8;
__host__ __device__ __forceinline__ int perm32(int rho) { const int n = rho >> 4, i = rho & 15; return 8 * (i >> 2) + 4 * n + (i & 3); }

struct DenseSched {
    int nM, nN, nwg, G, c; unsigned a_tile, a_col, b_tile;
    __device__ void init(int nM_, int nN_, int G_, int c_, int lda, int ldb, unsigned a_col_) { nM = nM_; nN = nN_; nwg = nM * nN; G = G_; c = c_; a_tile = 256u * lda * 2u; b_tile = 256u * ldb * 2u; a_col = a_col_; }
    __device__ bool next(int i, Unit& u) const {
        const long L = (long)i * G + c; if (L >= nwg) return false;
        int wgid = (int)L; { const int q = nwg / NXCD, r = nwg % NXCD, xcd = wgid % NXCD, off = wgid / NXCD; wgid = (xcd < r ? xcd * (q + 1) : r * (q + 1) + (xcd - r) * q) + off; }
        const int nig = WGM * nN, gid = wgid / nig, fm = gid * WGM, gsz = (nM - fm) < WGM ? (nM - fm) : WGM;
        u.pm = fm + ((wgid % nig) % gsz); u.pn = (wgid % nig) / gsz; u.e = 0;
        u.ao = (unsigned)u.pm * a_tile + (unsigned)u.pn * a_col; u.bo = (unsigned)u.pn * b_tile; return true;
    }
};
struct MoeSched {
    const int* tile_e; int R, NT, G, c; unsigned a_tile, b_tile;
    __device__ void init(const int* te, int NT_, int G_, int c_, int lda, int ldb) { tile_e = te; R = te[1023]; NT = NT_; G = G_; c = c_; a_tile = 256u * lda * 2u; b_tile = 256u * ldb * 2u; }
    __device__ bool next(int i, Unit& u) const {
        int rt, pn;
        if (G == 256) { const int x = c & 7, j = c >> 3, rpr = 256 / NT, pxc = rpr / 8; rt = i * rpr + x * pxc + j / NT; pn = j % NT; }
        else { const long L = (long)i * G + c; rt = (int)(L / NT); pn = (int)(L % NT); }
        if (rt >= R) return false;
        const int e = tile_e[rt];
        u.pm = rt; u.pn = pn; u.e = e; u.ao = (unsigned)rt * a_tile; u.bo = (unsigned)(e * NT + pn) * b_tile; return true;
    }
};

template <class Epi>
__device__ __forceinline__ void run_epi(const Epi& E, const f32x4 (&acc)[2][2][4][2], const Unit& u, int wr, int wc, int fr, int fq) {
    if constexpr (Epi::COLMAJOR) {
#pragma unroll
        for (int bj = 0; bj < 2; ++bj) {
            const int col = bj * 128 + wc * 32 + 8 * fq;
            const typename Epi::ColCtx cc = E.col_ctx(u, col);
            asm volatile("" ::: "memory");
#pragma unroll
            for (int ai = 0; ai < 2; ++ai)
#pragma unroll
                for (int m = 0; m < 4; ++m) {
                    float v[8];
#pragma unroll
                    for (int j = 0; j < 4; ++j) { v[j] = acc[ai][bj][m][0][j]; v[4 + j] = acc[ai][bj][m][1][j]; }
                    E.apply(u, u.pm * 256 + ai * 128 + wr * 64 + m * 16 + fr, col, v, 0.f, cc);
                }
            asm volatile("" ::: "memory");
        }
    } else {
        const bool wp = Epi::SUMSQ && E.want_partial(u);
#pragma unroll
        for (int ai = 0; ai < 2; ++ai)
#pragma unroll
            for (int m = 0; m < 4; ++m) {
                const int row = u.pm * 256 + ai * 128 + wr * 64 + m * 16 + fr;
                const float rc = E.row_ctx(u, row); float part = 0.f;
#pragma unroll
                for (int bj = 0; bj < 2; ++bj) {
                    const int col = bj * 128 + wc * 32 + 8 * fq;
                    float v[8];
#pragma unroll
                    for (int j = 0; j < 4; ++j) { v[j] = acc[ai][bj][m][0][j]; v[4 + j] = acc[ai][bj][m][1][j]; }
                    part += E.apply(u, row, col, v, rc, E.col_ctx(u, col));
                }
                if constexpr (Epi::SUMSQ) { if (wp) { float s = part; s += __shfl_xor(s, 16); s += __shfl_xor(s, 32); if (fq == 0) E.partial(u, row, wc, s); } }
                asm volatile("" ::: "memory");
            }
    }
}

template <class Epi, class Sched>
__device__ __forceinline__ void gemm_simple(LAS unsigned char* lds, const Gemm g, const Sched& S, const Epi& E) {
    const int tid = tid_fresh(), wid = __builtin_amdgcn_readfirstlane(tid >> 6), lane = tid & 63, wr = wid >> 2, wc = wid & 3, fr = lane & 15, fq = lane >> 4;
    const int nt = g.K / 64;
    Unit u;
    for (int ui = 0; S.next(ui, u); ++ui) {
        f32x4 acc[2][2][4][2];
#pragma unroll
        for (int a = 0; a < 2; ++a)
#pragma unroll
            for (int b = 0; b < 2; ++b)
#pragma unroll
                for (int m = 0; m < 4; ++m)
#pragma unroll
                    for (int n = 0; n < 2; ++n) acc[a][b][m][n] = (f32x4){0.f, 0.f, 0.f, 0.f};
        const char* cA = (const char*)g.A + u.ao; const char* cB = (const char*)g.Bt + u.bo;
#pragma unroll 1
        for (int kt = 0; kt < nt; ++kt) {
            __syncthreads();
#pragma unroll
            for (int i = 0; i < 4; ++i) { const int c = tid + 512 * i, row = c >> 3, kc = c & 7, rb = (row & ~31) + perm32(row & 31);
                const u32x4 va = *(const u32x4*)(cA + (size_t)row * g.lda * 2 + kt * 128 + kc * 16);
                const u32x4 vb = *(const u32x4*)(cB + (size_t)rb * g.ldb * 2 + kt * 128 + kc * 16);
                *(LAS u32x4*)(lds + row * 144 + kc * 16) = va; *(LAS u32x4*)(lds + 36864 + row * 144 + kc * 16) = vb; }
            __syncthreads();
#pragma unroll
            for (int k = 0; k < 2; ++k) {
                bf16x8 Af[2][4], Bf[2][2];
#pragma unroll
                for (int ai = 0; ai < 2; ++ai)
#pragma unroll
                    for (int m = 0; m < 4; ++m) Af[ai][m] = *(const LAS bf16x8*)(lds + (ai * 128 + wr * 64 + m * 16 + fr) * 144 + (k * 32 + fq * 8) * 2);
#pragma unroll
                for (int bj = 0; bj < 2; ++bj)
#pragma unroll
                    for (int n = 0; n < 2; ++n) Bf[bj][n] = *(const LAS bf16x8*)(lds + 36864 + (bj * 128 + wc * 32 + n * 16 + fr) * 144 + (k * 32 + fq * 8) * 2);
#pragma unroll
                for (int ai = 0; ai < 2; ++ai)
#pragma unroll
                    for (int bj = 0; bj < 2; ++bj)
#pragma unroll
                        for (int m = 0; m < 4; ++m)
#pragma unroll
                            for (int n = 0; n < 2; ++n) acc[ai][bj][m][n] = __builtin_amdgcn_mfma_f32_16x16x32_bf16(Bf[bj][n], Af[ai][m], acc[ai][bj][m][n], 0, 0, 0);
            }
        }
        run_epi(E, acc, u, wr, wc, fr, fq);
    }
    __syncthreads();
}

namespace pg8 {
constexpr int BK = 64, HALF = 128, HTB = HALF * BK * 2  , STAGE_BYTES = 8 * HTB;
__device__ __forceinline__ int lds_byte(int r, int c) { const int st = (r >> 4) * 2 + (c >> 5), rr = r & 15, cc = c & 31, ob = rr * 64 + cc * 2; return st * 1024 + (ob ^ (((ob >> 9) & 1) << 5)); }
__device__ __forceinline__ void stage_rc(int b, int& R, int& C) { const int st = b / 1024, sb = b % 1024, swz = sb ^ (((sb >> 9) & 1) << 5); R = (st >> 1) * 16 + swz / 64; C = (st & 1) * 32 + (swz % 64) / 2; }

template <class Epi, class Sched>
__device__ __forceinline__ void gemm_fast(LAS unsigned char* lds, const Gemm g, const Sched& S, const Epi& E) {
    const int tid = tid_fresh(), wid = __builtin_amdgcn_readfirstlane(tid >> 6), lane = tid & 63, wr = wid >> 2, wc = wid & 3, fr = lane & 15, fq = lane >> 4;
    const int nt = g.K / BK;
    unsigned voffA[2], voffB[2];
#pragma unroll
    for (int i = 0; i < 2; ++i) { int R, C; stage_rc(tid * 16 + i * 8192, R, C); const int Rb = (R & ~31) + perm32(R & 31);
        voffA[i] = (unsigned)(R * g.lda + C) * 2u; voffB[i] = (unsigned)(Rb * g.ldb + C) * 2u; }
    const size_t kstep = (size_t)(BK * 2);
    const size_t hstepA = (size_t)HALF * g.lda * 2, hstepB = (size_t)HALF * g.ldb * 2;
    const unsigned ldsw = (unsigned)wid * 1024u;
    const int aoff = lds_byte(wr * 64 + fr, fq * 8), boff = lds_byte(wc * 32 + fr, fq * 8);
#define PG8_SA(b, h) (((b) * 2 + (h)) * HTB)
#define PG8_SB(b, h) ((4 + (b) * 2 + (h)) * HTB)
#define PG8_STAGE(bufoff, gbase, voff) do { _Pragma("unroll") for (int _i = 0; _i < 2; ++_i) \
        __builtin_amdgcn_global_load_lds((const unsigned*)((const char*)(gbase) + (voff)[_i]), (LAS unsigned*)(lds + (bufoff) + ldsw + _i * 8192), 16, 0, 0); } while (0)
#define PG8_LDA(dst, b, h) do { _Pragma("unroll") for (int m = 0; m < 4; ++m) _Pragma("unroll") for (int k = 0; k < 2; ++k) dst[m][k] = *(const LAS bf16x8*)(lds + PG8_SA(b, h) + aoff + m * 2048 + k * 1024); } while (0)
#define PG8_LDB(dst, b, h) do { _Pragma("unroll") for (int n = 0; n < 2; ++n) _Pragma("unroll") for (int k = 0; k < 2; ++k) dst[n][k] = *(const LAS bf16x8*)(lds + PG8_SB(b, h) + boff + n * 2048 + k * 1024); } while (0)
#define PG8_MMA(ai, bj, At, Bt) do { __builtin_amdgcn_s_setprio(1); _Pragma("unroll") for (int m = 0; m < 4; ++m) _Pragma("unroll") for (int n = 0; n < 2; ++n) _Pragma("unroll") for (int k = 0; k < 2; ++k) \
        acc[ai][bj][m][n] = __builtin_amdgcn_mfma_f32_16x16x32_bf16(Bt[n][k], At[m][k], acc[ai][bj][m][n], 0, 0, 0); __builtin_amdgcn_s_setprio(0); } while (0)
#define PG8_WAIT_V(n) asm volatile("s_waitcnt vmcnt(" #n ")" ::: "memory")
#define PG8_WAIT_L(n) asm volatile("s_waitcnt lgkmcnt(" #n ")" ::: "memory")
#define PG8_BAR __builtin_amdgcn_s_barrier()
#define PG8_SCHED __builtin_amdgcn_sched_barrier(0)
    Unit cur, nxt; int ui = 0;
    if (!S.next(0, cur)) return;
    f32x4 acc[2][2][4][2];
#pragma unroll
    for (int a = 0; a < 2; ++a)
#pragma unroll
        for (int b = 0; b < 2; ++b)
#pragma unroll
            for (int m = 0; m < 4; ++m)
#pragma unroll
                for (int n = 0; n < 2; ++n) acc[a][b][m][n] = (f32x4){0.f, 0.f, 0.f, 0.f};
    bf16x8 At[4][2], B0[2][2], B1[2][2];
    const char* cA = (const char*)g.A + cur.ao; const char* cB = (const char*)g.Bt + cur.bo;
    PG8_STAGE(PG8_SB(0, 0), cB, voffB); PG8_STAGE(PG8_SB(0, 1), cB + hstepB, voffB); PG8_STAGE(PG8_SA(0, 0), cA, voffA); PG8_STAGE(PG8_SA(0, 1), cA + hstepA, voffA);
    if (wr == 1) PG8_BAR;
    PG8_WAIT_V(2); PG8_BAR;
    PG8_STAGE(PG8_SB(1, 0), cB + kstep, voffB); PG8_STAGE(PG8_SA(1, 0), cA + kstep, voffA); PG8_STAGE(PG8_SB(1, 1), cB + hstepB + kstep, voffB);
    PG8_WAIT_V(6); PG8_BAR;
    for (;;) {
        const bool has_next = S.next(ui + 1, nxt);
        const char* nA = has_next ? (const char*)g.A + nxt.ao : cA; const char* nB = has_next ? (const char*)g.Bt + nxt.bo : cB;
#pragma unroll 1
        for (int t = 0; t < nt; t += 2) {
            const bool last = (t == nt - 2);
            const char* a1 = cA + (size_t)(t + 1) * kstep;
            const char* a2 = last ? nA : cA + (size_t)(t + 2) * kstep; const char* b2 = last ? nB : cB + (size_t)(t + 2) * kstep;
            const char* a3 = a2 + kstep; const char* b3 = b2 + kstep;
            PG8_LDB(B0, 0, 0); PG8_LDB(B1, 0, 1); PG8_SCHED; PG8_LDA(At, 0, 0); PG8_STAGE(PG8_SA(1, 1), a1 + hstepA, voffA);
            PG8_WAIT_V(8); PG8_WAIT_L(0); PG8_BAR; PG8_MMA(0, 0, At, B0); PG8_MMA(0, 1, At, B1); PG8_BAR; PG8_SCHED;
            PG8_LDA(At, 0, 1); PG8_STAGE(PG8_SB(0, 0), b2, voffB); PG8_STAGE(PG8_SB(0, 1), b2 + hstepB, voffB); PG8_STAGE(PG8_SA(0, 0), a2, voffA);
            PG8_WAIT_V(8); PG8_WAIT_L(0); PG8_BAR; PG8_MMA(1, 0, At, B0); PG8_MMA(1, 1, At, B1); PG8_BAR; PG8_SCHED;
            PG8_LDB(B0, 1, 0); PG8_LDB(B1, 1, 1); PG8_SCHED; PG8_LDA(At, 1, 0); PG8_STAGE(PG8_SA(0, 1), a2 + hstepA, voffA);
            PG8_WAIT_V(8); PG8_WAIT_L(0); PG8_BAR; PG8_MMA(0, 0, At, B0); PG8_MMA(0, 1, At, B1); PG8_BAR; PG8_SCHED;
            PG8_LDA(At, 1, 1); PG8_STAGE(PG8_SB(1, 0), b3, voffB); PG8_STAGE(PG8_SB(1, 1), b3 + hstepB, voffB); PG8_STAGE(PG8_SA(1, 0), a3, voffA);
            PG8_WAIT_V(8); PG8_WAIT_L(0); PG8_BAR; PG8_MMA(1, 0, At, B0); PG8_MMA(1, 1, At, B1); PG8_BAR; PG8_SCHED;
        }
        if (wr == 0) PG8_BAR;
        run_epi(E, acc, cur, wr, wc, fr, fq);
        if (!has_next) break;
#pragma unroll
        for (int a = 0; a < 2; ++a)
#pragma unroll
            for (int b = 0; b < 2; ++b)
#pragma unroll
                for (int m = 0; m < 4; ++m)
#pragma unroll
                    for (int n = 0; n < 2; ++n) acc[a][b][m][n] = (f32x4){0.f, 0.f, 0.f, 0.f};
        cur = nxt; cA = nA; cB = nB; ++ui;
        if (wr == 1) PG8_BAR;
    }
    PG8_WAIT_V(0);
    PG8_BAR;
#undef PG8_SA
#undef PG8_SB
#undef PG8_STAGE
#undef PG8_LDA
#undef PG8_LDB
#undef PG8_MMA
#undef PG8_WAIT_V
#undef PG8_WAIT_L
#undef PG8_BAR
#undef PG8_SCHED
}
}

template <class Epi, class Sched>
__device__ __forceinline__ void gemm_phase(LAS unsigned char* lds, const Gemm g, const Sched& S, const Epi& E) {
#if FAST_GEMM
    pg8::gemm_fast<Epi, Sched>(lds, g, S, E);
#else
    gemm_simple<Epi, Sched>(lds, g, S, E);
#endif
}

struct NoCtx {};
struct EpiIn {
    static constexpr bool SUMSQ = true, COLMAJOR = false; typedef NoCtx ColCtx;
    bf16_t *U, *QLp, *KVLp, *KPE, *GATES; float *PSQQ, *PSQKV; const float* bgate; const f32x2* CS;
    __device__ __forceinline__ float row_ctx(const Unit&, int) const { return 0.f; }
    __device__ __forceinline__ NoCtx col_ctx(const Unit&, int) const { return NoCtx{}; }
    __device__ __forceinline__ bool want_partial(const Unit& u) const { return u.pn >= 4 && u.pn < 8; }
    __device__ __forceinline__ void partial(const Unit& u, int row, int wc, float s) const {
        if (u.pn < 7) PSQQ[(size_t)row * 12 + (u.pn - 4) * 4 + wc] = s; else PSQKV[(size_t)row * 4 + wc] = s; }
    __device__ __forceinline__ float apply(const Unit& u, int row, int col, float (&v)[8], float, NoCtx) const {
        const int pn = u.pn;
        if (pn < 4) { *(u32x4*)(U + (size_t)row * D + pn * 256 + col) = pack8(v); return 0.f; }
        if (pn < 8) {
            float s = 0.f;
#pragma unroll
            for (int j = 0; j < 8; ++j) s += v[j] * v[j];
            if (pn < 7) *(u32x4*)(QLp + (size_t)row * QL + (pn - 4) * 256 + col) = pack8(v);
            else *(u32x4*)(KVLp + (size_t)row * KVL + col) = pack8(v);
            return s;
        }
        if (pn < 16) {
            const int gc = (pn - 8) * 256 + col; const f32x4 b0 = *(const f32x4*)(bgate + gc), b1 = *(const f32x4*)(bgate + gc + 4);
            float o[8];
#pragma unroll
            for (int j = 0; j < 4; ++j) { o[j] = sigmoidf_(v[j] + b0[j]); o[4 + j] = sigmoidf_(v[4 + j] + b1[j]); }
            *(u32x4*)(GATES + (size_t)row * 2048 + gc) = pack8(o); return 0.f;
        }
        if (col < 64) {
            const int g = col >> 3; float y1[4], y2[4];
#pragma unroll
            for (int i = 0; i < 4; ++i) { const f32x2 cs = CS[(size_t)row * 32 + 4 * g + i]; y1[i] = v[i] * cs.x - v[4 + i] * cs.y; y2[i] = v[4 + i] * cs.x + v[i] * cs.y; }
            u32x2 a, b; a.x = pk2(y1[0], y1[1]); a.y = pk2(y1[2], y1[3]); b.x = pk2(y2[0], y2[1]); b.y = pk2(y2[2], y2[3]);
            *(u32x2*)(KPE + (size_t)row * 64 + 4 * g) = a; *(u32x2*)(KPE + (size_t)row * 64 + 32 + 4 * g) = b;
        }
        return 0.f;
    }
};
struct EpiQ {
    static constexpr bool SUMSQ = false, COLMAJOR = false; typedef NoCtx ColCtx;
    bf16_t* Q; const float* PSQQ; const f32x2* CS;
    __device__ __forceinline__ float row_ctx(const Unit&, int row) const {
        const f32x4* p = (const f32x4*)(PSQQ + (size_t)row * 12); const f32x4 a = p[0], b = p[1], c = p[2];
        const float s = ((a[0] + a[1]) + (a[2] + a[3])) + ((b[0] + b[1]) + (b[2] + b[3])) + ((c[0] + c[1]) + (c[2] + c[3]));
        return rsqrtf(s * (1.0f / QL) + EPS) * QSCALE; }
    __device__ __forceinline__ NoCtx col_ctx(const Unit&, int) const { return NoCtx{}; }
    __device__ __forceinline__ bool want_partial(const Unit&) const { return false; }
    __device__ __forceinline__ void partial(const Unit&, int, int, float) const {}
    __device__ __forceinline__ float apply(const Unit& u, int row, int col, float (&v)[8], float rs, NoCtx) const {
#pragma unroll
        for (int j = 0; j < 8; ++j) v[j] *= rs;
        if (u.pn < 4) { const int p = u.pn * 256 + col, hh = p >> 7, d = p & 127; *(u32x4*)(Q + (size_t)row * (NH * QKD) + hh * QKD + d) = pack8(v); }
        else { const int r = (u.pn - 4) * 256 + col, hh = r >> 6, g = (r & 63) >> 3; float y1[4], y2[4];
#pragma unroll
            for (int i = 0; i < 4; ++i) { const f32x2 cs = CS[(size_t)row * 32 + 4 * g + i]; y1[i] = v[i] * cs.x - v[4 + i] * cs.y; y2[i] = v[4 + i] * cs.x + v[i] * cs.y; }
            u32x2 a, b; a.x = pk2(y1[0], y1[1]); a.y = pk2(y1[2], y1[3]); b.x = pk2(y2[0], y2[1]); b.y = pk2(y2[2], y2[3]);
            bf16_t* q = Q + (size_t)row * (NH * QKD) + hh * QKD + NOPE; *(u32x2*)(q + 4 * g) = a; *(u32x2*)(q + 32 + 4 * g) = b; }
        return 0.f;
    }
};
__device__ __forceinline__ float rstd_kv(const float* PSQKV, int t) { const f32x4 a = *(const f32x4*)(PSQKV + (size_t)t * 4); return rsqrtf(((a[0] + a[1]) + (a[2] + a[3])) * (1.0f / KVL) + EPS); }
struct EpiK {
    static constexpr bool SUMSQ = false, COLMAJOR = false; typedef NoCtx ColCtx;
    bf16_t* KN; const float* PSQKV;
    __device__ __forceinline__ float row_ctx(const Unit&, int row) const { return rstd_kv(PSQKV, row); }
    __device__ __forceinline__ NoCtx col_ctx(const Unit&, int) const { return NoCtx{}; }
    __device__ __forceinline__ bool want_partial(const Unit&) const { return false; }
    __device__ __forceinline__ void partial(const Unit&, int, int, float) const {}
    __device__ __forceinline__ float apply(const Unit& u, int row, int col, float (&v)[8], float rs, NoCtx) const {
#pragma unroll
        for (int j = 0; j < 8; ++j) v[j] *= rs;
        *(u32x4*)(KN + (size_t)row * D + u.pn * 256 + col) = pack8(v); return 0.f; }
};
struct Ctx8 { float s[8]; };
struct EpiVT {
    static constexpr bool SUMSQ = false, COLMAJOR = true; typedef Ctx8 ColCtx;
    bf16_t* VT; const float* PSQKV;
    __device__ __forceinline__ float row_ctx(const Unit&, int) const { return 0.f; }
    __device__ __forceinline__ Ctx8 col_ctx(const Unit& u, int col) const { Ctx8 c; const int t0 = u.pn * 256 + col;
#pragma unroll
        for (int j = 0; j < 8; ++j) c.s[j] = rstd_kv(PSQKV, t0 + j);
        return c; }
    __device__ __forceinline__ bool want_partial(const Unit&) const { return false; }
    __device__ __forceinline__ void partial(const Unit&, int, int, float) const {}
    __device__ __forceinline__ float apply(const Unit& u, int row, int col, float (&v)[8], float, const Ctx8& cc) const {
#pragma unroll
        for (int j = 0; j < 8; ++j) v[j] *= cc.s[j];
        *(u32x4*)(VT + (size_t)row * T + u.pn * 256 + col) = pack8(v); return 0.f; }
};
struct EpiPlain {
    static constexpr bool SUMSQ = false, COLMAJOR = false; typedef NoCtx ColCtx;
    bf16_t* O; int ldc;
    __device__ __forceinline__ float row_ctx(const Unit&, int) const { return 0.f; }
    __device__ __forceinline__ NoCtx col_ctx(const Unit&, int) const { return NoCtx{}; }
    __device__ __forceinline__ bool want_partial(const Unit&) const { return false; }
    __device__ __forceinline__ void partial(const Unit&, int, int, float) const {}
    __device__ __forceinline__ float apply(const Unit& u, int row, int col, float (&v)[8], float, NoCtx) const {
        *(u32x4*)(O + (size_t)row * ldc + u.pn * 256 + col) = pack8(v); return 0.f; }
};
template <int MODE> struct EpiMerge {
    static constexpr bool SUMSQ = false, COLMAJOR = false; typedef NoCtx ColCtx;
    bf16_t* MG; const bf16_t* GATES;
    __device__ __forceinline__ float row_ctx(const Unit&, int) const { return 0.f; }
    __device__ __forceinline__ NoCtx col_ctx(const Unit&, int) const { return NoCtx{}; }
    __device__ __forceinline__ bool want_partial(const Unit&) const { return false; }
    __device__ __forceinline__ void partial(const Unit&, int, int, float) const {}
    __device__ __forceinline__ float apply(const Unit& u, int row, int col, float (&v)[8], float, NoCtx) const {
        const int c = u.pn * 256 + col; float g[8]; unpack8(*(const u32x4*)(GATES + (size_t)row * 2048 + MODE * 1024 + c), g);
        bf16_t* p = MG + (size_t)row * D + c;
        if (MODE == 0) {
#pragma unroll
            for (int j = 0; j < 8; ++j) v[j] *= g[j];
        } else {
            unsigned long long* p8 = (unsigned long long*)p;
            const unsigned long long lo = __hip_atomic_load(p8, __ATOMIC_RELAXED, __HIP_MEMORY_SCOPE_AGENT), hi = __hip_atomic_load(p8 + 1, __ATOMIC_RELAXED, __HIP_MEMORY_SCOPE_AGENT);
            u32x4 w; w.x = (unsigned)lo; w.y = (unsigned)(lo >> 32); w.z = (unsigned)hi; w.w = (unsigned)(hi >> 32); float a[8]; unpack8(w, a);
#pragma unroll
            for (int j = 0; j < 8; ++j) v[j] = a[j] + v[j] * g[j];
        }
        *(u32x4*)p = pack8(v); return 0.f; }
};
struct EpiOut {
    static constexpr bool SUMSQ = false, COLMAJOR = false; typedef NoCtx ColCtx;
    const float* X; float* X1; const float* MOD;
    __device__ __forceinline__ float row_ctx(const Unit&, int) const { return 0.f; }
    __device__ __forceinline__ NoCtx col_ctx(const Unit&, int) const { return NoCtx{}; }
    __device__ __forceinline__ bool want_partial(const Unit&) const { return false; }
    __device__ __forceinline__ void partial(const Unit&, int, int, float) const {}
    __device__ __forceinline__ float apply(const Unit& u, int row, int col, float (&v)[8], float, NoCtx) const {
        const int c = u.pn * 256 + col, b = row >> 12; const float* g1 = MOD + b * 6144 + 2 * 1024 + c; const float* xr = X + (size_t)row * D + c; float* o = X1 + (size_t)row * D + c;
        const f32x4 g0 = *(const f32x4*)g1, g1v = *(const f32x4*)(g1 + 4), x0 = *(const f32x4*)xr, x1v = *(const f32x4*)(xr + 4);
        f32x4 o0, o1;
#pragma unroll
        for (int j = 0; j < 4; ++j) { o0[j] = x0[j] + g0[j] * v[j]; o1[j] = x1v[j] + g1v[j] * v[4 + j]; }
        *(f32x4*)o = o0; *(f32x4*)(o + 4) = o1; return 0.f; }
};
struct EpiGU {
    static constexpr bool SUMSQ = false, COLMAJOR = false; typedef NoCtx ColCtx;
    bf16_t* ACT; const float* bgu;
    __device__ __forceinline__ float row_ctx(const Unit&, int) const { return 0.f; }
    __device__ __forceinline__ NoCtx col_ctx(const Unit&, int) const { return NoCtx{}; }
    __device__ __forceinline__ bool want_partial(const Unit&) const { return false; }
    __device__ __forceinline__ void partial(const Unit&, int, int, float) const {}
    __device__ __forceinline__ float apply(const Unit& u, int row, int col, float (&v)[8], float, NoCtx) const {
        const int p = u.pn * 256 + col; const float* bp = bgu + (size_t)u.e * 2048 + p; const f32x4 b0 = *(const f32x4*)bp, b1 = *(const f32x4*)(bp + 4);
        const float bb[8] = {b0[0], b0[1], b0[2], b0[3], b1[0], b1[1], b1[2], b1[3]}; float a[4];
#pragma unroll
        for (int i = 0; i < 4; ++i) { float gt = v[i] + bb[2 * i], up = v[4 + i] + bb[2 * i + 1]; gt = fminf(gt, 7.0f); up = fminf(fmaxf(up, -7.0f), 7.0f);
            a[i] = (up + 1.0f) * (gt * sigmoidf_(1.702f * gt)); }
        u32x2 w; w.x = pk2(a[0], a[1]); w.y = pk2(a[2], a[3]); *(u32x2*)(ACT + (size_t)row * DE + (p >> 1)) = w; return 0.f; }
};
struct EpiDown {
    static constexpr bool SUMSQ = false, COLMAJOR = false; typedef NoCtx ColCtx;
    bf16_t* Y; const float* bdn; const float* ROWW;
    __device__ __forceinline__ float row_ctx(const Unit&, int row) const { return ROWW[row]; }
    __device__ __forceinline__ NoCtx col_ctx(const Unit&, int) const { return NoCtx{}; }
    __device__ __forceinline__ bool want_partial(const Unit&) const { return false; }
    __device__ __forceinline__ void partial(const Unit&, int, int, float) const {}
    __device__ __forceinline__ float apply(const Unit& u, int row, int col, float (&v)[8], float rw, NoCtx) const {
        const int c = u.pn * 256 + col; const float* bp = bdn + (size_t)u.e * D + c; const f32x4 b0 = *(const f32x4*)bp, b1 = *(const f32x4*)(bp + 4);
#pragma unroll
        for (int j = 0; j < 4; ++j) { v[j] = (v[j] + b0[j]) * rw; v[4 + j] = (v[4 + j] + b1[j]) * rw; }
        *(u32x4*)(Y + (size_t)row * D + c) = pack8(v); return 0.f; }
};

__device__ __forceinline__ void tr_item(const float* src, int Nsrc, bf16_t* dst, int K, int kb, int pb, int lb, int perm, bool zero, const float* rs, const float* cs, LAS float* scr, int lane) {
    const int k0 = kb * 64;
#pragma unroll 4
    for (int it = 0; it < 16; ++it) {
        const int kk = 4 * it + (lane >> 4), o4 = 4 * (lane & 15);
        f32x4 v = (f32x4){0.f, 0.f, 0.f, 0.f};
        if (!zero) { v = *(const f32x4*)(src + (size_t)(k0 + kk) * Nsrc + lb + o4);
            if (rs) v *= rs[k0 + kk];
            if (cs) v *= *(const f32x4*)(cs + lb + o4); }
        int ph;
        if (perm == 1) ph = 8 * ((o4 & 31) >> 2) + 4 * (o4 >> 5);
        else if (perm == 2) ph = 8 * (o4 >> 3);
        else ph = o4;
        LAS float* s = scr + kk * 65;
        if (perm == 2) { const int w0 = o4 & 7;
            s[ph + 4 * ((w0 + 0) & 1) + ((w0 + 0) >> 1)] = v[0]; s[ph + 4 * ((w0 + 1) & 1) + ((w0 + 1) >> 1)] = v[1];
            s[ph + 4 * ((w0 + 2) & 1) + ((w0 + 2) >> 1)] = v[2]; s[ph + 4 * ((w0 + 3) & 1) + ((w0 + 3) >> 1)] = v[3]; }
        else { s[ph] = v[0]; s[ph + 1] = v[1]; s[ph + 2] = v[2]; s[ph + 3] = v[3]; }
    }
    asm volatile("s_waitcnt lgkmcnt(0)" ::: "memory");
    const int c = lane & 7;
#pragma unroll
    for (int j = 0; j < 8; ++j) { const int p = (lane >> 3) + 8 * j; const LAS float* s = scr + (8 * c) * 65 + p;
        u32x4 o; o.x = pk2(s[0 * 65], s[1 * 65]); o.y = pk2(s[2 * 65], s[3 * 65]); o.z = pk2(s[4 * 65], s[5 * 65]); o.w = pk2(s[6 * 65], s[7 * 65]);
        *(u32x4*)(dst + (size_t)(pb * 64 + p) * K + k0 + 8 * c) = o; }
    asm volatile("s_waitcnt lgkmcnt(0)" ::: "memory");
}

__device__ __forceinline__ void p0_prep(KArgP a, LAS unsigned char* lds, int vcu, int G) {
    const int tid = tid_fresh(), lane = tid & 63, wave = __builtin_amdgcn_readfirstlane(tid >> 6);
    unsigned char* ws = a->ws;
    for (int item = vcu; item < 128; item += G) {
        LAS float* cact = (LAS float*)lds;
        LAS float* part = (LAS float*)(lds + 32768);
        for (int i = tid; i < 8 * 1024; i += NTHREADS) { const float cv = a->in[I_C][i]; cact[i] = cv / (1.0f + __expf(-cv)); }
        __syncthreads();
        const bool isf = item >= 96; const float* W = isf ? a->in[I_WFMOD] : a->in[I_WMOD]; const int N = isf ? 2048 : 6144, j0 = (isf ? item - 96 : item) * 64;
        float acc[8];
#pragma unroll
        for (int b = 0; b < 8; ++b) acc[b] = 0.f;
        for (int k = wave * 128; k < wave * 128 + 128; ++k) { const float w = W[(size_t)k * N + j0 + lane];
#pragma unroll
            for (int b = 0; b < 8; ++b) acc[b] += cact[b * 1024 + k] * w; }
#pragma unroll
        for (int b = 0; b < 8; ++b) part[(wave * 8 + b) * 64 + lane] = acc[b];
        __syncthreads();
        { const int b = tid >> 6, col = tid & 63; float s = 0.f;
#pragma unroll
            for (int w = 0; w < 8; ++w) s += part[(w * 8 + b) * 64 + col];
            if (isf) ((float*)(ws + WS_FMOD))[b * 2048 + j0 + col] = s + a->in[I_BFMOD][j0 + col];
            else ((float*)(ws + WS_MOD))[b * 6144 + j0 + col] = s + a->in[I_BMOD][j0 + col]; }
        __syncthreads();
    }
    { const int* pos = (const int*)a->in[I_POS]; f32x2* CS = (f32x2*)(ws + WS_CS);
        for (int idx = vcu * NTHREADS + tid; idx < T * 32; idx += G * NTHREADS) { const int t = idx >> 5, i = idx & 31;
            const double invf = exp(-(double)i * (9.210340371976184 / 32.0));
            const double ang = (double)pos[t] * invf; const double n = rint(ang * 0.15915494309189535); const float r = (float)(ang - n * 6.283185307179586);
            CS[idx] = (f32x2){__cosf(r), __sinf(r)}; } }
    { bf16_t* WR = (bf16_t*)(ws + WS_WR);
        for (int idx = vcu * NTHREADS + tid; idx < 1024 * 32; idx += G * NTHREADS) { const int e = idx & 31, k = idx >> 5; const float v = a->in[I_WR][idx];
            const unsigned h = pk2(v, 0.f) & 0xffffu; const float lo = v - bflo(h); WR[e * 1024 + k] = (bf16_t)h; WR[32768 + e * 1024 + k] = (bf16_t)(pk2(lo, 0.f) & 0xffffu); } }
    LAS float* scr = (LAS float*)(lds + wave * 16640);
    const int gw = vcu * 8 + wave, NGW = G * 8;
    constexpr int N_IN = 16 * 68, N_Q = 12 * 24, N_K = 4 * 16, N_V = 4 * 16, N_G = 4 * 16, N_SQ = 16 * 16, N_GU = 32 * 16 * 32, N_DN = 32 * 16 * 16;
    constexpr int NITEMS = N_IN + N_Q + N_K + N_V + N_G + 3 * N_SQ + N_GU + N_DN;
    for (int it = gw; it < NITEMS; it += NGW) {
        int r = it;
        if (r < N_IN) { const int pb = r % 68, kb = r / 68; int lb, perm = 0; bool zero = false;
            if (pb < 32) lb = pb * 64; else if (pb < 64) lb = pb * 64 + 64; else if (pb == 64) { lb = 2048; perm = 1; } else { lb = 0; zero = true; }
            tr_item(a->in[I_WIN], IN_W, (bf16_t*)(ws + WS_WIN), 1024, kb, pb, lb, perm, zero, nullptr, nullptr, scr, lane); continue; } r -= N_IN;
        if (r < N_Q) { const int pb = r % 24, kb = r / 24; int lb, perm = 0;
            if (pb < 16) lb = (pb >> 1) * QKD + (pb & 1) * 64; else { lb = (pb - 16) * QKD + NOPE; perm = 1; }
            tr_item(a->in[I_WQB], NH * QKD, (bf16_t*)(ws + WS_WQ), QL, kb, pb, lb, perm, false, a->in[I_GQA], nullptr, scr, lane); continue; } r -= N_Q;
        if (r < N_K) { const int pb = r % 16, kb = r / 16; const int lb = (pb >> 1) * 256 + (pb & 1) * 64;
            tr_item(a->in[I_WKVB], NH * 256, (bf16_t*)(ws + WS_WK), KVL, kb, pb, lb, 0, false, a->in[I_GKVA], nullptr, scr, lane); continue; } r -= N_K;
        if (r < N_V) { const int pb = r % 16, kb = r / 16; const int lb = (pb >> 1) * 256 + 128 + (pb & 1) * 64;
            tr_item(a->in[I_WKVB], NH * 256, (bf16_t*)(ws + WS_WV), KVL, kb, pb, lb, 0, false, a->in[I_GKVA], nullptr, scr, lane); continue; } r -= N_V;
        if (r < N_G) { const int g = r / 16, q = r % 16, pb = q % 4, kb = q / 4;
            tr_item(a->in[I_WPG] + (size_t)g * 65536, 256, (bf16_t*)(ws + WS_WGRP) + (size_t)g * 65536, 256, kb, pb, pb * 64, 0, false, nullptr, a->in[I_PSCALE] + g * 256, scr, lane); continue; } r -= N_G;
        if (r < 3 * N_SQ) { const int which = r / N_SQ, q = r % N_SQ, pb = q % 16, kb = q / 16;
            const float* src = which == 0 ? a->in[I_WPO] : which == 1 ? a->in[I_WMO] : a->in[I_WOUT]; const size_t off = which == 0 ? WS_WPO : which == 1 ? WS_WMO : WS_WOUT;
            tr_item(src, 1024, (bf16_t*)(ws + off), 1024, kb, pb, pb * 64, 0, false, nullptr, nullptr, scr, lane); continue; } r -= 3 * N_SQ;
        if (r < N_GU) { const int e = r / 512, q = r % 512, pb = q % 32, kb = q / 32;
            tr_item(a->in[I_WGU] + (size_t)e * 1024 * 2048, 2048, (bf16_t*)(ws + WS_WGU) + (size_t)e * 2048 * 1024, 1024, kb, pb, pb * 64, 2, false, nullptr, nullptr, scr, lane); continue; } r -= N_GU;
        { const int e = r / 256, q = r % 256, pb = q % 16, kb = q / 16;
            tr_item(a->in[I_WDN] + (size_t)e * 1024 * 1024, 1024, (bf16_t*)(ws + WS_WDN) + (size_t)e * 1024 * 1024, 1024, kb, pb, pb * 64, 0, false, nullptr, nullptr, scr, lane); }
    }
}

__device__ __forceinline__ void p1_hb(KArgP a, int vcu, int G) {
    const int tid = tid_fresh(), lane = tid & 63, wave = tid >> 6;
    const float* MOD = (const float*)(a->ws + WS_MOD); bf16_t* HB = (bf16_t*)(a->ws + WS_S0);
    for (int rb = vcu * 128; rb < T; rb += G * 128) {
        const int b = rb >> 12;
        f32x4 gs[4], sh[4];
#pragma unroll
        for (int j = 0; j < 4; ++j) { const int c = 4 * lane + 256 * j; const f32x4 g = *(const f32x4*)(a->in[I_GMIX] + c), sc = *(const f32x4*)(MOD + b * 6144 + 1024 + c);
            gs[j] = g * (sc + 1.0f); sh[j] = *(const f32x4*)(MOD + b * 6144 + c); }
        for (int i = 0; i < 16; ++i) { const int r = rb + wave * 16 + i; const f32x4* xr = (const f32x4*)(a->in[I_X] + (size_t)r * D) + lane;
            f32x4 v[4]; float s = 0.f;
#pragma unroll
            for (int j = 0; j < 4; ++j) { v[j] = xr[64 * j]; s += (v[j][0] * v[j][0] + v[j][1] * v[j][1]) + (v[j][2] * v[j][2] + v[j][3] * v[j][3]); }
            const float rstd = rsqrtf(wave_sum(s) * (1.0f / D) + EPS);
            u32x2* o = (u32x2*)(HB + (size_t)r * D) + lane;
#pragma unroll
            for (int j = 0; j < 4; ++j) { const f32x4 h = v[j] * rstd * gs[j] + sh[j]; u32x2 w; w.x = pk2(h[0], h[1]); w.y = pk2(h[2], h[3]); o[64 * j] = w; } }
    }
}

__device__ __forceinline__ void p3_mixed(KArgP a, int vcu, int G) {
    const int tid = tid_fresh(); const bf16_t* U = (const bf16_t*)(a->ws + WS_S1); bf16_t* MX = (bf16_t*)(a->ws + WS_S0);
    for (int rb = vcu * 128; rb < T; rb += G * 128) {
        for (int q = 0; q < 2; ++q) { const int item = tid + NTHREADS * q, cgi = item & 127, seg = item >> 7;
            const int w = 2 << (cgi >> 5), row0 = rb + seg * 16, s0 = row0 & (SEQ - 1);
            float sum[8];
#pragma unroll
            for (int j = 0; j < 8; ++j) sum[j] = 0.f;
            for (int k = 1; k < w; ++k) if (s0 - k >= 0) { float f[8]; unpack8(*(const u32x4*)(U + (size_t)(row0 - k) * D + cgi * 8), f);
#pragma unroll
                for (int j = 0; j < 8; ++j) sum[j] += f[j]; }
            for (int i = 0; i < 16; ++i) { const int r = row0 + i, s = s0 + i; float cur[8]; unpack8(*(const u32x4*)(U + (size_t)r * D + cgi * 8), cur);
                const float inv = 1.0f / (float)(s + 1 < w ? s + 1 : w); float o[8];
#pragma unroll
                for (int j = 0; j < 8; ++j) { sum[j] += cur[j]; o[j] = sum[j] * inv - cur[j]; }
                *(u32x4*)(MX + (size_t)r * D + cgi * 8) = pack8(o);
                if (s - (w - 1) >= 0) { float f[8]; unpack8(*(const u32x4*)(U + (size_t)(r - (w - 1)) * D + cgi * 8), f);
#pragma unroll
                    for (int j = 0; j < 8; ++j) sum[j] -= f[j]; } }
        }
    }
}

__device__ __forceinline__ void attn_naive(KArgP a, LAS unsigned char* lds, int vcu, int G) {
    const int tid = tid_fresh(), qi = tid >> 3, part = tid & 7;
    const bf16_t* Q = (const bf16_t*)(a->ws + WS_Q); const bf16_t* KN = (const bf16_t*)(a->ws + WS_KN); const bf16_t* KPE = (const bf16_t*)(a->ws + WS_KPE);
    const bf16_t* VT = (const bf16_t*)(a->ws + WS_VT); bf16_t* O = (bf16_t*)(a->ws + WS_O);
    LAS unsigned char* Qs = lds;
    LAS unsigned char* Ks = lds + 25600;
    LAS unsigned char* Vs = lds + 51200;
    LAS float* Ss = (LAS float*)(lds + 69632);
    for (int it = vcu; it < NB * NH * 64; it += G) {
        const int c = 63 - (it & 63), bh = it >> 6, b = bh >> 3, h = bh & 7; const int t0 = b * SEQ + c * 64;
        __syncthreads();
#pragma unroll
        for (int i = 0; i < 3; ++i) { const int ch = tid + NTHREADS * i, row = ch / 24, kc = ch % 24;
            *(LAS u32x4*)(Qs + row * 400 + kc * 16) = *(const u32x4*)(Q + (size_t)(t0 + row) * (NH * QKD) + h * QKD + kc * 8); }
        float m = -1e30f, l = 0.f, o[16];
#pragma unroll
        for (int dd = 0; dd < 16; ++dd) o[dd] = 0.f;
        for (int kt = 0; kt <= c; ++kt) {
            const int k0 = b * SEQ + kt * 64;
            __syncthreads();
#pragma unroll
            for (int i = 0; i < 2; ++i) { const int ch = tid + NTHREADS * i, row = ch >> 4, kc = ch & 15;
                *(LAS u32x4*)(Ks + row * 400 + kc * 16) = *(const u32x4*)(KN + (size_t)(k0 + row) * D + h * 128 + kc * 8); }
            { const int row = tid >> 3, kc = tid & 7; *(LAS u32x4*)(Ks + row * 400 + 256 + kc * 16) = *(const u32x4*)(KPE + (size_t)(k0 + row) * 64 + kc * 8); }
#pragma unroll
            for (int i = 0; i < 2; ++i) { const int ch = tid + NTHREADS * i, d = ch >> 3, kc = ch & 7;
                *(LAS u32x4*)(Vs + d * 144 + kc * 16) = *(const u32x4*)(VT + (size_t)(h * 128 + d) * T + k0 + kc * 8); }
            __syncthreads();
            float s[8];
#pragma unroll
            for (int j = 0; j < 8; ++j) s[j] = 0.f;
            for (int d8 = 0; d8 < 24; ++d8) { float q8[8]; unpack8(*(const LAS u32x4*)(Qs + qi * 400 + d8 * 16), q8);
#pragma unroll
                for (int j = 0; j < 8; ++j) { float k8[8]; unpack8(*(const LAS u32x4*)(Ks + (part * 8 + j) * 400 + d8 * 16), k8);
#pragma unroll
                    for (int e = 0; e < 8; ++e) s[j] += q8[e] * k8[e]; } }
#pragma unroll
            for (int j = 0; j < 8; ++j) Ss[qi * 65 + part * 8 + j] = s[j];
            __syncthreads();
            float mx = -1e30f;
            for (int k = 0; k < 64; ++k) mx = fmaxf(mx, Ss[qi * 65 + k]);
            const float mn = fmaxf(m, mx), alpha = exp2f(m - mn); float ls = 0.f;
            for (int k = 0; k < 64; ++k) ls += exp2f(Ss[qi * 65 + k] - mn);
            l = l * alpha + ls; m = mn;
#pragma unroll
            for (int dd = 0; dd < 16; ++dd) o[dd] *= alpha;
            for (int k8 = 0; k8 < 8; ++k8) { float p8[8];
#pragma unroll
                for (int e = 0; e < 8; ++e) p8[e] = exp2f(Ss[qi * 65 + k8 * 8 + e] - mn);
#pragma unroll
                for (int dd = 0; dd < 16; ++dd) { float v8[8]; unpack8(*(const LAS u32x4*)(Vs + (part * 16 + dd) * 144 + k8 * 16), v8);
#pragma unroll
                    for (int e = 0; e < 8; ++e) o[dd] += p8[e] * v8[e]; } }
        }
        const float il = 1.0f / l; float o0[8], o1[8];
#pragma unroll
        for (int j = 0; j < 8; ++j) { o0[j] = o[j] * il; o1[j] = o[8 + j] * il; }
        bf16_t* op = O + (size_t)(t0 + qi) * D + h * 128 + part * 16; *(u32x4*)op = pack8(o0); *(u32x4*)(op + 8) = pack8(o1);
    }
    __syncthreads();
}

typedef float f32x16 __attribute__((ext_vector_type(16)));
__device__ __forceinline__ int kperm(int r) { return (r & ~12) | ((r & 4) << 1) | ((r & 8) >> 1); }
__device__ __forceinline__ void attn_fast(KArgP a, LAS unsigned char* lds, int vcu, int G) {
    const int tid = tid_fresh(), lane = tid & 63, wid = __builtin_amdgcn_readfirstlane(tid >> 6), i32 = lane & 31, hi = lane >> 5;
    const bf16_t* Q = (const bf16_t*)(a->ws + WS_Q); const bf16_t* KN = (const bf16_t*)(a->ws + WS_KN); const bf16_t* KPE = (const bf16_t*)(a->ws + WS_KPE);
    const bf16_t* VT = (const bf16_t*)(a->ws + WS_VT); bf16_t* O = (bf16_t*)(a->ws + WS_O);
    constexpr int BUF = 40960, KP_OFF = 16384, VT_OFF = 24576;
    const int rK = 4 * wid + (lane >> 4); const unsigned srcK = (unsigned)(kperm(rK) * 1024 + (((lane & 15) ^ (rK & 15)) * 8));
    const int rP = 8 * wid + (lane >> 3); const unsigned srcP = (unsigned)(kperm(rP) * 64 + (((lane & 7) ^ ((rP >> 1) & 7)) * 8));
    const int dV = 8 * wid + (lane >> 3); const size_t srcV = (size_t)dV * T + (size_t)(((lane & 7) ^ ((dV >> 1) & 7)) * 8);
    const int xk = i32 & 15, xp = (i32 >> 1) & 7;
    int koff[8], poff[4], voff[4];
#pragma unroll
    for (int ds = 0; ds < 8; ++ds) koff[ds] = i32 * 256 + (((2 * ds + hi) ^ xk) << 4);
#pragma unroll
    for (int ds = 0; ds < 4; ++ds) poff[ds] = KP_OFF + i32 * 128 + (((2 * ds + hi) ^ xp) << 4);
#pragma unroll
    for (int c = 0; c < 4; ++c) voff[c] = VT_OFF + i32 * 128 + (((2 * c + hi) ^ xp) << 4);
    const int nun = (G == 256) ? 4 : (NB * NH * 16 + G - 1) / G;
    for (int ui = 0; ui < nun; ++ui) {
        int bh, qb;
        if (G == 256) { const int s4 = vcu & 3; bh = vcu >> 2; qb = ui == 0 ? 15 - s4 : ui == 1 ? s4 : ui == 2 ? 11 - s4 : 4 + s4; }
        else { const int it = vcu + ui * G; if (it >= NB * NH * 16) break; bh = it >> 4; qb = 15 - (it & 15); }
        const int b = bh >> 3, h = bh & 7, t0 = b * SEQ + qb * 256, NT = 4 * qb + 4, myjmax = 4 * qb + (wid >> 1);
        const bf16_t* gK = KN + (size_t)b * SEQ * 1024 + h * 128 + srcK; const bf16_t* gP = KPE + (size_t)b * SEQ * 64 + srcP; const bf16_t* gV = VT + (size_t)(h * 128) * T + (size_t)b * SEQ + srcV;
#define ATT_STAGE(j, bo) do { \
        __builtin_amdgcn_global_load_lds((const unsigned*)(gK + (size_t)(j) * 65536), (LAS unsigned*)(lds + (bo) + wid * 1024), 16, 0, 0); \
        __builtin_amdgcn_global_load_lds((const unsigned*)(gK + (size_t)(j) * 65536 + 32768), (LAS unsigned*)(lds + (bo) + 8192 + wid * 1024), 16, 0, 0); \
        __builtin_amdgcn_global_load_lds((const unsigned*)(gP + (size_t)(j) * 4096), (LAS unsigned*)(lds + (bo) + KP_OFF + wid * 1024), 16, 0, 0); \
        __builtin_amdgcn_global_load_lds((const unsigned*)(gV + (size_t)(j) * 64), (LAS unsigned*)(lds + (bo) + VT_OFF + wid * 1024), 16, 0, 0); \
        __builtin_amdgcn_global_load_lds((const unsigned*)(gV + (size_t)(j) * 64 + (size_t)64 * T), (LAS unsigned*)(lds + (bo) + VT_OFF + 8192 + wid * 1024), 16, 0, 0); } while (0)
        ATT_STAGE(0, 0);
        bf16x8 qf[12];
        { const bf16_t* qp = Q + (size_t)(t0 + 32 * wid + i32) * (NH * QKD) + h * QKD + 8 * hi;
#pragma unroll
            for (int ds = 0; ds < 12; ++ds) qf[ds] = *(const bf16x8*)(qp + 16 * ds); }
        f32x16 o[4];
#pragma unroll
        for (int d = 0; d < 4; ++d)
#pragma unroll
            for (int r = 0; r < 16; ++r) o[d][r] = 0.f;
        float m = -1e30f, l = 0.f;
        asm volatile("s_waitcnt vmcnt(0)" ::: "memory");
        __syncthreads();
        for (int j = 0; j < NT; ++j) {
            const int bo = (j & 1) * BUF;
            if (j + 1 < NT) ATT_STAGE(j + 1, BUF - bo);
            if (j <= myjmax) {
                const LAS unsigned char* kb = lds + bo;
                f32x16 p0, p1;
#pragma unroll
                for (int r = 0; r < 16; ++r) { p0[r] = 0.f; p1[r] = 0.f; }
#pragma unroll
                for (int ds = 0; ds < 8; ++ds) { const bf16x8 k0 = *(const LAS bf16x8*)(kb + koff[ds]), k1 = *(const LAS bf16x8*)(kb + koff[ds] + 8192);
                    p0 = __builtin_amdgcn_mfma_f32_32x32x16_bf16(k0, qf[ds], p0, 0, 0, 0); p1 = __builtin_amdgcn_mfma_f32_32x32x16_bf16(k1, qf[ds], p1, 0, 0, 0); }
#pragma unroll
                for (int ds = 0; ds < 4; ++ds) { const bf16x8 k0 = *(const LAS bf16x8*)(kb + poff[ds]), k1 = *(const LAS bf16x8*)(kb + poff[ds] + 4096);
                    p0 = __builtin_amdgcn_mfma_f32_32x32x16_bf16(k0, qf[8 + ds], p0, 0, 0, 0); p1 = __builtin_amdgcn_mfma_f32_32x32x16_bf16(k1, qf[8 + ds], p1, 0, 0, 0); }
                float mx = fmaxf(p0[0], p1[0]);
#pragma unroll
                for (int r = 1; r < 16; ++r) mx = fmaxf(mx, fmaxf(p0[r], p1[r]));
                mx = fmaxf(mx, __shfl_xor(mx, 32));
                const float mn = fmaxf(m, mx), alpha = __builtin_amdgcn_exp2f(m - mn); m = mn;
                float ls = 0.f;
#pragma unroll
                for (int r = 0; r < 16; ++r) { p0[r] = __builtin_amdgcn_exp2f(p0[r] - mn); p1[r] = __builtin_amdgcn_exp2f(p1[r] - mn); ls += p0[r] + p1[r]; }
                l = l * alpha + ls;
                if (__any(alpha != 1.0f)) {
#pragma unroll
                    for (int d = 0; d < 4; ++d)
#pragma unroll
                        for (int r = 0; r < 16; ++r) o[d][r] *= alpha;
                }
                bf16x8 pk[4];
#pragma unroll
                for (int s = 0; s < 2; ++s) {
                    u32x4 w0, w1;
                    w0.x = pk2(p0[8 * s + 0], p0[8 * s + 1]); w0.y = pk2(p0[8 * s + 2], p0[8 * s + 3]); w0.z = pk2(p0[8 * s + 4], p0[8 * s + 5]); w0.w = pk2(p0[8 * s + 6], p0[8 * s + 7]);
                    w1.x = pk2(p1[8 * s + 0], p1[8 * s + 1]); w1.y = pk2(p1[8 * s + 2], p1[8 * s + 3]); w1.z = pk2(p1[8 * s + 4], p1[8 * s + 5]); w1.w = pk2(p1[8 * s + 6], p1[8 * s + 7]);
                    pk[s] = __builtin_bit_cast(bf16x8, w0); pk[2 + s] = __builtin_bit_cast(bf16x8, w1);
                }
#pragma unroll
                for (int d = 0; d < 4; ++d)
#pragma unroll
                    for (int c = 0; c < 4; ++c) { const bf16x8 vf = *(const LAS bf16x8*)(kb + voff[c] + d * 4096);
                        o[d] = __builtin_amdgcn_mfma_f32_32x32x16_bf16(vf, pk[c], o[d], 0, 0, 0); }
            }
            asm volatile("s_waitcnt vmcnt(0)" ::: "memory");
            __syncthreads();
        }
#undef ATT_STAGE
        l += __shfl_xor(l, 32);
        const float il = 1.0f / l;
        bf16_t* op = O + (size_t)(t0 + 32 * wid + i32) * D + h * 128 + 4 * hi;
#pragma unroll
        for (int d = 0; d < 4; ++d)
#pragma unroll
            for (int g4 = 0; g4 < 4; ++g4) { u32x2 w; w.x = pk2(o[d][4 * g4] * il, o[d][4 * g4 + 1] * il); w.y = pk2(o[d][4 * g4 + 2] * il, o[d][4 * g4 + 3] * il);
                *(u32x2*)(op + 32 * d + 8 * g4) = w; }
    }
    __syncthreads();
}

__device__ __forceinline__ void p7_router(KArgP a, LAS unsigned char* lds, int vcu, int G) {
    const int tid = tid_fresh(), lane = tid & 63, wave = tid >> 6, rr = lane & 15, g = lane >> 4;
    const float* MOD = (const float*)(a->ws + WS_MOD); const float* X1 = a->out; bf16_t* H2 = (bf16_t*)(a->ws + WS_S0);
    int* TKI = (int*)(a->ws + WS_TKI); float* TKW = (float*)(a->ws + WS_TKW); int* RANK = (int*)(a->ws + WS_RANK); int* COUNTS = (int*)(a->ws + WS_COUNTS);
    LAS int* cnt = (LAS int*)(lds + 131072);
    __syncthreads();
    { const u32x4* src = (const u32x4*)(a->ws + WS_WR);
        for (int ch = tid; ch < 8192; ch += NTHREADS) { const int hl = ch >> 12, e = (ch >> 7) & 31, kc = ch & 127;
            *(LAS u32x4*)(lds + hl * 65536 + e * 2048 + ((kc ^ (e & 15)) << 4)) = src[ch]; } }
    for (int rb = vcu * 128; rb < T; rb += G * 128) {
        if (tid < 32) cnt[tid] = 0;
        __syncthreads();
        const int r0 = rb + wave * 16, b = rb >> 12, row = r0 + rr;
        const float* xr = X1 + (size_t)row * D + 8 * g;
        float ss = 0.f;
        for (int s = 0; s < 32; ++s) { const f32x4 x0 = *(const f32x4*)(xr + 32 * s), x1 = *(const f32x4*)(xr + 32 * s + 4);
            ss += (x0[0] * x0[0] + x0[1] * x0[1]) + (x0[2] * x0[2] + x0[3] * x0[3]) + (x1[0] * x1[0] + x1[1] * x1[1]) + (x1[2] * x1[2] + x1[3] * x1[3]); }
        ss += __shfl_xor(ss, 16); ss += __shfl_xor(ss, 32);
        const float rstd = rsqrtf(ss * (1.0f / D) + EPS);
        f32x4 acc0 = (f32x4){0.f, 0.f, 0.f, 0.f}, acc1 = acc0;
        const float* gf = a->in[I_GFFN] + 8 * g; const float* sc2 = MOD + b * 6144 + 4 * 1024 + 8 * g; const float* sh2 = MOD + b * 6144 + 3 * 1024 + 8 * g;
        for (int s = 0; s < 32; ++s) {
            const f32x4 x0 = *(const f32x4*)(xr + 32 * s), x1 = *(const f32x4*)(xr + 32 * s + 4);
            const f32x4 g0 = *(const f32x4*)(gf + 32 * s), g1 = *(const f32x4*)(gf + 32 * s + 4), c0 = *(const f32x4*)(sc2 + 32 * s), c1 = *(const f32x4*)(sc2 + 32 * s + 4);
            const f32x4 h0 = x0 * rstd * g0 * (c0 + 1.0f) + *(const f32x4*)(sh2 + 32 * s), h1 = x1 * rstd * g1 * (c1 + 1.0f) + *(const f32x4*)(sh2 + 32 * s + 4);
            u32x4 hi; hi.x = pk2(h0[0], h0[1]); hi.y = pk2(h0[2], h0[3]); hi.z = pk2(h1[0], h1[1]); hi.w = pk2(h1[2], h1[3]);
            *(u32x4*)(H2 + (size_t)row * D + 32 * s + 8 * g) = hi;
            float hf[8]; unpack8(hi, hf);
            u32x4 lo; lo.x = pk2(h0[0] - hf[0], h0[1] - hf[1]); lo.y = pk2(h0[2] - hf[2], h0[3] - hf[3]); lo.z = pk2(h1[0] - hf[4], h1[1] - hf[5]); lo.w = pk2(h1[2] - hf[6], h1[3] - hf[7]);
            const bf16x8 Ah = __builtin_bit_cast(bf16x8, hi), Al = __builtin_bit_cast(bf16x8, lo);
            const int kc = 4 * s + g;
            const bf16x8 Bh0 = *(const LAS bf16x8*)(lds + rr * 2048 + ((kc ^ rr) << 4)), Bh1 = *(const LAS bf16x8*)(lds + (16 + rr) * 2048 + ((kc ^ rr) << 4));
            const bf16x8 Bl0 = *(const LAS bf16x8*)(lds + 65536 + rr * 2048 + ((kc ^ rr) << 4)), Bl1 = *(const LAS bf16x8*)(lds + 65536 + (16 + rr) * 2048 + ((kc ^ rr) << 4));
            acc0 = __builtin_amdgcn_mfma_f32_16x16x32_bf16(Ah, Bh0, acc0, 0, 0, 0); acc0 = __builtin_amdgcn_mfma_f32_16x16x32_bf16(Al, Bh0, acc0, 0, 0, 0); acc0 = __builtin_amdgcn_mfma_f32_16x16x32_bf16(Ah, Bl0, acc0, 0, 0, 0);
            acc1 = __builtin_amdgcn_mfma_f32_16x16x32_bf16(Ah, Bh1, acc1, 0, 0, 0); acc1 = __builtin_amdgcn_mfma_f32_16x16x32_bf16(Al, Bh1, acc1, 0, 0, 0); acc1 = __builtin_amdgcn_mfma_f32_16x16x32_bf16(Ah, Bl1, acc1, 0, 0, 0);
        }
        const float br0 = a->in[I_BR][rr], br1 = a->in[I_BR][16 + rr];
#pragma unroll
        for (int reg = 0; reg < 4; ++reg) {
            float v0 = acc0[reg] + br0, v1 = acc1[reg] + br1; float tv[4]; int ti[4];
#pragma unroll
            for (int k = 0; k < 4; ++k) {
                float bv = v0; int bi = rr; if (v1 > bv) { bv = v1; bi = 16 + rr; }
#pragma unroll
                for (int o = 1; o < 16; o <<= 1) { const float ov = __shfl_xor(bv, o); const int oi = __shfl_xor(bi, o); if (ov > bv || (ov == bv && oi < bi)) { bv = ov; bi = oi; } }
                tv[k] = bv; ti[k] = bi; if (bi == rr) v0 = -INFINITY; if (bi == 16 + rr) v1 = -INFINITY;
            }
            if (rr == 0) { const int t = r0 + 4 * g + reg;
                const float e1 = __expf(tv[1] - tv[0]), e2 = __expf(tv[2] - tv[0]), e3 = __expf(tv[3] - tv[0]), inv = 1.0f / (1.0f + e1 + e2 + e3);
                *(f32x4*)(TKW + (size_t)t * 4) = (f32x4){inv, e1 * inv, e2 * inv, e3 * inv};
                int rk[4];
#pragma unroll
                for (int k = 0; k < 4; ++k) rk[k] = __hip_atomic_fetch_add(cnt + ti[k], 1, __ATOMIC_RELAXED, __HIP_MEMORY_SCOPE_WORKGROUP);
                *(u32x4*)(TKI + (size_t)t * 4) = (u32x4){(unsigned)ti[0], (unsigned)ti[1], (unsigned)ti[2], (unsigned)ti[3]};
                *(u32x4*)(RANK + (size_t)t * 4) = (u32x4){(unsigned)rk[0], (unsigned)rk[1], (unsigned)rk[2], (unsigned)rk[3]}; }
        }
        __syncthreads();
        if (tid < 32) COUNTS[(rb >> 7) * 32 + tid] = cnt[tid];
        __syncthreads();
    }
}

__device__ __forceinline__ void p8_scatter(KArgP a, LAS unsigned char* lds, int vcu, int G) {
    const int tid = tid_fresh(), lane = tid & 63, wave = tid >> 6;
    const int* COUNTS = (const int*)(a->ws + WS_COUNTS); const int* TKI = (const int*)(a->ws + WS_TKI); const float* TKW = (const float*)(a->ws + WS_TKW); const int* RANK = (const int*)(a->ws + WS_RANK);
    int* SLOTROW = (int*)(a->ws + WS_SLOTROW); float* ROWW = (float*)(a->ws + WS_ROWW); int* TILEE = (int*)(a->ws + WS_TILEE);
    const bf16_t* H2 = (const bf16_t*)(a->ws + WS_S0); bf16_t* XS = (bf16_t*)(a->ws + WS_XS);
    LAS int* ptot = (LAS int*)lds;
    LAS int* pbef = ptot + 512;
    LAS int* base = pbef + 512;
    for (int rb = vcu * 128; rb < T; rb += G * 128) {
        const int blk = rb >> 7;
        __syncthreads();
        { const int e = tid & 31, pt = tid >> 5; int st = 0, sb = 0;
            for (int bb = pt * 16; bb < pt * 16 + 16; ++bb) { const int cv = COUNTS[bb * 32 + e]; st += cv; if (bb < blk) sb += cv; }
            ptot[pt * 32 + e] = st; pbef[pt * 32 + e] = sb; }
        __syncthreads();
        if (tid == 0) { int ps = 0;
            for (int e = 0; e < 32; ++e) { int tot = 0, bef = 0;
                for (int pt = 0; pt < 16; ++pt) { tot += ptot[pt * 32 + e]; bef += pbef[pt * 32 + e]; }
                base[e] = ps + bef;
                const int ntl = (tot + 255) >> 8;
                if (blk == 0) { for (int q = 0; q < ntl; ++q) TILEE[(ps >> 8) + q] = e; }
                ps += ntl << 8; }
            if (blk == 0) TILEE[1023] = ps >> 8; }
        __syncthreads();
        for (int sidx = wave; sidx < 512; sidx += 8) { const int t = rb + (sidx >> 2), k = sidx & 3;
            const int e = TKI[(size_t)t * 4 + k], dest = base[e] + RANK[(size_t)t * 4 + k];
            if (lane == 0) { SLOTROW[(size_t)t * 4 + k] = dest; ROWW[dest] = TKW[(size_t)t * 4 + k]; }
            const u32x4* src = (const u32x4*)(H2 + (size_t)t * D); u32x4* dst = (u32x4*)(XS + (size_t)dest * D);
            dst[lane] = src[lane]; dst[64 + lane] = src[64 + lane]; }
    }
    __syncthreads();
}

__device__ __forceinline__ void p11_final(KArgP a, int vcu, int G) {
    const int tid = tid_fresh(), lane = tid & 63, wave = tid >> 6;
    const float* MOD = (const float*)(a->ws + WS_MOD); const float* FMOD = (const float*)(a->ws + WS_FMOD); const int* SLOTROW = (const int*)(a->ws + WS_SLOTROW);
    const bf16_t* Y = (const bf16_t*)(a->ws + WS_XS); float* OUT = a->out;
    for (int rb = vcu * 128; rb < T; rb += G * 128) {
        const int b = rb >> 12;
        f32x4 g2[4], gs[4], sh[4];
#pragma unroll
        for (int j = 0; j < 4; ++j) { const int c = 4 * lane + 256 * j; g2[j] = *(const f32x4*)(MOD + b * 6144 + 5 * 1024 + c);
            gs[j] = *(const f32x4*)(a->in[I_GFIN] + c) * (*(const f32x4*)(FMOD + b * 2048 + 1024 + c) + 1.0f); sh[j] = *(const f32x4*)(FMOD + b * 2048 + c); }
        for (int i = 0; i < 16; ++i) { const int t = rb + wave * 16 + i; const u32x4 sr = *(const u32x4*)(SLOTROW + (size_t)t * 4);
            f32x4* xr = (f32x4*)(OUT + (size_t)t * D) + lane; f32x4 v[4]; float s = 0.f;
#pragma unroll
            for (int j = 0; j < 4; ++j) { f32x4 mo = (f32x4){0.f, 0.f, 0.f, 0.f};
#pragma unroll
                for (int k = 0; k < 4; ++k) { const u32x2 w = *((const u32x2*)(Y + (size_t)sr[k] * D) + lane + 64 * j); mo[0] += bflo(w.x); mo[1] += bfhi(w.x); mo[2] += bflo(w.y); mo[3] += bfhi(w.y); }
                v[j] = xr[64 * j] + g2[j] * mo; s += (v[j][0] * v[j][0] + v[j][1] * v[j][1]) + (v[j][2] * v[j][2] + v[j][3] * v[j][3]); }
            const float rstd = rsqrtf(wave_sum(s) * (1.0f / D) + EPS);
#pragma unroll
            for (int j = 0; j < 4; ++j) xr[64 * j] = v[j] * rstd * gs[j] + sh[j]; }
    }
}

#define RLX_AGENT __ATOMIC_RELAXED, __HIP_MEMORY_SCOPE_AGENT
#define XB_TMO      128
#define XB_XCNT(j)  (256  + 64 * (j))
#define XB_XSUB(j)  (1280 + 64 * (j))
#define XB_XGEN(j)  (2304 + 64 * (j))
#define XB_TOP      3328
#define XB_TOPGEN   3392
#define XCD_BAR_WORDS 3456
#define XB_SPIN_CAP (1u << 18)
__device__ __forceinline__ unsigned xb_ld(unsigned* p)              { return __hip_atomic_load(p, __ATOMIC_RELAXED, __HIP_MEMORY_SCOPE_AGENT); }
__device__ __forceinline__ unsigned xb_add(unsigned* p, unsigned v) { return __hip_atomic_fetch_add(p, v, __ATOMIC_RELAXED, __HIP_MEMORY_SCOPE_AGENT); }
__device__ __forceinline__ unsigned xb_xcc_id() { return (unsigned)__builtin_amdgcn_s_getreg((3 << 11) | 20) & 0xFu; }
#define XB_SPIN(cond, bar) do { unsigned _sp = 0; while (cond) { __builtin_amdgcn_s_sleep(1); \
    if ((++_sp & 255u) == 0u) { if (xb_ld(&(bar)[XB_TMO])) break; if (_sp > XB_SPIN_CAP) { atomicAdd(&(bar)[XB_TMO], 1u); break; } } } } while (0)
struct XcdBarrier { unsigned* bar; unsigned x; volatile LAS unsigned* st; };
__device__ __forceinline__ XcdBarrier xcd_barrier_post(unsigned* bar, volatile LAS unsigned* st) {
    XcdBarrier b; b.bar = bar; b.x = xb_xcc_id(); b.st = st;
    if (threadIdx.x == 0) (void)xb_add(&bar[XB_XCNT(b.x)], 1u);
    return b;
}
__device__ __forceinline__ void xcd_barrier_complete(unsigned* bar, unsigned x, unsigned& nloc, unsigned& nx) {
    const unsigned G = gridDim.x * gridDim.y * gridDim.z;
    unsigned sum, cnt, mine, sp = 0u;
    for (;;) {
        sum = 0u; cnt = 0u; mine = 0u;
#pragma unroll
        for (unsigned j = 0; j < 16; ++j) { const unsigned c = xb_ld(&bar[XB_XCNT(j)]); sum += c; cnt += (c > 0u) ? 1u : 0u; mine = (j == x) ? c : mine; }
        if (sum == G) break;
        __builtin_amdgcn_s_sleep(1);
        if ((++sp & 255u) == 0u) { if (xb_ld(&bar[XB_TMO])) break; if (sp > XB_SPIN_CAP) { atomicAdd(&bar[XB_TMO], 1u); break; } }
    }
    nloc = mine > 0u ? mine : 1u; nx = cnt > 0u ? cnt : 1u;
}
__device__ __forceinline__ void xcd_barrier(const XcdBarrier& b) {
    asm volatile("s_waitcnt vmcnt(0)" ::: "memory");
    __syncthreads();
    if (threadIdx.x == 0) {
        unsigned* bar = b.bar;
        __builtin_amdgcn_s_waitcnt(0);
        unsigned nloc = b.st[0], nx = b.st[1];
        if (nloc == 0u) { xcd_barrier_complete(bar, b.x, nloc, nx); b.st[0] = nloc; b.st[1] = nx; }
        const unsigned old = xb_add(&bar[XB_XSUB(b.x)], 1u);
        const unsigned gen = old / nloc;
        if (old + 1u == (gen + 1u) * nloc) {
            __builtin_amdgcn_fence(__ATOMIC_RELEASE, "agent");
            asm volatile("s_waitcnt vmcnt(0)" ::: "memory");
            const unsigned og = xb_add(&bar[XB_TOP], 1u);
            const unsigned tg = og / nx;
            if (og + 1u == (tg + 1u) * nx) xb_add(&bar[XB_TOPGEN], 1u);
            else XB_SPIN(xb_ld(&bar[XB_TOPGEN]) == tg, bar);
            __builtin_amdgcn_fence(__ATOMIC_ACQUIRE, "agent");
            xb_add(&bar[XB_XGEN(b.x)], 1u);
            asm volatile("s_waitcnt vmcnt(0)" ::: "memory");
        } else {
            XB_SPIN(xb_ld(&bar[XB_XGEN(b.x)]) == gen, bar);
            __builtin_amdgcn_fence(__ATOMIC_ACQUIRE, "agent");
            asm volatile("s_waitcnt vmcnt(0)" ::: "memory");
        }
    }
    __syncthreads();
}

__global__ void __launch_bounds__(NTHREADS, 2) mk_fwd(Args a_) {
    extern __shared__ __attribute__((aligned(16))) unsigned char lds_raw[];
    LAS unsigned char* lds = (LAS unsigned char*)lds_raw;
    const int G = gridDim.x, bx = blockIdx.x; const int vcu = (G % 8 == 0) ? (bx % 8) * (G / 8) + bx / 8 : bx;
    KArgP a = (KArgP)__builtin_amdgcn_kernarg_segment_ptr();
    const int lo = a->ph_lo, hi = a->ph_hi;
    volatile LAS unsigned* misc = (volatile LAS unsigned*)(lds + LDS_BYTES - 64);
    if (threadIdx.x < 16) misc[threadIdx.x] = 0u;
    __syncthreads();
    XcdBarrier xbar; xbar.bar = (unsigned*)a->ws + 1024; xbar.x = 0; xbar.st = misc;
#if ONE_LAUNCH
    xbar = xcd_barrier_post((unsigned*)a->ws + 1024, misc);
#endif
#define PHASE_ARGS() asm volatile("" : "+s"(a)); unsigned char* ws = a->ws; (void)ws
#ifndef REPEAT_MASK
#define REPEAT_MASK 0
#endif
#define REPS(k) ((((REPEAT_MASK) >> (k)) & 1) ? 2 : 1)
#ifndef PHASE_MASK
#define PHASE_MASK 0xFFF
#endif
#define IN(k) ((((PHASE_MASK) >> (k)) & 1) && lo <= (k) && (k) < hi)
#if ONE_LAUNCH
#ifndef SYNC_REPEAT
#define SYNC_REPEAT 1
#endif
#define SEAM(k) do { if (IN(k) && IN((k) + 1)) { for (int _r = 0; _r < SYNC_REPEAT; ++_r) { if ((k) == 0) cg::this_grid().sync(); else xcd_barrier(xbar); } } } while (0)
#else
#define SEAM(k) do { } while (0)
#endif
    for (int _rep = 0; _rep < REPS(0); ++_rep) if (IN(0)) { PHASE_ARGS(); p0_prep(a, lds, vcu, G); } SEAM(0);
    for (int _rep = 0; _rep < REPS(1); ++_rep) if (IN(1)) { PHASE_ARGS(); p1_hb(a, vcu, G); } SEAM(1);
    for (int _rep = 0; _rep < REPS(2); ++_rep) if (IN(2)) { PHASE_ARGS();
        Gemm g{(const bf16_t*)(ws + WS_S0), (const bf16_t*)(ws + WS_WIN), D, D, D}; DenseSched S; S.init(T / 256, INP / 256, G, bx, D, D, 0);
        EpiIn E{(bf16_t*)(ws + WS_S1), (bf16_t*)(ws + WS_QLAT), (bf16_t*)(ws + WS_KVLAT), (bf16_t*)(ws + WS_KPE), (bf16_t*)(ws + WS_GATES), (float*)(ws + WS_PSQQ), (float*)(ws + WS_PSQKV), a->in[I_BGATE], (const f32x2*)(ws + WS_CS)};
        gemm_phase(lds, g, S, E);
    } SEAM(2);
    for (int _rep = 0; _rep < REPS(3); ++_rep) if (IN(3)) { PHASE_ARGS();
        p3_mixed(a, vcu, G);
        { Gemm g{(const bf16_t*)(ws + WS_QLAT), (const bf16_t*)(ws + WS_WQ), QL, QL, QL}; DenseSched S; S.init(T / 256, 6, G, bx, QL, QL, 0);
            EpiQ E{(bf16_t*)(ws + WS_Q), (const float*)(ws + WS_PSQQ), (const f32x2*)(ws + WS_CS)}; gemm_phase(lds, g, S, E); }
        { Gemm g{(const bf16_t*)(ws + WS_KVLAT), (const bf16_t*)(ws + WS_WK), KVL, KVL, KVL}; DenseSched S; S.init(T / 256, 4, G, bx, KVL, KVL, 0);
            EpiK E{(bf16_t*)(ws + WS_KN), (const float*)(ws + WS_PSQKV)}; gemm_phase(lds, g, S, E); }
        { Gemm g{(const bf16_t*)(ws + WS_WV), (const bf16_t*)(ws + WS_KVLAT), KVL, KVL, KVL}; DenseSched S; S.init(4, T / 256, G, bx, KVL, KVL, 0);
            EpiVT E{(bf16_t*)(ws + WS_VT), (const float*)(ws + WS_PSQKV)}; gemm_phase(lds, g, S, E); }
    } SEAM(3);
    for (int _rep = 0; _rep < REPS(4); ++_rep) if (IN(4)) { PHASE_ARGS();
#if FAST_ATTN
        attn_fast(a, lds, vcu, G);
#else
        attn_naive(a, lds, vcu, G);
#endif
        { Gemm g{(const bf16_t*)(ws + WS_S0), (const bf16_t*)(ws + WS_WGRP), D, 256, 256}; DenseSched S; S.init(T / 256, 4, G, bx, D, 256, 512u);
            EpiPlain E{(bf16_t*)(ws + WS_S1), D}; gemm_phase(lds, g, S, E); }
    } SEAM(4);
    for (int _rep = 0; _rep < REPS(5); ++_rep) if (IN(5)) { PHASE_ARGS();
        DenseSched S; S.init(T / 256, 4, G, bx, D, D, 0);
        { Gemm g{(const bf16_t*)(ws + WS_S1), (const bf16_t*)(ws + WS_WPO), D, D, D}; EpiMerge<0> E{(bf16_t*)(ws + WS_S0), (const bf16_t*)(ws + WS_GATES)}; gemm_phase(lds, g, S, E); }
        { Gemm g{(const bf16_t*)(ws + WS_O), (const bf16_t*)(ws + WS_WMO), D, D, D}; EpiMerge<1> E{(bf16_t*)(ws + WS_S0), (const bf16_t*)(ws + WS_GATES)}; gemm_phase(lds, g, S, E); }
    } SEAM(5);
    for (int _rep = 0; _rep < REPS(6); ++_rep) if (IN(6)) { PHASE_ARGS();
        Gemm g{(const bf16_t*)(ws + WS_S0), (const bf16_t*)(ws + WS_WOUT), D, D, D}; DenseSched S; S.init(T / 256, 4, G, bx, D, D, 0);
        EpiOut E{a->in[I_X], a->out, (const float*)(ws + WS_MOD)}; gemm_phase(lds, g, S, E);
    } SEAM(6);
    for (int _rep = 0; _rep < REPS(7); ++_rep) if (IN(7)) { PHASE_ARGS(); p7_router(a, lds, vcu, G); } SEAM(7);
    for (int _rep = 0; _rep < REPS(8); ++_rep) if (IN(8)) { PHASE_ARGS(); p8_scatter(a, lds, vcu, G); } SEAM(8);
    for (int _rep = 0; _rep < REPS(9); ++_rep) if (IN(9)) { PHASE_ARGS();
        Gemm g{(const bf16_t*)(ws + WS_XS), (const bf16_t*)(ws + WS_WGU), D, D, D}; MoeSched S; S.init((const int*)(ws + WS_TILEE), 8, G, bx, D, D);
        EpiGU E{(bf16_t*)(ws + WS_ACT), a->in[I_BGU]}; gemm_phase(lds, g, S, E);
    } SEAM(9);
    for (int _rep = 0; _rep < REPS(10); ++_rep) if (IN(10)) { PHASE_ARGS();
        Gemm g{(const bf16_t*)(ws + WS_ACT), (const bf16_t*)(ws + WS_WDN), D, D, D}; MoeSched S; S.init((const int*)(ws + WS_TILEE), 4, G, bx, D, D);
        EpiDown E{(bf16_t*)(ws + WS_XS), a->in[I_BDN], (const float*)(ws + WS_ROWW)}; gemm_phase(lds, g, S, E);
    } SEAM(10);
    for (int _rep = 0; _rep < REPS(11); ++_rep) if (IN(11)) { PHASE_ARGS(); p11_final(a, vcu, G); }
#undef IN
#undef SEAM
}

constexpr int NPHASES = 12;
extern "C" void kernel_launch(void* const* d_in, const int* in_sizes, int n_in, void* d_out, int out_size, void* d_ws, size_t ws_size, hipStream_t stream) {
    static int grid = 0;
    if (grid == 0) {
        if (n_in != 27 || out_size != T * D || ws_size < WS_END) { fprintf(stderr, "kernel_launch: unexpected problem (n_in %d out %d ws %zu)\n", n_in, out_size, ws_size); grid = -1; return; }
        int dev = 0, cus = 0, per_cu = 0;
        hipGetDevice(&dev); hipDeviceGetAttribute(&cus, hipDeviceAttributeMultiprocessorCount, dev);
        hipFuncSetAttribute((const void*)mk_fwd, hipFuncAttributeMaxDynamicSharedMemorySize, LDS_BYTES);
        hipOccupancyMaxActiveBlocksPerMultiprocessor(&per_cu, (const void*)mk_fwd, NTHREADS, LDS_BYTES);
        (void)hipGetLastError();
        if (per_cu < 1) { fprintf(stderr, "kernel_launch: occupancy query says %d blocks per CU\n", per_cu); per_cu = 1; }
        grid = cus;
    }
    if (grid < 0) return;
    Args a{};
    for (int i = 0; i < 27; ++i) a.in[i] = (const float*)d_in[i];
    a.out = (float*)d_out; a.ws = (unsigned char*)d_ws;
#if ONE_LAUNCH
    if (hipMemsetAsync(d_ws, 0, 65536, stream) != hipSuccess) { fprintf(stderr, "kernel_launch: memset of the barrier words failed\n"); return; }
    a.ph_lo = 0; a.ph_hi = NPHASES;
    void* args[] = {&a};
    hipError_t e = hipLaunchCooperativeKernel((const void*)mk_fwd, dim3(grid), dim3(NTHREADS), args, LDS_BYTES, stream);
    if (e != hipSuccess) fprintf(stderr, "cooperative launch failed: %s (grid %d)\n", hipGetErrorString(e), grid);
#else
    for (int p = 0; p < NPHASES; ++p) { a.ph_lo = p; a.ph_hi = p + 1; hipLaunchKernelGGL(mk_fwd, dim3(grid), dim3(NTHREADS), LDS_BYTES, stream, a); }
#endif
}
```

```cpp
#include <hip/hip_runtime.h>
#include <hip/hip_cooperative_groups.h>
#include <cstdio>
#include <cstdint>
namespace cg = cooperative_groups;

#ifndef ONE_LAUNCH
#define ONE_LAUNCH 1
#endif
#ifndef FAST_GEMM
#define FAST_GEMM 1
#endif
#ifndef EPI_REPEAT
#define EPI_REPEAT 1
#endif
#ifndef P3REP
#define P3REP 0
#endif
#ifndef SKEW_MOE
#define SKEW_MOE 0
#endif

#define LAS __attribute__((address_space(3)))
typedef unsigned short bf16_t;
typedef short bf16x8 __attribute__((ext_vector_type(8)));
typedef float f32x4 __attribute__((ext_vector_type(4)));
typedef float f32x2 __attribute__((ext_vector_type(2)));
typedef unsigned u32x4 __attribute__((ext_vector_type(4)));
typedef unsigned u32x2 __attribute__((ext_vector_type(2)));
typedef __bf16 bf16x2_t __attribute__((ext_vector_type(2)));
typedef int v4i32 __attribute__((ext_vector_type(4)));
typedef int v8i32 __attribute__((ext_vector_type(8)));

constexpr int D = 1024, NB = 8, SEQ = 4096, T = NB * SEQ;
constexpr int QL = 768, KVL = 256, ROPE = 64, NH = 8, NOPE = 128, VH = 128, QKD = NOPE + ROPE;
constexpr int IN_W = 4160, INP = 4096;
constexpr int NE = 32, TOPK = 4, DE = 1024;
constexpr int NSLOT = T * TOPK;
constexpr int RT_MAX = 543;
constexpr float EPS = 1e-6f;
constexpr float W8SCALE = 64.0f;
constexpr float Q8SCALE = 16.0f;
constexpr int SCALE_Q8 = 0x7b7b7b7b;
constexpr float GUC = 1.702f * 1.4426950408889634f, GUCI = 1.0f / GUC;
constexpr float YSCALE = 16.0f;
constexpr int SCALE_ONE = 0x7f7f7f7f, SCALE_W8 = 0x79797979;
constexpr float QSCALE = 0.07216878364870322f * 1.4426950408889634f;

constexpr size_t MiB = 1u << 20;
constexpr size_t WS_MOD = 1 * MiB;
constexpr size_t WS_FMOD = 1 * MiB + 256 * 1024;
constexpr size_t WS_CS = 2 * MiB;
constexpr size_t WS_PSQQ = 10 * MiB;
constexpr size_t WS_PSQKV = 12 * MiB;
constexpr size_t WS_TKI = 13 * MiB;
constexpr size_t WS_TKW = 13 * MiB + 512 * 1024;
constexpr size_t WS_RANK = 14 * MiB;
constexpr size_t WS_SLOTROW = 14 * MiB + 512 * 1024;
constexpr size_t WS_COUNTS = 15 * MiB;
constexpr size_t WS_ROWW = 16 * MiB;
constexpr size_t WS_TILEE = 17 * MiB;
constexpr size_t WS_ROWTOK = 19 * MiB;
constexpr size_t WS_WIN8 = 22 * MiB;
constexpr size_t WS_HB8 = 864 * MiB;
constexpr size_t WS_X1B = 456 * MiB;
constexpr size_t WS_PSQX = 26 * MiB;
constexpr size_t WS_WKPE = 20 * MiB;
constexpr size_t WS_WR = 18 * MiB;
constexpr size_t WS_WIN = 32 * MiB;
constexpr size_t WS_WQ = 41 * MiB;
constexpr size_t WS_WK = 44 * MiB;
constexpr size_t WS_WV = 45 * MiB;
constexpr size_t WS_WGRP = 46 * MiB;
constexpr size_t WS_WPO = 47 * MiB;
constexpr size_t WS_WMO = 49 * MiB;
constexpr size_t WS_WOUT = 51 * MiB;
constexpr size_t WS_WGU = 54 * MiB;
constexpr size_t WS_WDN = 182 * MiB;
constexpr size_t WS_S0 = 256 * MiB;
constexpr size_t WS_S1 = 320 * MiB;
constexpr size_t WS_QLAT = 384 * MiB;
constexpr size_t WS_KVLAT = 432 * MiB;
constexpr size_t WS_KPE = 448 * MiB;
constexpr size_t WS_GATES = 452 * MiB;
constexpr size_t WS_Q = 580 * MiB;
constexpr size_t WS_KN = 676 * MiB;
constexpr size_t WS_VT = 740 * MiB;
constexpr size_t WS_O = 804 * MiB;
constexpr size_t WS_XS = 320 * MiB;
constexpr size_t WS_ACT = 592 * MiB;
constexpr size_t WS_END = 896 * MiB;

constexpr int LDS_BYTES = 148480;
constexpr int NTHREADS = 512;

__device__ __forceinline__ unsigned pk2(float lo, float hi) { f32x2 v = {lo, hi}; bf16x2_t b = __builtin_convertvector(v, bf16x2_t); return __builtin_bit_cast(unsigned, b); }
__device__ __forceinline__ float bflo(unsigned u) { return __uint_as_float(u << 16); }
__device__ __forceinline__ float bfhi(unsigned u) { return __uint_as_float(u & 0xffff0000u); }
__device__ __forceinline__ void unpack8(const u32x4 w, float (&f)[8]) { f[0] = bflo(w.x); f[1] = bfhi(w.x); f[2] = bflo(w.y); f[3] = bfhi(w.y); f[4] = bflo(w.z); f[5] = bfhi(w.z); f[6] = bflo(w.w); f[7] = bfhi(w.w); }
__device__ __forceinline__ u32x4 pack8(const float (&f)[8]) { u32x4 w; w.x = pk2(f[0], f[1]); w.y = pk2(f[2], f[3]); w.z = pk2(f[4], f[5]); w.w = pk2(f[6], f[7]); return w; }
__device__ __forceinline__ unsigned pk4_fp8(float a, float b, float c, float d) { int w = 0; w = __builtin_amdgcn_cvt_pk_fp8_f32(a, b, w, false); w = __builtin_amdgcn_cvt_pk_fp8_f32(c, d, w, true); return (unsigned)w; }
__device__ __forceinline__ float wave_sum(float v) {
#pragma unroll
    for (int o = 1; o < 64; o <<= 1) v += __shfl_xor(v, o);
    return v;
}
__device__ __forceinline__ int tid_fresh() { int t = threadIdx.x; asm volatile("" : "+v"(t)); return t; }
__device__ __forceinline__ float sigmoidf_(float x) { return __builtin_amdgcn_rcpf(1.0f + __builtin_amdgcn_exp2f(-1.4426950408889634f * x)); }

struct Args {
    const float* in[27]; float* out; unsigned char* ws; int ph_lo, ph_hi;
};
typedef const Args __attribute__((address_space(4)))* KArgP;
enum { I_X = 0, I_C, I_POS, I_WMOD, I_BMOD, I_GMIX, I_WIN, I_BGATE, I_WPG, I_PSCALE, I_WPO, I_GQA, I_WQB, I_GKVA, I_WKVB, I_WMO, I_WOUT, I_GFFN, I_WR, I_BR, I_WGU, I_BGU, I_WDN, I_BDN, I_GFIN, I_WFMOD, I_BFMOD };

struct Unit { int pm, pn, e; unsigned ao, bo; };
struct Gemm { const bf16_t* A; const bf16_t* Bt; int lda, ldb, K; const int* gather; int scaleA, scaleB; };
constexpr int NXCD = 8, WGM = 8;
__host__ __device__ __forceinline__ int perm32(int rho) { const int n = rho >> 4, i = rho & 15; return 8 * (i >> 2) + 4 * n + (i & 3); }

struct DenseSched {
    int nM, nN, nwg, G, c; unsigned a_tile, a_col, b_tile;
    __device__ void init(int nM_, int nN_, int G_, int c_, int lda, int ldb, unsigned a_col_, int eb = 2) { nM = nM_; nN = nN_; nwg = nM * nN; G = G_; c = c_; a_tile = 256u * lda * eb; b_tile = 256u * ldb * eb; a_col = a_col_; }
    __device__ bool next(int i, Unit& u) const {
        const long L = (long)i * G + c; if (L >= nwg) return false;
        int wgid = (int)L; { const int q = nwg / NXCD, r = nwg % NXCD, xcd = wgid % NXCD, off = wgid / NXCD; wgid = (xcd < r ? xcd * (q + 1) : r * (q + 1) + (xcd - r) * q) + off; }
        const int nig = WGM * nN, gid = wgid / nig, fm = gid * WGM, gsz = (nM - fm) < WGM ? (nM - fm) : WGM;
        u.pm = fm + ((wgid % nig) % gsz); u.pn = (wgid % nig) / gsz; u.e = 0;
        u.ao = (unsigned)u.pm * a_tile + (unsigned)u.pn * a_col; u.bo = (unsigned)u.pn * b_tile; return true;
    }
};
struct MoeSched {
    const LAS int* tile_e; int R, NT, G, c; unsigned a_tile, b_tile;
    __device__ void init(const LAS int* te, int NT_, int G_, int c_, int lda, int ldb, int eb) { tile_e = te; R = te[1023]; NT = NT_; G = G_; c = c_; a_tile = 256u * lda * eb; b_tile = 256u * ldb * eb; }
    __device__ bool next(int i, Unit& u) const {
        int rt, pn;
        if (G == 256) { const int x = c & 7, j = c >> 3, rpr = 256 / NT, pxc = rpr / 8; rt = i * rpr + x * pxc + j / NT; pn = j % NT; }
        else { const long L = (long)i * G + c; rt = (int)(L / NT); pn = (int)(L % NT); }
        if (rt >= R) return false;
        const int e = tile_e[rt];
        u.pm = rt; u.pn = pn; u.e = e; u.ao = (unsigned)rt * a_tile; u.bo = (unsigned)(e * NT + pn) * b_tile; return true;
    }
};
__device__ __forceinline__ const LAS int* moe_table_to_lds(const int* tile_e, LAS unsigned char* lds) {
    LAS int* t = (LAS int*)(lds + 131072 + 1024);
    for (int i = threadIdx.x; i < 1023; i += NTHREADS) t[i] = tile_e[i] & 31;
    if (threadIdx.x == 0) t[1023] = tile_e[1023];
    __syncthreads();
    return t;
}
struct DualSched {
    DenseSched B; unsigned a2, b2;
    __device__ bool next(int i, Unit& u) const { if (!B.next(i >> 1, u)) return false; if (i & 1) { u.ao += a2; u.bo += b2; u.e = 0; } else u.e = 1; return true; }
};
template <class Base> struct DupSched {
    Base B;
    __device__ bool next(int i, Unit& u) const { const bool r = B.next(i >> 1, u); if (!(i & 1)) u.e = -1; return r; }
};
struct NoPre {};
struct NoCtx {};
struct Ctx8 { float s[8]; };
__device__ __forceinline__ Ctx8 load8f(const float* p) { const f32x4 a = *(const f32x4*)p, b = *(const f32x4*)(p + 4); Ctx8 c; c.s[0] = a[0]; c.s[1] = a[1]; c.s[2] = a[2]; c.s[3] = a[3]; c.s[4] = b[0]; c.s[5] = b[1]; c.s[6] = b[2]; c.s[7] = b[3]; return c; }
__device__ __forceinline__ Ctx8 load8f_lds(const LAS float* p) { const f32x4 a = *(const LAS f32x4*)p, b = *(const LAS f32x4*)(p + 4); Ctx8 c; c.s[0] = a[0]; c.s[1] = a[1]; c.s[2] = a[2]; c.s[3] = a[3]; c.s[4] = b[0]; c.s[5] = b[1]; c.s[6] = b[2]; c.s[7] = b[3]; return c; }
template <class E, class = void> struct EpiPaired { static constexpr bool value = false; };
template <class E> struct EpiPaired<E, decltype((void)E::PAIRED)> { static constexpr bool value = E::PAIRED; };
template <class Epi, bool BI = false>
__device__ __forceinline__ void run_epi(const Epi& E, const f32x4 (&acc)[2][2][4][2], const Unit& u, int wr, int wc, int fr, int fq, const LAS float* bslot = nullptr) {
    const int col0 = wc * 32 + 8 * fq, rowb = u.pm * 256 + wr * 64 + fr;
    if constexpr (Epi::COLMAJOR) {
#pragma unroll
        for (int bj = 0; bj < 2; ++bj) {
            const int col = bj * 128 + col0;
            const typename Epi::ColCtx cc = E.col_ctx(u, col);
            asm volatile("" ::: "memory");
#pragma unroll
            for (int ai = 0; ai < 2; ++ai)
#pragma unroll
                for (int m = 0; m < 4; ++m) {
                    float v[8];
#pragma unroll
                    for (int j = 0; j < 4; ++j) { v[j] = acc[ai][bj][m][0][j]; v[4 + j] = acc[ai][bj][m][1][j]; }
                    E.template apply<false>(u, rowb + ai * 128 + m * 16, col, v, 0.f, cc, NoPre{});
                }
            asm volatile("" ::: "memory");
        }
    } else {
        typename Epi::ColCtx cc[2];
        if constexpr (BI) { cc[0] = typename Epi::ColCtx{}; cc[1] = typename Epi::ColCtx{}; }
        else if constexpr (Epi::LDSBIAS) { if (bslot) { cc[0] = load8f_lds(bslot + col0); cc[1] = load8f_lds(bslot + 128 + col0); } else { cc[0] = E.col_ctx(u, col0); cc[1] = E.col_ctx(u, 128 + col0); } }
        else { cc[0] = E.col_ctx(u, col0); cc[1] = E.col_ctx(u, 128 + col0); }
        const bool wp = Epi::SUMSQ && E.want_partial(u);
        constexpr int DP = Epi::PRE_DEPTH, NS = DP + 1;
        typename Epi::RowPre rp[NS]; typename Epi::Pre pp[NS][2];
#define EPI_ROW(r_) (rowb + ((r_) >> 2) * 128 + ((r_) & 3) * 16)
#pragma unroll
        for (int r = 0; r < DP; ++r) { rp[r] = E.row_pre(u, EPI_ROW(r)); pp[r][0] = E.pre(u, EPI_ROW(r), col0); pp[r][1] = E.pre(u, EPI_ROW(r), 128 + col0); }
        asm volatile("" ::: "memory");
#pragma unroll
        for (int r = 0; r < 8; ++r) {
            const int ai = r >> 2, m = r & 3, row = EPI_ROW(r);
            if (r + DP < 8) { const int rn = EPI_ROW(r + DP);
                rp[(r + DP) % NS] = E.row_pre(u, rn); pp[(r + DP) % NS][0] = E.pre(u, rn, col0); pp[(r + DP) % NS][1] = E.pre(u, rn, 128 + col0); }
            asm volatile("" ::: "memory");
            const float rc = E.row_ctx(rp[r % NS]); float part = 0.f;
            if constexpr (EpiPaired<Epi>::value) {
                float v0[8], v1[8];
#pragma unroll
                for (int j = 0; j < 4; ++j) { v0[j] = acc[ai][0][m][0][j]; v0[4 + j] = acc[ai][0][m][1][j]; v1[j] = acc[ai][1][m][0][j]; v1[4 + j] = acc[ai][1][m][1][j]; }
                E.apply2(u, row, col0, v0, v1, rc);
            } else
#pragma unroll
            for (int bj = 0; bj < 2; ++bj) {
                float v[8];
#pragma unroll
                for (int j = 0; j < 4; ++j) { v[j] = acc[ai][bj][m][0][j]; v[4 + j] = acc[ai][bj][m][1][j]; }
                part += E.template apply<BI>(u, row, bj * 128 + col0, v, rc, cc[bj], pp[r % NS][bj]);
            }
            if constexpr (Epi::SUMSQ) { if (wp) { float sq = part; sq += __shfl_xor(sq, 16); sq += __shfl_xor(sq, 32); if (fq == 0) E.partial(u, row, wc, sq); } }
            asm volatile("" ::: "memory");
        }
#undef EPI_ROW
    }
}

template <class Epi>
__device__ __forceinline__ void run_mid(const Epi& E, f32x4 (&acc)[2][2][4][2], const Unit& u, int wr, int wc, int fr, int fq) {
    const int col0 = wc * 32 + 8 * fq, rowb = u.pm * 256 + wr * 64 + fr;
    u32x4 ga[3][2], gb[3][2];
#define EPI_ROW(r_) (rowb + ((r_) >> 2) * 128 + ((r_) & 3) * 16)
#pragma unroll
    for (int r = 0; r < 2; ++r)
#pragma unroll
        for (int bj = 0; bj < 2; ++bj) E.load_gates(u, EPI_ROW(r), bj * 128 + col0, ga[r][bj], gb[r][bj]);
    asm volatile("" ::: "memory");
#pragma unroll
    for (int r = 0; r < 8; ++r) {
        const int ai = r >> 2, m = r & 3;
        if (r + 2 < 8) {
#pragma unroll
            for (int bj = 0; bj < 2; ++bj) E.load_gates(u, EPI_ROW(r + 2), bj * 128 + col0, ga[(r + 2) % 3][bj], gb[(r + 2) % 3][bj]); }
        asm volatile("" ::: "memory");
#pragma unroll
        for (int bj = 0; bj < 2; ++bj) { float g0[8], g1[8]; unpack8(ga[r % 3][bj], g0); unpack8(gb[r % 3][bj], g1);
#pragma unroll
            for (int j = 0; j < 4; ++j) { acc[ai][bj][m][0][j] *= g0[j] * __builtin_amdgcn_rcpf(fmaxf(g1[j], 1e-30f)); acc[ai][bj][m][1][j] *= g0[4 + j] * __builtin_amdgcn_rcpf(fmaxf(g1[4 + j], 1e-30f)); } }
        asm volatile("" ::: "memory");
    }
#undef EPI_ROW
}

template <class Epi, class Sched>
__device__ __forceinline__ void gemm_simple(LAS unsigned char* lds, const Gemm g, const Sched& S, const Epi& E) {
    const int tid = tid_fresh(), wid = __builtin_amdgcn_readfirstlane(tid >> 6), lane = tid & 63, wr = wid >> 2, wc = wid & 3, fr = lane & 15, fq = lane >> 4;
    const int nt = g.K / 64;
    Unit u;
    for (int ui = 0; S.next(ui, u); ++ui) {
        f32x4 acc[2][2][4][2];
#pragma unroll
        for (int a = 0; a < 2; ++a)
#pragma unroll
            for (int b = 0; b < 2; ++b)
#pragma unroll
                for (int m = 0; m < 4; ++m)
#pragma unroll
                    for (int n = 0; n < 2; ++n) acc[a][b][m][n] = (f32x4){0.f, 0.f, 0.f, 0.f};
        const char* cA = (const char*)g.A + u.ao; const char* cB = (const char*)g.Bt + u.bo;
#pragma unroll 1
        for (int kt = 0; kt < nt; ++kt) {
            __syncthreads();
#pragma unroll
            for (int i = 0; i < 4; ++i) { const int c = tid + 512 * i, row = c >> 3, kc = c & 7, rb = (row & ~31) + perm32(row & 31);
                const u32x4 va = g.gather ? *(const u32x4*)((const char*)g.A + (size_t)g.gather[u.pm * 256 + row] * g.lda * 2 + kt * 128 + kc * 16)
                                          : *(const u32x4*)(cA + (size_t)row * g.lda * 2 + kt * 128 + kc * 16);
                const u32x4 vb = *(const u32x4*)(cB + (size_t)rb * g.ldb * 2 + kt * 128 + kc * 16);
                *(LAS u32x4*)(lds + row * 144 + kc * 16) = va; *(LAS u32x4*)(lds + 36864 + row * 144 + kc * 16) = vb; }
            __syncthreads();
#pragma unroll
            for (int k = 0; k < 2; ++k) {
                bf16x8 Af[2][4], Bf[2][2];
#pragma unroll
                for (int ai = 0; ai < 2; ++ai)
#pragma unroll
                    for (int m = 0; m < 4; ++m) Af[ai][m] = *(const LAS bf16x8*)(lds + (ai * 128 + wr * 64 + m * 16 + fr) * 144 + (k * 32 + fq * 8) * 2);
#pragma unroll
                for (int bj = 0; bj < 2; ++bj)
#pragma unroll
                    for (int n = 0; n < 2; ++n) Bf[bj][n] = *(const LAS bf16x8*)(lds + 36864 + (bj * 128 + wc * 32 + n * 16 + fr) * 144 + (k * 32 + fq * 8) * 2);
#pragma unroll
                for (int ai = 0; ai < 2; ++ai)
#pragma unroll
                    for (int bj = 0; bj < 2; ++bj)
#pragma unroll
                        for (int m = 0; m < 4; ++m)
#pragma unroll
                            for (int n = 0; n < 2; ++n) acc[ai][bj][m][n] = __builtin_amdgcn_mfma_f32_16x16x32_bf16(Bf[bj][n], Af[ai][m], acc[ai][bj][m][n], 0, 0, 0);
            }
        }
        run_epi(E, acc, u, wr, wc, fr, fq);
    }
    __syncthreads();
}

template <class E, class = void> struct EpiNStore { static constexpr int value = 0; };
template <class E> struct EpiNStore<E, decltype((void)E::NSTORE)> { static constexpr int value = E::NSTORE; };
template <class E, class = void> struct EpiDefer { static constexpr bool value = false; };
template <class E> struct EpiDefer<E, decltype((void)E::DEFER)> { static constexpr bool value = E::DEFER; };
namespace pg8 {
template <int N> __device__ __forceinline__ void wait_vm() { asm volatile("s_waitcnt vmcnt(%0)" :: "n"(N) : "memory"); }
constexpr int BK = 64, HALF = 128, HTB = HALF * BK * 2  , STAGE_BYTES = 8 * HTB;
__device__ __forceinline__ int lds_byte(int r, int c) { const int st = (r >> 4) * 2 + (c >> 5), rr = r & 15, cc = c & 31, ob = rr * 64 + cc * 2; return st * 1024 + (ob ^ (((ob >> 9) & 1) << 5)); }
__device__ __forceinline__ void stage_rc(int b, int& R, int& C) { const int st = b / 1024, sb = b % 1024, swz = sb ^ (((sb >> 9) & 1) << 5); R = (st >> 1) * 16 + swz / 64; C = (st & 1) * 32 + (swz % 64) / 2; }

template <class Epi, class Sched, bool GATHER, bool FP8>
__device__ __forceinline__ void gemm_fast(LAS unsigned char* lds, const Gemm g, const Sched& S, const Epi& E, int skew_ticks) {
    const int tid = tid_fresh(), wid = __builtin_amdgcn_readfirstlane(tid >> 6), lane = tid & 63, wr = wid >> 2, wc = wid & 3, fr = lane & 15, fq = lane >> 4;
    constexpr int EB = FP8 ? 1 : 2;
    const int nt = g.K * EB / 128;
    unsigned voffA[2], voffB[2];
#pragma unroll
    for (int i = 0; i < 2; ++i) { int R, C; stage_rc(tid * 16 + i * 8192, R, C); const int Rb = (R & ~31) + perm32(R & 31);
        voffA[i] = (unsigned)(R * g.lda * EB + C * 2); voffB[i] = (unsigned)(Rb * g.ldb * EB + C * 2); }
    const size_t kstep = (size_t)(BK * 2);
    const size_t hstepA = GATHER ? (size_t)0 : (size_t)HALF * g.lda * EB, hstepB = (size_t)HALF * g.ldb * EB;
    unsigned cV0[2], cV1[2], nV0[2], nV1[2];
#define PG8_GATHER(pm_, V0, V1) do { _Pragma("unroll") for (int _i = 0; _i < 2; ++_i) { int R_, C_; stage_rc(tid * 16 + _i * 8192, R_, C_); \
        V0[_i] = (unsigned)(g.gather[(pm_) * 256 + R_] * g.lda * EB + C_ * 2); V1[_i] = (unsigned)(g.gather[(pm_) * 256 + 128 + R_] * g.lda * EB + C_ * 2); } } while (0)
    const unsigned ldsw = (unsigned)wid * 1024u;
    const int aoff = lds_byte(wr * 64 + fr, fq * 8), boff = lds_byte(wc * 32 + fr, fq * 8);
#define PG8_SA(b, h) (((b) * 2 + (h)) * HTB)
#define PG8_SB(b, h) ((4 + (b) * 2 + (h)) * HTB)
#define PG8_STAGE(bufoff, gbase, voff) do { _Pragma("unroll") for (int _i = 0; _i < 2; ++_i) \
        __builtin_amdgcn_global_load_lds((const unsigned*)((const char*)(gbase) + (voff)[_i]), (LAS unsigned*)(lds + (bufoff) + ldsw + _i * 8192), 16, 0, 0); } while (0)
#define PG8_LD8(p) __builtin_shufflevector(*(const LAS v4i32*)(p), *(const LAS v4i32*)((p) + 1024), 0, 1, 2, 3, 4, 5, 6, 7)
#define PG8_LDA(dst, b, h) do { _Pragma("unroll") for (int m = 0; m < 4; ++m) dst[m] = PG8_LD8(lds + PG8_SA(b, h) + aoff + m * 2048); } while (0)
#define PG8_LDB(dst, b, h) do { _Pragma("unroll") for (int n = 0; n < 2; ++n) dst[n] = PG8_LD8(lds + PG8_SB(b, h) + boff + n * 2048); } while (0)
#define PG8_HALF0(v) __builtin_bit_cast(bf16x8, __builtin_shufflevector(v, v, 0, 1, 2, 3))
#define PG8_HALF1(v) __builtin_bit_cast(bf16x8, __builtin_shufflevector(v, v, 4, 5, 6, 7))
#define PG8_MMA(ai, bj, At, Bt) do { __builtin_amdgcn_s_setprio(1); \
        if constexpr (FP8) { _Pragma("unroll") for (int m = 0; m < 4; ++m) _Pragma("unroll") for (int n = 0; n < 2; ++n) \
            asm volatile("v_mfma_scale_f32_16x16x128_f8f6f4 %0, %1, %2, %0, %3, %4 op_sel_hi:[0,0,0]" : "+v"(acc[ai][bj][m][n]) : "v"(Bt[n]), "v"(At[m]), "v"(sclW), "v"(sclX)); } \
        else { _Pragma("unroll") for (int m = 0; m < 4; ++m) _Pragma("unroll") for (int n = 0; n < 2; ++n) { \
            acc[ai][bj][m][n] = __builtin_amdgcn_mfma_f32_16x16x32_bf16(PG8_HALF0(Bt[n]), PG8_HALF0(At[m]), acc[ai][bj][m][n], 0, 0, 0); \
            acc[ai][bj][m][n] = __builtin_amdgcn_mfma_f32_16x16x32_bf16(PG8_HALF1(Bt[n]), PG8_HALF1(At[m]), acc[ai][bj][m][n], 0, 0, 0); } } \
        __builtin_amdgcn_s_setprio(0); } while (0)
#define PG8_WAIT_V(n) asm volatile("s_waitcnt vmcnt(" #n ")" ::: "memory")
#define PG8_WAIT_L(n) asm volatile("s_waitcnt lgkmcnt(" #n ")" ::: "memory")
#define PG8_BAR __builtin_amdgcn_s_barrier()
#define PG8_SCHED __builtin_amdgcn_sched_barrier(0)
    Unit cur, nxt; int ui = 0;
    constexpr int NSTR = EpiNStore<Epi>::value; bool stored_prev = false, pre11 = false;
    constexpr bool DEFER = EpiDefer<Epi>::value;
    u32x2 pend[4]; int ppm = 0, ppn = 0; bool hp = false, stlast = false;
#pragma unroll
    for (int i_ = 0; i_ < 4; ++i_) pend[i_] = (u32x2){0u, 0u};
    if (!S.next(0, cur)) return;
    if (skew_ticks > 0) {
        const unsigned long long t0 = __builtin_amdgcn_s_memrealtime(); const unsigned long long d = (unsigned long long)(((blockIdx.x * 167u + 13u) & 255u) * (unsigned)skew_ticks) >> 8;
        while (__builtin_amdgcn_s_memrealtime() - t0 < d) __builtin_amdgcn_s_sleep(8);
    }
    f32x4 acc[2][2][4][2];
#define PG8_INIT(un, slot_) do { const LAS float* bs0_ = nullptr; if constexpr (Epi::BIASINIT) { if (E.bias_ptr(un) != nullptr) bs0_ = (const LAS float*)(lds + 131072 + 8192 + (slot_) * 1024) + wc * 32 + 8 * fq; } \
        _Pragma("unroll") for (int b = 0; b < 2; ++b) { f32x4 lo_ = (f32x4){0.f, 0.f, 0.f, 0.f}, hi_ = lo_; \
            if constexpr (Epi::BIASINIT) { if (bs0_) { lo_ = *(const LAS f32x4*)(bs0_ + b * 128); hi_ = *(const LAS f32x4*)(bs0_ + b * 128 + 4); } } \
            _Pragma("unroll") for (int n = 0; n < 2; ++n) { f32x4 iv = (f32x4){0.f, 0.f, 0.f, 0.f}; if constexpr (Epi::BIASINIT) { if (bs0_) iv = E.init_vec(lo_, hi_, n); } \
                _Pragma("unroll") for (int a = 0; a < 2; ++a) _Pragma("unroll") for (int m = 0; m < 4; ++m) acc[a][b][m][n] = iv; } } } while (0)
    v8i32 At[4], B0[2], B1[2];
    const int sclW = g.scaleB, sclX = g.scaleA;
    const char* cA = (const char*)g.A + (GATHER ? 0u : cur.ao); const char* cB = (const char*)g.Bt + cur.bo;
#define PG8_BIAS(un, ui_) do { if constexpr (Epi::LDSBIAS) { const float* bp_ = E.bias_ptr(un); if (bp_ != nullptr && wid == 0) \
        __builtin_amdgcn_global_load_lds((const unsigned*)(bp_ + lane * 4), (LAS unsigned*)(lds + 131072 + 8192 + (ui_) * 1024), 16, 0, 0); } } while (0)
    int bsl = 0;
    PG8_BIAS(cur, 0);
    if constexpr (GATHER) { PG8_GATHER(cur.pm, cV0, cV1); } else { cV0[0] = cV1[0] = voffA[0]; cV0[1] = cV1[1] = voffA[1]; }
    nV0[0] = cV0[0]; nV0[1] = cV0[1]; nV1[0] = cV1[0]; nV1[1] = cV1[1];
    PG8_STAGE(PG8_SB(0, 0), cB, voffB); PG8_STAGE(PG8_SB(0, 1), cB + hstepB, voffB); PG8_STAGE(PG8_SA(0, 0), cA, cV0); PG8_STAGE(PG8_SA(0, 1), cA + hstepA, cV1);
    if (wr == 1) PG8_BAR;
    PG8_WAIT_V(2); PG8_BAR;
    PG8_STAGE(PG8_SB(1, 0), cB + kstep, voffB); PG8_STAGE(PG8_SA(1, 0), cA + kstep, cV0); PG8_STAGE(PG8_SB(1, 1), cB + hstepB + kstep, voffB);
    PG8_WAIT_V(6); PG8_BAR;
    PG8_INIT(cur, 0);
    for (;;) {
        const bool has_next = S.next(ui + 1, nxt);
        const int bsn = (bsl == 2) ? 0 : bsl + 1;
        if (has_next) PG8_BIAS(nxt, bsn);
        const char* nA = (has_next && !GATHER) ? (const char*)g.A + nxt.ao : cA; const char* nB = has_next ? (const char*)g.Bt + nxt.bo : cB;
        if constexpr (GATHER) { if (has_next) PG8_GATHER(nxt.pm, nV0, nV1); }
#pragma unroll 1
        for (int t = 0; t < nt; t += 2) {
            const bool last = (t == nt - 2);
            const char* a1 = cA + (size_t)(t + 1) * kstep;
            const char* a2 = last ? nA : cA + (size_t)(t + 2) * kstep; const char* b2 = last ? nB : cB + (size_t)(t + 2) * kstep;
            const char* a3 = a2 + kstep; const char* b3 = b2 + kstep;
            unsigned sV0[2], sV1[2];
            sV0[0] = last ? nV0[0] : cV0[0]; sV0[1] = last ? nV0[1] : cV0[1]; sV1[0] = last ? nV1[0] : cV1[0]; sV1[1] = last ? nV1[1] : cV1[1];
            const bool rlx = NSTR > 0 && t == 0 && stored_prev;
            const bool stl = DEFER && t == 2 && stlast; const bool sts = DEFER && hp && t < 2;
            if constexpr (DEFER) { if (sts) E.store_row(ppm, ppn, 4 + 0, wr, wc, fr, fq, pend[0]); }
            PG8_LDB(B0, 0, 0); PG8_LDB(B1, 0, 1); PG8_SCHED; PG8_LDA(At, 0, 0); if (!(pre11 && t == 0)) PG8_STAGE(PG8_SA(1, 1), a1 + hstepA, cV1);
            if (sts || stl) wait_vm<9>(); else if (rlx) wait_vm<8 + NSTR>(); else PG8_WAIT_V(8);
            PG8_WAIT_L(0); PG8_BAR; PG8_MMA(0, 0, At, B0); PG8_MMA(0, 1, At, B1); PG8_BAR; PG8_SCHED;
            if constexpr (DEFER) { if (sts) E.store_row(ppm, ppn, 4 + 1, wr, wc, fr, fq, pend[1]); }
            PG8_LDA(At, 0, 1); PG8_STAGE(PG8_SB(0, 0), b2, voffB); PG8_STAGE(PG8_SB(0, 1), b2 + hstepB, voffB); PG8_STAGE(PG8_SA(0, 0), a2, sV0);
            if (sts) wait_vm<10>(); else if (rlx) wait_vm<8 + NSTR>(); else PG8_WAIT_V(8);
            PG8_WAIT_L(0); PG8_BAR; PG8_MMA(1, 0, At, B0); PG8_MMA(1, 1, At, B1); PG8_BAR; PG8_SCHED;
            if constexpr (DEFER) { if (sts) E.store_row(ppm, ppn, 4 + 2, wr, wc, fr, fq, pend[2]); }
            PG8_LDB(B0, 1, 0); PG8_LDB(B1, 1, 1); PG8_SCHED; PG8_LDA(At, 1, 0); PG8_STAGE(PG8_SA(0, 1), a2 + hstepA, sV1);
            if (sts) wait_vm<10>(); else if (rlx && pre11) wait_vm<8 + NSTR>(); else PG8_WAIT_V(8);
            PG8_WAIT_L(0); PG8_BAR; PG8_MMA(0, 0, At, B0); PG8_MMA(0, 1, At, B1); PG8_BAR; PG8_SCHED;
            if constexpr (DEFER) { if (sts) E.store_row(ppm, ppn, 4 + 3, wr, wc, fr, fq, pend[3]); }
            PG8_LDA(At, 1, 1); PG8_STAGE(PG8_SB(1, 0), b3, voffB); PG8_STAGE(PG8_SB(1, 1), b3 + hstepB, voffB); PG8_STAGE(PG8_SA(1, 0), a3, sV0);
            if (sts) wait_vm<10>(); else PG8_WAIT_V(8);
            PG8_WAIT_L(0); PG8_BAR; PG8_MMA(1, 0, At, B0); PG8_MMA(1, 1, At, B1); PG8_BAR; PG8_SCHED;
            if constexpr (DEFER) { stlast = sts; if (sts) hp = false; }
        }
        if (wr == 0) PG8_BAR;
        const bool pre11n = has_next;
        if (has_next) PG8_STAGE(PG8_SA(1, 1), nA + kstep + hstepA, nV1);
        if constexpr (FP8) asm volatile("s_nop 15\n\ts_nop 15" ::: "memory");
        stored_prev = Epi::DUAL ? cur.e != 1 : cur.e >= 0;
        if constexpr (Epi::DUAL) { if (cur.e == 1) run_mid(E, acc, cur, wr, wc, fr, fq); else run_epi<Epi, false>(E, acc, cur, wr, wc, fr, fq); }
        else if (DEFER && cur.e >= 0) { if constexpr (DEFER) { E.compute(acc, pend, cur.pm, cur.pn, wr, wc, fr, fq); ppm = cur.pm; ppn = cur.pn; hp = true; } }
        else if (cur.e >= 0) { const LAS float* bs_ = nullptr; if constexpr (Epi::LDSBIAS) { if (E.bias_ptr(cur) != nullptr) bs_ = (const LAS float*)(lds + 131072 + 8192 + bsl * 1024); }
            run_epi<Epi, Epi::BIASINIT>(E, acc, cur, wr, wc, fr, fq, bs_); }
        if (!has_next) break;
        { const bool keep_ = Epi::DUAL && cur.e == 1;
            cur = nxt; cA = nA; cB = nB; ++ui; bsl = bsn; pre11 = pre11n;
            if (!keep_) PG8_INIT(cur, bsl); }
        cV0[0] = nV0[0]; cV0[1] = nV0[1]; cV1[0] = nV1[0]; cV1[1] = nV1[1];
        if (wr == 1) PG8_BAR;
    }
    if constexpr (DEFER) { if (hp) {
#pragma unroll
        for (int r_ = 0; r_ < 4; ++r_) E.store_row(ppm, ppn, 4 + r_, wr, wc, fr, fq, pend[r_]); } }
    PG8_WAIT_V(0);
    PG8_BAR;
#undef PG8_GATHER
#undef PG8_BIAS
#undef PG8_INIT
#undef PG8_SA
#undef PG8_SB
#undef PG8_STAGE
#undef PG8_LD8
#undef PG8_HALF0
#undef PG8_HALF1
#undef PG8_LDA
#undef PG8_LDB
#undef PG8_MMA
#undef PG8_WAIT_V
#undef PG8_WAIT_L
#undef PG8_BAR
#undef PG8_SCHED
}
}

template <class Epi, class Sched, bool GATHER = false, bool FP8 = false>
__device__ __forceinline__ void gemm_phase(LAS unsigned char* lds, const Gemm g, const Sched& S, const Epi& E, int skew_ticks = 0) {
#if FAST_GEMM
    pg8::gemm_fast<Epi, Sched, GATHER, FP8>(lds, g, S, E, skew_ticks);
#else
    gemm_simple<Epi, Sched>(lds, g, S, E);
#endif
}

#define EPI_DEFAULTS_NOROW typedef NoPre RowPre; __device__ __forceinline__ NoPre row_pre(const Unit&, int) const { return NoPre{}; } __device__ __forceinline__ float row_ctx(const NoPre&) const { return 0.f; }
#define EPI_DEFAULTS_NOPRE typedef NoPre Pre; __device__ __forceinline__ NoPre pre(const Unit&, int, int) const { return NoPre{}; }
#define EPI_INITVEC_PLAIN __device__ __forceinline__ f32x4 init_vec(f32x4 lo, f32x4 hi, int n) const { return n ? hi : lo; }
#define EPI_NOBIAS static constexpr bool LDSBIAS = false, BIASINIT = false; EPI_INITVEC_PLAIN __device__ __forceinline__ const float* bias_ptr(const Unit&) const { return nullptr; }
#define EPI_DEFAULTS_NOPART static constexpr bool DUAL = false; __device__ __forceinline__ bool want_partial(const Unit&) const { return false; } __device__ __forceinline__ void partial(const Unit&, int, int, float) const {}
struct EpiIn {
    static constexpr int NSTORE = 16;
    static constexpr int PRE_DEPTH = 1; static constexpr bool SUMSQ = true, COLMAJOR = false, LDSBIAS = true, BIASINIT = true; typedef Ctx8 ColCtx; EPI_DEFAULTS_NOROW EPI_DEFAULTS_NOPRE
    EPI_INITVEC_PLAIN
    __device__ __forceinline__ int ltile(const Unit& u) const { return u.pn; }
    __device__ __forceinline__ const float* bias_ptr(const Unit& u) const { return u.pn >= 8 ? bgate + (u.pn - 8) * 256 : nullptr; }
    static constexpr bool DUAL = false;
    bf16_t *U, *QLp, *KVLp, *KPE, *GATES; float *PSQQ, *PSQKV; const float* bgate; const f32x2* CS; int pn0;
    __device__ __forceinline__ Ctx8 col_ctx(const Unit& u, int col) const { if (u.pn >= 8) return load8f(bgate + (u.pn - 8) * 256 + col); Ctx8 c;
#pragma unroll
        for (int j = 0; j < 8; ++j) c.s[j] = 0.f;
        return c; }
    __device__ __forceinline__ bool want_partial(const Unit& u) const { return u.pn >= 4 && u.pn < 8; }
    __device__ __forceinline__ void partial(const Unit& u, int row, int wc, float s) const {
        if (u.pn < 7) PSQQ[(size_t)row * 12 + (u.pn - 4) * 4 + wc] = s; else PSQKV[(size_t)row * 4 + wc] = s; }
    template <bool BI> __device__ __forceinline__ float apply(const Unit& u, int row, int col, float (&v)[8], float, const Ctx8& cc, NoPre) const {
        const int pn = ltile(u);
        if (pn < 4) { *(u32x4*)(U + (size_t)row * D + pn * 256 + col) = pack8(v); return 0.f; }
        if (pn < 8) {
            float s = 0.f;
#pragma unroll
            for (int j = 0; j < 8; ++j) s += v[j] * v[j];
            if (pn < 7) { u32x2 w; w.x = pk4_fp8(v[0], v[1], v[2], v[3]); w.y = pk4_fp8(v[4], v[5], v[6], v[7]); *(u32x2*)((unsigned char*)QLp + (size_t)row * QL + (pn - 4) * 256 + col) = w; }
            else { u32x2 w; w.x = pk4_fp8(v[0], v[1], v[2], v[3]); w.y = pk4_fp8(v[4], v[5], v[6], v[7]); *(u32x2*)((unsigned char*)KVLp + (size_t)row * KVL + col) = w; }
            return s;
        }
        {
            float o[8];
#pragma unroll
            for (int j = 0; j < 8; ++j) o[j] = sigmoidf_(BI ? v[j] : v[j] + cc.s[j]);
            *(u32x4*)(GATES + (size_t)row * 2048 + (pn - 8) * 256 + col) = pack8(o);
        }
        return 0.f;
    }
};
struct Pre12 { f32x4 a, b, c; };
struct EpiQ {
    static constexpr int NSTORE = 16;
    static constexpr int PRE_DEPTH = 2; static constexpr bool SUMSQ = false, COLMAJOR = false; typedef NoCtx ColCtx; typedef Pre12 RowPre; typedef Ctx8 Pre; EPI_DEFAULTS_NOPART EPI_NOBIAS
    bf16_t* Q; const float* PSQQ; const f32x2* CS;
    __device__ __forceinline__ Pre12 row_pre(const Unit&, int row) const { const f32x4* p = (const f32x4*)(PSQQ + (size_t)row * 12); Pre12 r; r.a = p[0]; r.b = p[1]; r.c = p[2]; return r; }
    __device__ __forceinline__ float row_ctx(const Pre12& r) const {
        const float s = ((r.a[0] + r.a[1]) + (r.a[2] + r.a[3])) + ((r.b[0] + r.b[1]) + (r.b[2] + r.b[3])) + ((r.c[0] + r.c[1]) + (r.c[2] + r.c[3]));
        return rsqrtf(s * (1.0f / QL) + EPS) * (QSCALE * Q8SCALE); }
    __device__ __forceinline__ NoCtx col_ctx(const Unit&, int) const { return NoCtx{}; }
    __device__ __forceinline__ Ctx8 pre(const Unit& u, int row, int col) const {
        if (u.pn >= 4) { const int g = (((u.pn - 4) * 256 + col) & 63) >> 3; return load8f((const float*)(CS + (size_t)row * 32 + 4 * g)); }
        Ctx8 c;
#pragma unroll
        for (int j = 0; j < 8; ++j) c.s[j] = 0.f;
        return c; }
    template <bool BI> __device__ __forceinline__ float apply(const Unit& u, int row, int col, float (&v)[8], float rs, NoCtx, const Ctx8& cs) const {
#pragma unroll
        for (int j = 0; j < 8; ++j) v[j] *= rs;
        unsigned char* Q8 = (unsigned char*)Q + (size_t)row * (NH * QKD);
        if (u.pn < 4) { const int p = u.pn * 256 + col, hh = p >> 7, d = p & 127; u32x2 w; w.x = pk4_fp8(v[0], v[1], v[2], v[3]); w.y = pk4_fp8(v[4], v[5], v[6], v[7]); *(u32x2*)(Q8 + hh * QKD + d) = w; }
        else { const int r = (u.pn - 4) * 256 + col, hh = r >> 6, g = (r & 63) >> 3; float y1[4], y2[4];
#pragma unroll
            for (int i = 0; i < 4; ++i) { const float c = cs.s[2 * i], sn = cs.s[2 * i + 1]; y1[i] = v[i] * c - v[4 + i] * sn; y2[i] = v[4 + i] * c + v[i] * sn; }
            unsigned char* q = Q8 + hh * QKD + NOPE; *(unsigned*)(q + 4 * g) = pk4_fp8(y1[0], y1[1], y1[2], y1[3]); *(unsigned*)(q + 32 + 4 * g) = pk4_fp8(y2[0], y2[1], y2[2], y2[3]); }
        return 0.f;
    }
};
__device__ __forceinline__ float rstd_kv4(const f32x4 a) { return rsqrtf(((a[0] + a[1]) + (a[2] + a[3])) * (1.0f / KVL) + EPS); }
struct Pre4 { f32x4 a; };
struct EpiK {
    static constexpr int NSTORE = 16;
    static constexpr int PRE_DEPTH = 4; static constexpr bool SUMSQ = false, COLMAJOR = false; typedef NoCtx ColCtx; typedef Pre4 RowPre; EPI_DEFAULTS_NOPRE EPI_DEFAULTS_NOPART EPI_NOBIAS
    bf16_t* KN; const float* PSQKV;
    __device__ __forceinline__ Pre4 row_pre(const Unit&, int row) const { Pre4 r; r.a = *(const f32x4*)(PSQKV + (size_t)row * 4); return r; }
    __device__ __forceinline__ float row_ctx(const Pre4& r) const { return rstd_kv4(r.a); }
    __device__ __forceinline__ NoCtx col_ctx(const Unit&, int) const { return NoCtx{}; }
    template <bool BI> __device__ __forceinline__ float apply(const Unit& u, int row, int col, float (&v)[8], float rs, NoCtx, NoPre) const {
#pragma unroll
        for (int j = 0; j < 8; ++j) v[j] *= rs;
        u32x2 w; w.x = pk4_fp8(v[0], v[1], v[2], v[3]); w.y = pk4_fp8(v[4], v[5], v[6], v[7]);
        *(u32x2*)((unsigned char*)KN + (size_t)row * D + u.pn * 256 + col) = w; return 0.f; }
};
struct EpiVT {
    static constexpr int NSTORE = 16;
    static constexpr int PRE_DEPTH = 1; static constexpr bool SUMSQ = false, COLMAJOR = true; typedef Ctx8 ColCtx; EPI_NOBIAS static constexpr bool DUAL = false;
    bf16_t* VT; const float* PSQKV;
    __device__ __forceinline__ Ctx8 col_ctx(const Unit& u, int col) const { Ctx8 c; const int t0 = u.pn * 256 + col;
#pragma unroll
        for (int j = 0; j < 8; ++j) c.s[j] = rstd_kv4(*(const f32x4*)(PSQKV + (size_t)(t0 + j) * 4));
        return c; }
    template <bool BI> __device__ __forceinline__ float apply(const Unit& u, int row, int col, float (&v)[8], float, const Ctx8& cc, NoPre) const {
#pragma unroll
        for (int j = 0; j < 8; ++j) v[j] *= cc.s[j];
        u32x2 w; w.x = pk4_fp8(v[0], v[1], v[2], v[3]); w.y = pk4_fp8(v[4], v[5], v[6], v[7]);
        *(u32x2*)((unsigned char*)VT + (size_t)row * T + u.pn * 256 + col) = w; return 0.f; }
};
struct EpiPlain {
    static constexpr int PRE_DEPTH = 1; static constexpr bool SUMSQ = false, COLMAJOR = false; typedef NoCtx ColCtx; EPI_DEFAULTS_NOROW EPI_DEFAULTS_NOPRE EPI_DEFAULTS_NOPART EPI_NOBIAS
    bf16_t* O; int ldc;
    __device__ __forceinline__ NoCtx col_ctx(const Unit&, int) const { return NoCtx{}; }
    template <bool BI> __device__ __forceinline__ float apply(const Unit& u, int row, int col, float (&v)[8], float, NoCtx, NoPre) const {
        *(u32x4*)(O + (size_t)row * ldc + u.pn * 256 + col) = pack8(v); return 0.f; }
};
struct PreG { u32x4 g; };
struct EpiMergeDual {
    static constexpr int NSTORE = 16;
    static constexpr int PRE_DEPTH = 3; static constexpr bool SUMSQ = false, COLMAJOR = false, DUAL = true; typedef NoCtx ColCtx; typedef PreG Pre; EPI_DEFAULTS_NOROW EPI_NOBIAS
    __device__ __forceinline__ bool want_partial(const Unit&) const { return false; } __device__ __forceinline__ void partial(const Unit&, int, int, float) const {}
    bf16_t* MG; const bf16_t* GATES;
    __device__ __forceinline__ NoCtx col_ctx(const Unit&, int) const { return NoCtx{}; }
    __device__ __forceinline__ void load_gates(const Unit& u, int row, int col, u32x4& ga, u32x4& gb) const { const bf16_t* p = GATES + (size_t)row * 2048 + u.pn * 256 + col; ga = *(const u32x4*)p; gb = *(const u32x4*)(p + 1024); }
    __device__ __forceinline__ PreG pre(const Unit& u, int row, int col) const { PreG p; p.g = *(const u32x4*)(GATES + (size_t)row * 2048 + 1024 + u.pn * 256 + col); return p; }
    template <bool BI> __device__ __forceinline__ float apply(const Unit& u, int row, int col, float (&v)[8], float, NoCtx, const PreG& pr) const {
        float g[8]; unpack8(pr.g, g);
#pragma unroll
        for (int j = 0; j < 8; ++j) v[j] *= g[j];
        *(u32x4*)(MG + (size_t)row * D + u.pn * 256 + col) = pack8(v); return 0.f; }
};
struct PreX { f32x4 a, b; };
struct EpiOut {
    static constexpr int NSTORE = 16;
    static constexpr int PRE_DEPTH = 3; static constexpr bool SUMSQ = true, COLMAJOR = false, LDSBIAS = true, BIASINIT = false, DUAL = false; typedef Ctx8 ColCtx; typedef PreX Pre; EPI_DEFAULTS_NOROW
    __device__ __forceinline__ bool want_partial(const Unit&) const { return true; }
    __device__ __forceinline__ void partial(const Unit& u, int row, int wc, float sq) const { PSQX[(size_t)row * 16 + u.pn * 4 + wc] = sq; }
    EPI_INITVEC_PLAIN
    __device__ __forceinline__ const float* bias_ptr(const Unit& u) const { return MOD + ((u.pm * 256) >> 12) * 6144 + 2 * 1024 + u.pn * 256; }
    const float* X; bf16_t* X1; const float* MOD; float* PSQX;
    __device__ __forceinline__ Ctx8 col_ctx(const Unit& u, int col) const { return load8f(MOD + ((u.pm * 256) >> 12) * 6144 + 2 * 1024 + u.pn * 256 + col); }
    __device__ __forceinline__ PreX pre(const Unit& u, int row, int col) const { const float* xr = X + (size_t)row * D + u.pn * 256 + col; PreX p; p.a = *(const f32x4*)xr; p.b = *(const f32x4*)(xr + 4); return p; }
    template <bool BI> __device__ __forceinline__ float apply(const Unit& u, int row, int col, float (&v)[8], float, const Ctx8& g1, const PreX& x) const {
        float o[8];
#pragma unroll
        for (int j = 0; j < 4; ++j) { o[j] = x.a[j] + g1.s[j] * v[j]; o[4 + j] = x.b[j] + g1.s[4 + j] * v[4 + j]; }
        *(u32x4*)(X1 + (size_t)row * D + u.pn * 256 + col) = pack8(o);
        float sq = 0.f;
#pragma unroll
        for (int j = 0; j < 8; ++j) sq += o[j] * o[j];
        return sq; }
};
__device__ __forceinline__ constexpr int ACT_SRC(int pos) { return ((pos >> 2) & 1) * 64 + (pos >> 5) * 16 + ((pos >> 3) & 3) * 4 + (pos & 3); }
struct EpiGU {
    static constexpr bool PAIRED = true, DEFER = true;
    __device__ __forceinline__ unsigned swiglu4(const float (&v)[8]) const { float a[4];
#pragma unroll
        for (int i = 0; i < 4; ++i) { const float gt = fminf(v[i], 7.0f * GUC), up1 = __builtin_amdgcn_fmed3f(v[4 + i], -6.0f * GUCI, 8.0f * GUCI);
            a[i] = up1 * (gt * __builtin_amdgcn_rcpf(1.0f + __builtin_amdgcn_exp2f(-gt))); }
        return pk4_fp8(a[0], a[1], a[2], a[3]); }
    __device__ __forceinline__ void compute(const f32x4 (&acc)[2][2][4][2], u32x2 (&pend)[4], int pm, int pn, int wr, int wc, int fr, int fq) const {
#pragma unroll
        for (int r = 0; r < 8; ++r) { const int ai = r >> 2, m = r & 3; float v0[8], v1[8];
#pragma unroll
            for (int j = 0; j < 4; ++j) { v0[j] = acc[ai][0][m][0][j]; v0[4 + j] = acc[ai][0][m][1][j]; v1[j] = acc[ai][1][m][0][j]; v1[4 + j] = acc[ai][1][m][1][j]; }
            u32x2 w; w.x = swiglu4(v0); w.y = swiglu4(v1);
            if (r < 4) store_row(pm, pn, r, wr, wc, fr, fq, w); else pend[r - 4] = w;
            asm volatile("" ::: "memory"); } }
    __device__ __forceinline__ void store_row(int pm, int pn, int r, int wr, int wc, int fr, int fq, u32x2 w) const {
        const int row = pm * 256 + wr * 64 + fr + (r >> 2) * 128 + (r & 3) * 16;
        *(u32x2*)((unsigned char*)ACT + (size_t)row * DE + pn * 128 + wc * 32 + 8 * fq) = w; }
    __device__ __forceinline__ void apply2(const Unit& u, int row, int col0, const float (&v0)[8], const float (&v1)[8], float) const {
        u32x2 w; w.x = swiglu4(v0); w.y = swiglu4(v1);
        *(u32x2*)((unsigned char*)ACT + (size_t)row * DE + u.pn * 128 + col0) = w; }
    static constexpr int PRE_DEPTH = 1; static constexpr bool SUMSQ = false, COLMAJOR = false, LDSBIAS = true, BIASINIT = true; typedef Ctx8 ColCtx; EPI_DEFAULTS_NOROW EPI_DEFAULTS_NOPRE EPI_DEFAULTS_NOPART
    __device__ __forceinline__ const float* bias_ptr(const Unit& u) const { return bgu + (size_t)u.e * 2048 + u.pn * 256; }
    __device__ __forceinline__ f32x4 init_vec(f32x4 lo, f32x4 hi, int n) const { return n ? (f32x4){lo[1] + 1.0f, lo[3] + 1.0f, hi[1] + 1.0f, hi[3] + 1.0f} * GUCI : (f32x4){lo[0], lo[2], hi[0], hi[2]} * GUC; }
    bf16_t* ACT; const float* bgu;
    __device__ __forceinline__ Ctx8 col_ctx(const Unit& u, int col) const { return load8f(bgu + (size_t)u.e * 2048 + u.pn * 256 + col); }
    template <bool BI> __device__ __forceinline__ float apply(const Unit& u, int row, int col, float (&v)[8], float, const Ctx8& bb, NoPre) const {
        const int p = u.pn * 256 + col; float a[4];
#pragma unroll
        for (int i = 0; i < 4; ++i) { float gt = BI ? v[i] : v[i] + bb.s[2 * i] * GUC, up1 = BI ? v[4 + i] : v[4 + i] + (bb.s[2 * i + 1] + 1.0f) * GUCI;
            gt = fminf(gt, 7.0f * GUC); up1 = __builtin_amdgcn_fmed3f(up1, -6.0f * GUCI, 8.0f * GUCI);
            a[i] = up1 * (gt * __builtin_amdgcn_rcpf(1.0f + __builtin_amdgcn_exp2f(-gt))); }
        *(unsigned*)((unsigned char*)ACT + (size_t)row * DE + (p >> 1)) = pk4_fp8(a[0], a[1], a[2], a[3]); return 0.f; }
};
struct Pre1 { float w; };
struct EpiDown {
    static constexpr int NSTORE = 8; static constexpr bool PAIRED = true;
    __device__ __forceinline__ void apply2(const Unit& u, int row, int col0, const float (&v0)[8], const float (&v1)[8], float rw) const {
        const float rs = rw * YSCALE;
        u32x4 w; w.x = pk4_fp8(v0[0] * rs, v0[1] * rs, v0[2] * rs, v0[3] * rs); w.y = pk4_fp8(v0[4] * rs, v0[5] * rs, v0[6] * rs, v0[7] * rs);
        w.z = pk4_fp8(v1[0] * rs, v1[1] * rs, v1[2] * rs, v1[3] * rs); w.w = pk4_fp8(v1[4] * rs, v1[5] * rs, v1[6] * rs, v1[7] * rs);
        *(u32x4*)((unsigned char*)Y + (size_t)row * D + u.pn * 256 + 2 * col0) = w; }
    static constexpr int PRE_DEPTH = 7; static constexpr bool SUMSQ = false, COLMAJOR = false, LDSBIAS = true, BIASINIT = true; typedef Ctx8 ColCtx; typedef Pre1 RowPre; EPI_DEFAULTS_NOPRE EPI_DEFAULTS_NOPART EPI_INITVEC_PLAIN
    __device__ __forceinline__ const float* bias_ptr(const Unit& u) const { return bdn + (size_t)u.e * D + u.pn * 256; }
    bf16_t* Y; const float* bdn; const float* ROWW;
    __device__ __forceinline__ Pre1 row_pre(const Unit&, int row) const { Pre1 r; r.w = ROWW[row]; return r; }
    __device__ __forceinline__ float row_ctx(const Pre1& r) const { return r.w; }
    __device__ __forceinline__ Ctx8 col_ctx(const Unit& u, int col) const { return load8f(bdn + (size_t)u.e * D + u.pn * 256 + col); }
    template <bool BI> __device__ __forceinline__ float apply(const Unit& u, int row, int col, float (&v)[8], float rw, const Ctx8& bb, NoPre) const {
        const float rs = rw * YSCALE;
#pragma unroll
        for (int j = 0; j < 8; ++j) v[j] = (BI ? v[j] : v[j] + bb.s[j]) * rs;
        u32x2 w; w.x = pk4_fp8(v[0], v[1], v[2], v[3]); w.y = pk4_fp8(v[4], v[5], v[6], v[7]);
        *(u32x2*)((unsigned char*)Y + (size_t)row * D + u.pn * 256 + col) = w; return 0.f; }
};

struct TrItem { const float* src; unsigned char* dst; const float* rs; const float* cs; int Nsrc, K, kb, pb, lb, perm; bool fp8, valid, kperm; };
__device__ __forceinline__ void tr_load(const TrItem& t, f32x4 (&R)[16], int lane) {
    if (t.kperm) {
        const float* p = t.src + (size_t)((t.kb >> 1) * 128 + ACT_SRC(16 * (lane >> 3))) * t.Nsrc + t.lb + 32 * (t.kb & 1) + 4 * (lane & 7);
#pragma unroll
        for (int it = 0; it < 16; ++it) R[it] = __builtin_nontemporal_load((const f32x4*)(p + (size_t)ACT_SRC(it) * t.Nsrc));
        return; }
    const float* p = t.src + (size_t)((t.kb >> 1) * 128 + 16 * (lane >> 3)) * t.Nsrc + t.lb + 32 * (t.kb & 1) + 4 * (lane & 7);
#pragma unroll
    for (int it = 0; it < 16; ++it) R[it] = __builtin_nontemporal_load((const f32x4*)(p + (size_t)it * t.Nsrc));
}
__device__ __forceinline__ void tr_process(const TrItem& t, const f32x4 (&R)[16], int lane) {
    const int k0 = (t.kb >> 1) * 128 + 16 * (lane >> 3), o4 = 32 * (t.kb & 1) + 4 * (lane & 7);
    f32x4 csv = (f32x4){1.f, 1.f, 1.f, 1.f}; if (t.cs) csv = *(const f32x4*)(t.cs + t.lb + o4);
    if (t.fp8) csv *= W8SCALE;
    f32x4 rs[4];
#pragma unroll
    for (int q = 0; q < 4; ++q) rs[q] = (f32x4){1.f, 1.f, 1.f, 1.f};
    if (t.rs) {
#pragma unroll
        for (int q = 0; q < 4; ++q) rs[q] = *(const f32x4*)(t.rs + k0 + 4 * q); }
#pragma unroll
    for (int e = 0; e < 4; ++e) {
        const int o = o4 + e;
        int ph;
        if (t.perm == 1) ph = 8 * ((o & 31) >> 2) + 4 * (o >> 5) + (o & 3);
        else if (t.perm == 2) ph = 8 * (o >> 3) + 4 * (o & 1) + ((o & 7) >> 1);
        else ph = o;
        float v[16];
        const float ce = csv[e] * (t.perm == 2 ? ((e & 1) ? GUCI : GUC) : 1.0f);
#pragma unroll
        for (int it = 0; it < 16; ++it) v[it] = R[it][e] * ce * rs[it >> 2][it & 3];
        const size_t off = (size_t)(t.pb * 64 + ph) * t.K + k0;
        if (t.fp8) { u32x4 w; w.x = pk4_fp8(v[0], v[1], v[2], v[3]); w.y = pk4_fp8(v[4], v[5], v[6], v[7]); w.z = pk4_fp8(v[8], v[9], v[10], v[11]); w.w = pk4_fp8(v[12], v[13], v[14], v[15]);
            *(u32x4*)(t.dst + off) = w; }
        else { u32x4 w0, w1; w0.x = pk2(v[0], v[1]); w0.y = pk2(v[2], v[3]); w0.z = pk2(v[4], v[5]); w0.w = pk2(v[6], v[7]); w1.x = pk2(v[8], v[9]); w1.y = pk2(v[10], v[11]); w1.z = pk2(v[12], v[13]); w1.w = pk2(v[14], v[15]);
            *(u32x4*)(t.dst + off * 2) = w0; *(u32x4*)(t.dst + off * 2 + 16) = w1; }
    }
}
constexpr int TR_N_IN = 16 * 65, TR_N_Q = 12 * 24, TR_N_K = 4 * 16, TR_N_V = 4 * 16, TR_N_SQ = 16 * 16, TR_N_GU = 32 * 16 * 32, TR_N_DN = 32 * 16 * 16;
constexpr int TR_NITEMS = TR_N_IN + TR_N_Q + TR_N_K + TR_N_V + 2 * TR_N_SQ + TR_N_GU + TR_N_DN;
__device__ __forceinline__ TrItem tr_decode(KArgP a, int it, int last) {
    unsigned char* ws = a->ws; TrItem t; t.rs = nullptr; t.cs = nullptr; t.perm = 0; t.fp8 = false; t.kperm = false; t.valid = it < last;
    if (!t.valid) it = 0;
    int r = it;
    if (r < TR_N_IN) { const int pb = r % 65; t.kb = r / 65; t.src = a->in[I_WIN]; t.Nsrc = IN_W; t.K = 1024;
        if (pb < 32) { t.dst = ws + WS_WIN8; t.pb = pb; t.lb = pb * 64; t.fp8 = true; }
        else if (pb < 64) { t.dst = ws + WS_WIN8; t.pb = pb; t.lb = pb * 64 + 64; t.fp8 = true; }
        else { t.dst = ws + WS_WKPE; t.pb = 0; t.lb = 2048; t.fp8 = true; }
        return t; } r -= TR_N_IN;
    if (r < TR_N_Q) { const int pb = r % 24; t.kb = r / 24; t.src = a->in[I_WQB]; t.Nsrc = NH * QKD; t.K = QL; t.dst = ws + WS_WQ; t.pb = pb; t.rs = a->in[I_GQA]; t.fp8 = true;
        if (pb < 16) t.lb = (pb >> 1) * QKD + (pb & 1) * 64; else { t.lb = (pb - 16) * QKD + NOPE; t.perm = 1; }
        return t; } r -= TR_N_Q;
    if (r < TR_N_K) { const int pb = r % 16; t.kb = r / 16; t.src = a->in[I_WKVB]; t.Nsrc = NH * 256; t.K = KVL; t.dst = ws + WS_WK; t.pb = pb; t.rs = a->in[I_GKVA]; t.lb = (pb >> 1) * 256 + (pb & 1) * 64; t.fp8 = true; return t; } r -= TR_N_K;
    if (r < TR_N_V) { const int pb = r % 16; t.kb = r / 16; t.src = a->in[I_WKVB]; t.Nsrc = NH * 256; t.K = KVL; t.dst = ws + WS_WV; t.pb = pb; t.rs = a->in[I_GKVA]; t.lb = (pb >> 1) * 256 + 128 + (pb & 1) * 64; t.fp8 = true; return t; } r -= TR_N_V;
    if (r < 2 * TR_N_SQ) { const int which = r / TR_N_SQ, q = r % TR_N_SQ; t.pb = q % 16; t.kb = q / 16; t.src = which == 0 ? a->in[I_WMO] : a->in[I_WOUT];
        t.dst = ws + (which == 0 ? WS_WMO : WS_WOUT); t.Nsrc = 1024; t.K = 1024; t.lb = t.pb * 64; return t; } r -= 2 * TR_N_SQ;
    if (r < TR_N_GU) { const int e = r / 512, q = r % 512; t.pb = q % 32; t.kb = q / 32; t.src = a->in[I_WGU] + (size_t)e * 1024 * 2048; t.Nsrc = 2048; t.K = 1024; t.dst = ws + WS_WGU + (size_t)e * 2048 * 1024; t.lb = t.pb * 64; t.perm = 2; t.fp8 = true; return t; } r -= TR_N_GU;
    { const int e = r / 256, q = r % 256; t.pb = q % 16; t.kb = q / 16; t.src = a->in[I_WDN] + (size_t)e * 1024 * 1024; t.Nsrc = 1024; t.K = 1024; t.dst = ws + WS_WDN + (size_t)e * 1024 * 1024; t.lb = t.pb * 64; t.fp8 = true; t.kperm = true; }
    return t;
}

constexpr int TR_EARLY = TR_NITEMS - TR_N_GU - TR_N_DN;
__device__ __forceinline__ void tr_range(KArgP a, LAS unsigned char* lds, int vcu, int G, int first, int last) {
    const int tid = tid_fresh(), lane = tid & 63, wave = __builtin_amdgcn_readfirstlane(tid >> 6);
    const int gw = first + vcu * 8 + wave, NGW = G * 8;
    f32x4 R0[16], R1[16];
    TrItem c0 = tr_decode(a, gw, last);
    if (c0.valid) tr_load(c0, R0, lane);
#pragma unroll 1
    for (int it = gw; it < last; it += 2 * NGW) {
        const TrItem c1 = tr_decode(a, it + NGW, last);
        if (c1.valid) tr_load(c1, R1, lane);
        tr_process(c0, R0, lane);
        c0 = tr_decode(a, it + 2 * NGW, last);
        if (c0.valid) tr_load(c0, R0, lane);
        if (c1.valid) tr_process(c1, R1, lane);
    }
}
__device__ __forceinline__ void p0_prep(KArgP a, LAS unsigned char* lds, int vcu, int G) {
    const int tid = tid_fresh(), lane = tid & 63, wave = __builtin_amdgcn_readfirstlane(tid >> 6);
    unsigned char* ws = a->ws;
    __syncthreads();
    for (int item = vcu; item < 128; item += G) {
        LAS float* cact = (LAS float*)lds;
        LAS float* part = (LAS float*)(lds + 32768);
        for (int i = tid; i < 8 * 1024; i += NTHREADS) { const float cv = a->in[I_C][i]; cact[i] = cv / (1.0f + __expf(-cv)); }
        __syncthreads();
        const bool isf = item >= 96; const float* W = isf ? a->in[I_WFMOD] : a->in[I_WMOD]; const int N = isf ? 2048 : 6144, j0 = (isf ? item - 96 : item) * 64;
        float acc[8];
#pragma unroll
        for (int b = 0; b < 8; ++b) acc[b] = 0.f;
        for (int k0 = wave * 128; k0 < wave * 128 + 128; k0 += 32) {
            float wv[32];
#pragma unroll
            for (int q = 0; q < 32; ++q) wv[q] = W[(size_t)(k0 + q) * N + j0 + lane];
#pragma unroll
            for (int q = 0; q < 32; ++q)
#pragma unroll
                for (int b = 0; b < 8; ++b) acc[b] += cact[b * 1024 + k0 + q] * wv[q]; }
#pragma unroll
        for (int b = 0; b < 8; ++b) part[(wave * 8 + b) * 64 + lane] = acc[b];
        __syncthreads();
        { const int b = tid >> 6, col = tid & 63; float s = 0.f;
#pragma unroll
            for (int w = 0; w < 8; ++w) s += part[(w * 8 + b) * 64 + col];
            if (isf) ((float*)(ws + WS_FMOD))[b * 2048 + j0 + col] = s + a->in[I_BFMOD][j0 + col];
            else ((float*)(ws + WS_MOD))[b * 6144 + j0 + col] = s + a->in[I_BMOD][j0 + col]; }
        __syncthreads();
    }
    { const int* pos = (const int*)a->in[I_POS]; f32x2* CS = (f32x2*)(ws + WS_CS);
        for (int idx = vcu * NTHREADS + tid; idx < T * 32; idx += G * NTHREADS) { const int t = idx >> 5, i = idx & 31;
            const double invf = exp(-(double)i * (9.210340371976184 / 32.0));
            const double ang = (double)pos[t] * invf; const double n = rint(ang * 0.15915494309189535); const float r = (float)(ang - n * 6.283185307179586);
            CS[idx] = (f32x2){__cosf(r), __sinf(r)}; } }
    { int* RT = (int*)(ws + WS_ROWTOK); for (int idx = vcu * NTHREADS + tid; idx < RT_MAX * 256; idx += G * NTHREADS) RT[idx] = 0; }
    { bf16_t* WR = (bf16_t*)(ws + WS_WR);
        for (int idx = vcu * NTHREADS + tid; idx < 1024 * 32; idx += G * NTHREADS) { const int e = idx & 31, k = idx >> 5; const float v = a->in[I_WR][idx];
            const unsigned h = pk2(v, 0.f) & 0xffffu; const float lo = v - bflo(h); WR[e * 1024 + k] = (bf16_t)h; WR[32768 + e * 1024 + k] = (bf16_t)(pk2(lo, 0.f) & 0xffffu); } }
    for (int item = vcu; item < 256; item += G) {
        const int kg8 = item >> 1, nb = (item & 1) * 512, g = kg8 >> 5, kl0 = (kg8 & 31) * 8;
        LAS float* wg8 = (LAS float*)lds;
        __syncthreads();
        for (int i = tid; i < 2048; i += NTHREADS) { const int kk = i >> 8, j = i & 255; wg8[j * 8 + kk] = a->in[I_WPG][(size_t)g * 65536 + (size_t)(kl0 + kk) * 256 + j] * a->in[I_PSCALE][g * 256 + j]; }
        __syncthreads();
        const int n = nb + tid; const float* wp = a->in[I_WPO] + (size_t)(g * 256) * 1024 + n;
        float acc[8];
#pragma unroll
        for (int i = 0; i < 8; ++i) acc[i] = 0.f;
        for (int j0 = 0; j0 < 256; j0 += 32) {
            float wv[32];
#pragma unroll
            for (int q = 0; q < 32; ++q) wv[q] = wp[(size_t)(j0 + q) * 1024];
#pragma unroll
            for (int q = 0; q < 32; ++q) { const f32x4 c0 = *(const LAS f32x4*)(wg8 + (j0 + q) * 8), c1 = *(const LAS f32x4*)(wg8 + (j0 + q) * 8 + 4);
#pragma unroll
                for (int i = 0; i < 4; ++i) { acc[i] += wv[q] * c0[i]; acc[4 + i] += wv[q] * c1[i]; } }
        }
        *(u32x4*)((bf16_t*)(ws + WS_WPO) + (size_t)n * 1024 + g * 256 + kl0) = pack8(acc);
        __syncthreads();
    }
    tr_range(a, lds, vcu, G, 0, TR_EARLY);
}

__device__ __forceinline__ void quad_transpose4(unsigned (&w)[4], int lane) {
    const bool o1 = lane & 1, o2 = lane & 2;
    { const unsigned s0 = o1 ? w[0] : w[1], s1 = o1 ? w[2] : w[3];
        const unsigned t0 = (unsigned)__builtin_amdgcn_mov_dpp((int)s0, 0xB1, 0xF, 0xF, true), t1 = (unsigned)__builtin_amdgcn_mov_dpp((int)s1, 0xB1, 0xF, 0xF, true);
        if (o1) { w[0] = t0; w[2] = t1; } else { w[1] = t0; w[3] = t1; } }
    { const unsigned s0 = o2 ? w[0] : w[2], s1 = o2 ? w[1] : w[3];
        const unsigned t0 = (unsigned)__builtin_amdgcn_mov_dpp((int)s0, 0x4E, 0xF, 0xF, true), t1 = (unsigned)__builtin_amdgcn_mov_dpp((int)s1, 0x4E, 0xF, 0xF, true);
        if (o2) { w[0] = t0; w[1] = t1; } else { w[2] = t0; w[3] = t1; } }
}
__device__ __forceinline__ void p1_hb(KArgP a, int vcu, int G) {
    const int tid = tid_fresh(), lane = tid & 63, wave = tid >> 6;
    const float* MOD = (const float*)(a->ws + WS_MOD); bf16_t* HB = (bf16_t*)(a->ws + WS_S0);
    for (int rb = vcu * 128; rb < T; rb += G * 128) {
        const int b = rb >> 12;
        f32x4 gs[4], sh[4];
#pragma unroll
        for (int j = 0; j < 4; ++j) { const int c = 4 * lane + 256 * j; const f32x4 g = *(const f32x4*)(a->in[I_GMIX] + c), sc = *(const f32x4*)(MOD + b * 6144 + 1024 + c);
            gs[j] = g * (sc + 1.0f); sh[j] = *(const f32x4*)(MOD + b * 6144 + c); }
#pragma unroll 1
        for (int i0 = 0; i0 < 16; i0 += 4) {
            f32x4 v[4][4];
#pragma unroll
            for (int q = 0; q < 4; ++q) { const f32x4* xr = (const f32x4*)(a->in[I_X] + (size_t)(rb + wave * 16 + i0 + q) * D) + lane;
#pragma unroll
                for (int j = 0; j < 4; ++j) v[q][j] = __builtin_nontemporal_load(xr + 64 * j); }
#pragma unroll
            for (int q = 0; q < 4; ++q) { const int r = rb + wave * 16 + i0 + q; float s = 0.f;
#pragma unroll
                for (int j = 0; j < 4; ++j) s += (v[q][j][0] * v[q][j][0] + v[q][j][1] * v[q][j][1]) + (v[q][j][2] * v[q][j][2] + v[q][j][3] * v[q][j][3]);
                const float rstd = rsqrtf(wave_sum(s) * (1.0f / D) + EPS);
                unsigned w[4];
#pragma unroll
                for (int j = 0; j < 4; ++j) { const f32x4 h = v[q][j] * rstd * gs[j] + sh[j]; w[j] = pk4_fp8(h[0], h[1], h[2], h[3]); }
                quad_transpose4(w, lane);
                *(u32x4*)(a->ws + WS_HB8 + (size_t)r * D + 16 * (lane >> 2) + 256 * (lane & 3)) = (u32x4){w[0], w[1], w[2], w[3]}; } }
    }
}

__device__ __forceinline__ void p3_kpe(KArgP a, LAS unsigned char* lds, int vcu, int G) {
    const int tid = tid_fresh(), lane = tid & 63, wave = tid >> 6, rr = lane & 15, g = lane >> 4;
    const unsigned char* HB8 = a->ws + WS_HB8; unsigned char* KPE = a->ws + WS_KPE; const f32x2* CS = (const f32x2*)(a->ws + WS_CS);
    __syncthreads();
    { const u32x4* src = (const u32x4*)(a->ws + WS_WKPE);
        for (int ch = tid; ch < 4096; ch += NTHREADS) { const int e = ch >> 6, kc = ch & 63; *(LAS u32x4*)(lds + e * 1024 + ((kc ^ (e & 15)) << 4)) = src[ch]; } }
    __syncthreads();
    const int sclX = SCALE_ONE, sclW = SCALE_W8;
    for (int rb = vcu * 128; rb < T; rb += G * 128) {
        const int r0 = rb + wave * 16;
        const unsigned char* hr = HB8 + (size_t)(r0 + rr) * D + 32 * g;
        f32x4 acc[4];
#pragma unroll
        for (int c = 0; c < 4; ++c) acc[c] = (f32x4){0.f, 0.f, 0.f, 0.f};
        v8i32 Ah[8];
#pragma unroll
        for (int s = 0; s < 8; ++s) Ah[s] = __builtin_shufflevector(*(const v4i32*)(hr + 128 * s), *(const v4i32*)(hr + 128 * s + 16), 0, 1, 2, 3, 4, 5, 6, 7);
#pragma unroll
        for (int s = 0; s < 8; ++s) { const int kc = 8 * s + 2 * g;
#pragma unroll
            for (int c = 0; c < 4; ++c) { const LAS unsigned char* wr = lds + (16 * c + rr) * 1024;
                const v8i32 Bw = __builtin_shufflevector(*(const LAS v4i32*)(wr + ((kc ^ rr) << 4)), *(const LAS v4i32*)(wr + (((kc + 1) ^ rr) << 4)), 0, 1, 2, 3, 4, 5, 6, 7);
                asm volatile("v_mfma_scale_f32_16x16x128_f8f6f4 %0, %1, %2, %0, %3, %4 op_sel_hi:[0,0,0]" : "+v"(acc[c]) : "v"(Ah[s]), "v"(Bw), "v"(sclX), "v"(sclW)); } }
        asm volatile("s_nop 15\n\ts_nop 15" : "+v"(acc[0]), "+v"(acc[1]), "+v"(acc[2]), "+v"(acc[3]));
#pragma unroll
        for (int reg = 0; reg < 4; ++reg) { const int t = r0 + 4 * g + reg;
#pragma unroll
            for (int c = 0; c < 2; ++c) { const int f = 16 * c + rr; const f32x2 cs = CS[(size_t)t * 32 + f]; const float x1 = acc[c][reg], x2 = acc[c + 2][reg];
                unsigned char* kp8 = KPE + (size_t)t * 64; kp8[f] = (unsigned char)(pk4_fp8(x1 * cs.x - x2 * cs.y, 0.f, 0.f, 0.f) & 0xffu); kp8[32 + f] = (unsigned char)(pk4_fp8(x2 * cs.x + x1 * cs.y, 0.f, 0.f, 0.f) & 0xffu); } }
    }
    __syncthreads();
}

__device__ __forceinline__ void p3_mixed(KArgP a, int vcu, int G) {
    const int tid = tid_fresh(); const bf16_t* U = (const bf16_t*)(a->ws + WS_S1); bf16_t* MX = (bf16_t*)(a->ws + WS_S0);
    for (int rb = vcu * 128; rb < T; rb += G * 128) {
        for (int q = 0; q < 2; ++q) { const int item = tid + NTHREADS * q, cgi = item & 127, seg = item >> 7;
            const int w = 2 << (cgi >> 5), row0 = rb + seg * 16, s0 = row0 & (SEQ - 1);
            const bf16_t* up = U + (size_t)row0 * D + cgi * 8;
            u32x4 R[31];
#pragma unroll
            for (int i = 0; i < 15; ++i) { R[i] = (u32x4){0u, 0u, 0u, 0u}; if (15 - i < w && s0 - (15 - i) >= 0) R[i] = *(const u32x4*)(up - (size_t)(15 - i) * D); }
#pragma unroll
            for (int i = 0; i < 16; ++i) R[15 + i] = *(const u32x4*)(up + (size_t)i * D);
            float sum[8];
#pragma unroll
            for (int j = 0; j < 8; ++j) sum[j] = 0.f;
#pragma unroll
            for (int i = 0; i < 15; ++i) { float f[8]; unpack8(R[i], f);
#pragma unroll
                for (int j = 0; j < 8; ++j) sum[j] += f[j]; }
#pragma unroll
            for (int i = 0; i < 16; ++i) { const int s = s0 + i; float cur[8]; unpack8(R[15 + i], cur);
                const float inv = 1.0f / (float)(s + 1 < w ? s + 1 : w); float o[8];
#pragma unroll
                for (int j = 0; j < 8; ++j) { sum[j] += cur[j]; o[j] = sum[j] * inv - cur[j]; }
                *(u32x4*)(MX + (size_t)(row0 + i) * D + cgi * 8) = pack8(o);
                const u32x4 dr = w == 2 ? R[15 + i - 1] : w == 4 ? R[15 + i - 3] : w == 8 ? R[15 + i - 7] : R[i]; float fd[8]; unpack8(dr, fd);
#pragma unroll
                for (int j = 0; j < 8; ++j) sum[j] -= fd[j]; }
        }
    }
}

typedef float f32x16 __attribute__((ext_vector_type(16)));
__device__ __forceinline__ float max3f(float a, float b, float c) { float r; asm("v_max3_f32 %0, %1, %2, %3" : "=v"(r) : "v"(a), "v"(b), "v"(c)); return r; }
constexpr int CV_NLOOP = 70;
constexpr float ATT_THR = 8.0f;
__device__ __forceinline__ int kperm(int r) { return (r & ~36) | ((r & 4) << 3) | ((r & 32) >> 3); }
__device__ __forceinline__ void attn_fast(KArgP a, LAS unsigned char* lds, int vcu, int G) {
    const int tid = tid_fresh(), lane = tid & 63, wid = __builtin_amdgcn_readfirstlane(tid >> 6), i32 = lane & 31, hi = lane >> 5;
    const bool isB = wid >= 4;
    const unsigned char* Q8 = a->ws + WS_Q; const unsigned char* KN8 = a->ws + WS_KN; const unsigned char* KPE8 = a->ws + WS_KPE; const unsigned char* VT = a->ws + WS_VT; bf16_t* O = (bf16_t*)(a->ws + WS_O);
    constexpr int KBUF = 12288, KP_OFF = 8192, KPAIR = 2 * KBUF, V_BASE = 2 * KPAIR, VBUF = 8192, VPAIR = 2 * VBUF;
    const int rK = 8 * wid + (lane >> 3); const unsigned srcK = (unsigned)(kperm(rK) * 1024 + (((lane & 7) ^ ((rK >> 1) & 7)) * 16));
    const int rP = 16 * (wid & 3) + (lane >> 2); const unsigned srcP = (unsigned)(kperm(rP) * 64 + (((lane & 3) ^ ((rP >> 2) & 3)) * 16));
    const int dV = 16 * wid + (lane >> 2); const size_t srcV = (size_t)dV * T + (size_t)(((lane & 3) ^ ((dV >> 2) & 3)) * 16);
    const int xk = (i32 >> 1) & 7, xq = (i32 >> 2) & 3;
    int koff[2][2], poff[2], voff[2];
#pragma unroll
    for (int s2 = 0; s2 < 2; ++s2)
#pragma unroll
        for (int c = 0; c < 2; ++c) koff[s2][c] = i32 * 128 + (((4 * s2 + 2 * hi + c) ^ xk) << 4);
#pragma unroll
    for (int c = 0; c < 2; ++c) { poff[c] = KP_OFF + i32 * 64 + (((2 * hi + c) ^ xq) << 4); voff[c] = V_BASE + i32 * 64 + (((2 * hi + c) ^ xq) << 4); }
    const unsigned lds0 = (unsigned)(size_t)lds;
    const int sclK = SCALE_ONE, sclQ = SCALE_Q8;
    const int nun = (G == 256) ? 4 : (NB * NH * 16 + G - 1) / G;
    const int trslot = (vcu >> 2) & 3;
    const int ncl = (G == 256) ? CV_NLOOP : 0;
    constexpr int CV_BASE = 98304;
    int cst = 0, cpr = 0;
#define CV_DECODE(n_) int r_ = (n_) * G + vcu; const bool gu_ = r_ < TR_N_GU; if (!gu_) r_ -= TR_N_GU; \
        const int e_ = gu_ ? r_ >> 9 : r_ >> 8, q_ = gu_ ? r_ & 511 : r_ & 255, pb_ = gu_ ? q_ & 31 : q_ & 15, kb_ = gu_ ? q_ >> 5 : q_ >> 4
#define CV_LANE() int ln_ = lane; asm volatile("" : "+v"(ln_)); const int cvp = 8 * wid + (ln_ >> 3), cvc = ln_ & 7
#define CV_READ() do { CV_LANE(); const int cvrd = (8 * cvc) * 256 + (((cvp >> 2) ^ (2 * cvc)) << 4) + (cvp & 3) * 4; const LAS float* sp_ = (const LAS float*)(lds + CV_BASE + (cpr % 3) * 16384 + cvrd); \
        _Pragma("unroll") for (int i_ = 0; i_ < 8; ++i_) cv[i_] = sp_[i_ * 64]; cvpend = true; } while (0)
#define CV_STORE() do { CV_DECODE(cpr); CV_LANE(); \
        const int ph_ = gu_ ? (cvp & ~7) + 4 * (cvp & 1) + ((cvp & 7) >> 1) : cvp; \
        unsigned char* dp_ = ws_b + (gu_ ? WS_WGU + (size_t)e_ * 2048 * 1024 : WS_WDN + (size_t)e_ * 1024 * 1024) + (size_t)(pb_ * 64 + ph_) * 1024 + kb_ * 64 + 8 * cvc; \
        const float f_ = gu_ ? ((cvp & 1) ? W8SCALE * GUCI : W8SCALE * GUC) : W8SCALE; \
        u32x2 w_; w_.x = pk4_fp8(cv[0] * f_, cv[1] * f_, cv[2] * f_, cv[3] * f_); w_.y = pk4_fp8(cv[4] * f_, cv[5] * f_, cv[6] * f_, cv[7] * f_); \
        *(u32x2*)dp_ = w_; ++cpr; cvpend = false; } while (0)
    const float* const wgu_s = a->in[I_WGU]; const float* const wdn_s = a->in[I_WDN]; unsigned char* const ws_b = a->ws;
    float cv[8]; bool cvpend = false;
#pragma unroll
    for (int i_ = 0; i_ < 8; ++i_) cv[i_] = 0.f;
    for (int ui = 0; ui < nun; ++ui) {
        if (ui == trslot && ui < 3) tr_range(a, lds, vcu, G, TR_EARLY + G * ncl, TR_NITEMS);
        int bh, qb;
        if (G == 256) { const int s4 = vcu & 3; bh = vcu >> 2; qb = ui == 0 ? 15 - s4 : ui == 1 ? 11 - s4 : ui == 2 ? s4 : 4 + s4; }
        else { const int it = vcu + ui * G; if (it >= NB * NH * 16) break; bh = it >> 4; qb = 15 - (it & 15); }
        const int b = bh >> 3, h = bh & 7, t0 = b * SEQ + qb * 256, NT = 4 * qb + 4, myjmax = 4 * qb + (wid >> 1);
        const unsigned char* gK = KN8 + (size_t)b * SEQ * 1024 + h * 128 + srcK; const unsigned char* gP = KPE8 + (size_t)b * SEQ * 64 + srcP; const unsigned char* gV = VT + (size_t)(h * 128) * T + (size_t)b * SEQ + srcV;
#define ATT_GLDS(gp, ldsoff) do { unsigned keep_; const unsigned dst_ = (unsigned)__builtin_amdgcn_readfirstlane((int)(lds0 + (unsigned)(ldsoff))); \
        asm volatile("s_mov_b32 %0, m0\n\ts_mov_b32 m0, %2\n\ts_nop 0\n\tglobal_load_lds_dwordx4 %1, off\n\ts_mov_b32 m0, %0" : "=&s"(keep_) : "v"(gp), "s"(dst_) : "memory"); } while (0)
#define ATT_STAGE(jp_, ko, vo) do { const size_t j0_ = (size_t)(2 * (jp_)); \
        ATT_GLDS(gK + j0_ * 65536, (ko) + wid * 1024); ATT_GLDS(gK + (j0_ + 1) * 65536, (ko) + KBUF + wid * 1024); \
        ATT_GLDS(gP + (j0_ + (wid >> 2)) * 4096, (ko) + (wid >> 2) * KBUF + KP_OFF + (wid & 3) * 1024); \
        ATT_GLDS(gV + j0_ * 64, V_BASE + (vo) + wid * 1024); ATT_GLDS(gV + (j0_ + 1) * 64, V_BASE + (vo) + VBUF + wid * 1024); } while (0)
#define ATT_LD2(p0_, p1_) __builtin_shufflevector(*(const LAS v4i32*)(p0_), *(const LAS v4i32*)(p1_), 0, 1, 2, 3, 4, 5, 6, 7)
#define ATT_PV(vo) do { const LAS unsigned char* vb_ = lds + (vo); \
        _Pragma("unroll") for (int d = 0; d < 4; ++d) { const v8i32 va_ = ATT_LD2(vb_ + voff[0] + d * 2048, vb_ + voff[1] + d * 2048); \
            asm volatile("s_nop 1\n\tv_mfma_scale_f32_32x32x64_f8f6f4 %0, %1, %2, %0, %3, %3 op_sel_hi:[0,0,0]" : "+v"(o[d]) : "v"(va_), "v"(pq), "v"(sclK)); } } while (0)
        ATT_STAGE(0, 0, 0);
        v8i32 qf[3];
        { const unsigned char* qp = Q8 + (size_t)(t0 + 32 * wid + i32) * (NH * QKD) + h * QKD + 32 * hi;
#pragma unroll
            for (int s2 = 0; s2 < 3; ++s2) qf[s2] = __builtin_shufflevector(*(const v4i32*)(qp + 64 * s2), *(const v4i32*)(qp + 64 * s2 + 16), 0, 1, 2, 3, 4, 5, 6, 7); }
        { const int qtouch = qf[0][0] ^ qf[0][4] ^ qf[1][0] ^ qf[1][4] ^ qf[2][0] ^ qf[2][4]; asm volatile("" :: "v"(qtouch)); }
        f32x16 o[4];
#pragma unroll
        for (int d = 0; d < 4; ++d)
#pragma unroll
            for (int r = 0; r < 16; ++r) o[d][r] = 0.f;
        v8i32 pq = (v8i32){0, 0, 0, 0, 0, 0, 0, 0};
        f32x16 negm;
#pragma unroll
        for (int r = 0; r < 16; ++r) negm[r] = 0.f;
        float m = 0.f, l = 0.f;
        int vprev = 0, vcur = 0, vnext = VPAIR;
        asm volatile("s_waitcnt vmcnt(0)" ::: "memory");
        __syncthreads();
        const int NP = NT >> 1;
        for (int jp = 0; jp <= NP; ++jp) {
            const int kop = (jp & 1) * KPAIR;
            if (jp + 1 < NP) ATT_STAGE(jp + 1, KPAIR - kop, vnext);
            if (cpr + 1 < cst) CV_READ();
            const bool cvnow = cst < ncl;
            if (cvnow) { CV_DECODE(cst); const int ns_ = gu_ ? 2048 : 1024;
                const float* gp_ = (gu_ ? wgu_s + (size_t)e_ * 1024 * 2048 : wdn_s + (size_t)e_ * 1024 * 1024) + (size_t)(gu_ ? kb_ * 64 + 8 * wid + (lane >> 4) : (kb_ >> 1) * 128 + ACT_SRC((kb_ & 1) * 64 + 8 * wid + (lane >> 4))) * ns_ + pb_ * 64 + 4 * ((lane & 15) ^ (2 * wid));
                const int so_ = CV_BASE + (cst % 3) * 16384 + wid * 2048;
                ATT_GLDS(gp_, so_); ATT_GLDS(gp_ + (gu_ ? 4 : 64) * ns_, so_ + 1024); ++cst; }
#pragma unroll
            for (int sub = 0; sub < 2; ++sub) {
                const int j = 2 * jp + sub, ko = kop + sub * KBUF;
                if (isB && j >= 1 && j - 1 <= myjmax && j - 1 < NT) ATT_PV(sub == 0 ? vprev + VBUF : vcur);
                if (j < NT && j <= myjmax) {
                    const LAS unsigned char* kb = lds + ko;
                    f32x16 p0, p1;
                    {   const v8i32 k00 = ATT_LD2(kb + koff[0][0], kb + koff[0][1]), k01 = ATT_LD2(kb + koff[0][0] + 4096, kb + koff[0][1] + 4096);
                        const v8i32 k10 = ATT_LD2(kb + koff[1][0], kb + koff[1][1]), k11 = ATT_LD2(kb + koff[1][0] + 4096, kb + koff[1][1] + 4096);
                        const v8i32 k20 = ATT_LD2(kb + poff[0], kb + poff[1]), k21 = ATT_LD2(kb + poff[0] + 2048, kb + poff[1] + 2048);
                        asm volatile("v_mfma_scale_f32_32x32x64_f8f6f4 %0, %1, %2, %3, %4, %5 op_sel_hi:[0,0,0]" : "=&v"(p0) : "v"(k00), "v"(qf[0]), "v"(negm), "v"(sclK), "v"(sclQ));
                        asm volatile("v_mfma_scale_f32_32x32x64_f8f6f4 %0, %1, %2, %3, %4, %5 op_sel_hi:[0,0,0]" : "=&v"(p1) : "v"(k01), "v"(qf[0]), "v"(negm), "v"(sclK), "v"(sclQ));
                        asm volatile("v_mfma_scale_f32_32x32x64_f8f6f4 %0, %1, %2, %0, %3, %4 op_sel_hi:[0,0,0]" : "+v"(p0) : "v"(k10), "v"(qf[1]), "v"(sclK), "v"(sclQ));
                        asm volatile("v_mfma_scale_f32_32x32x64_f8f6f4 %0, %1, %2, %0, %3, %4 op_sel_hi:[0,0,0]" : "+v"(p1) : "v"(k11), "v"(qf[1]), "v"(sclK), "v"(sclQ));
                        asm volatile("v_mfma_scale_f32_32x32x64_f8f6f4 %0, %1, %2, %0, %3, %4 op_sel_hi:[0,0,0]" : "+v"(p0) : "v"(k20), "v"(qf[2]), "v"(sclK), "v"(sclQ));
                        asm volatile("v_mfma_scale_f32_32x32x64_f8f6f4 %0, %1, %2, %0, %3, %4 op_sel_hi:[0,0,0]" : "+v"(p1) : "v"(k21), "v"(qf[2]), "v"(sclK), "v"(sclQ));
                    }
                    if (cvpend) CV_STORE();
                    asm volatile("s_nop 15\n\ts_nop 15" : "+v"(p0), "+v"(p1));
                    float mx;
                    { float ma = max3f(p0[0], p0[1], p1[0]), mb = max3f(p0[2], p0[3], p1[1]); ma = max3f(ma, p1[2], p1[3]);
    #pragma unroll
                        for (int r = 4; r < 16; r += 4) { ma = max3f(ma, p0[r], p0[r + 1]); mb = max3f(mb, p0[r + 2], p0[r + 3]); ma = max3f(ma, p1[r], p1[r + 1]); mb = max3f(mb, p1[r + 2], p1[r + 3]); }
                        mx = max3f(ma, mb, mb); }
                    mx = max3f(mx, __shfl_xor(mx, 32), mx);
                    if (j == 0) {
                        m = mx;
    #pragma unroll
                        for (int r = 0; r < 16; ++r) { p0[r] -= mx; p1[r] -= mx; negm[r] = -mx; }
                    } else if (__any(mx > ATT_THR)) {
                        const float dl = max3f(mx, 0.f, 0.f), alpha = __builtin_amdgcn_exp2f(-dl); m += dl; l *= alpha;
    #pragma unroll
                        for (int r = 0; r < 16; ++r) { p0[r] -= dl; p1[r] -= dl; negm[r] = -m; }
    #pragma unroll
                        for (int d = 0; d < 4; ++d)
    #pragma unroll
                            for (int r = 0; r < 16; ++r) o[d][r] *= alpha;
                    }
                    float ls = 0.f;
    #pragma unroll
                    for (int r = 0; r < 16; ++r) { p0[r] = __builtin_amdgcn_exp2f(p0[r]); p1[r] = __builtin_amdgcn_exp2f(p1[r]); ls += p0[r] + p1[r]; }
                    l += ls;
    #pragma unroll
                    for (int g4 = 0; g4 < 4; ++g4) {
                        pq[2 * g4] = (int)pk4_fp8(p0[4 * g4], p0[4 * g4 + 1], p0[4 * g4 + 2], p0[4 * g4 + 3]);
                        pq[2 * g4 + 1] = (int)pk4_fp8(p1[4 * g4], p1[4 * g4 + 1], p1[4 * g4 + 2], p1[4 * g4 + 3]); }
                    if (!isB) ATT_PV(vcur + sub * VBUF);
                }
            }
            if (cvpend) CV_STORE();
            vprev = vcur; vcur = vnext; vnext = (vnext == 2 * VPAIR) ? 0 : vnext + VPAIR;
            if (cvnow) asm volatile("s_waitcnt vmcnt(2)" ::: "memory");
            else asm volatile("s_waitcnt vmcnt(0)" ::: "memory");
            __syncthreads();
        }
#undef ATT_STAGE
#undef ATT_PV
#undef ATT_LD2
        l += __shfl_xor(l, 32);
        const float il = __builtin_amdgcn_rcpf(l);
        bf16_t* op = O + (size_t)(t0 + 32 * wid + i32) * D + h * 128 + 8 * hi;
#pragma unroll
        for (int d = 0; d < 4; ++d) {
            u32x2 wv[4];
#pragma unroll
            for (int g4 = 0; g4 < 4; ++g4) { wv[g4].x = pk2(o[d][4 * g4] * il, o[d][4 * g4 + 1] * il); wv[g4].y = pk2(o[d][4 * g4 + 2] * il, o[d][4 * g4 + 3] * il); }
#pragma unroll
            for (int k = 0; k < 4; k += 2) {
                const auto r0 = __builtin_amdgcn_permlane32_swap(wv[k].x, wv[k + 1].x, false, false), r1 = __builtin_amdgcn_permlane32_swap(wv[k].y, wv[k + 1].y, false, false);
                *(u32x4*)(op + 32 * d + 8 * k) = (u32x4){(unsigned)r0[0], (unsigned)r1[0], (unsigned)r0[1], (unsigned)r1[1]}; } }
    }
    asm volatile("s_waitcnt vmcnt(0)" ::: "memory");
    __syncthreads();
    while (cpr < cst) { CV_READ(); CV_STORE(); }
#undef CV_READ
#undef CV_LANE
#undef CV_STORE
#undef CV_DECODE
#undef ATT_GLDS
    if (trslot >= 3 || trslot >= nun) tr_range(a, lds, vcu, G, TR_EARLY + G * ncl, TR_NITEMS);
    __syncthreads();
}

__device__ __forceinline__ void p7_router(KArgP a, LAS unsigned char* lds, int vcu, int G) {
    const int tid = tid_fresh(), lane = tid & 63, wave = tid >> 6, rr = lane & 15, g = lane >> 4;
    const float* MOD = (const float*)(a->ws + WS_MOD); const bf16_t* X1 = (const bf16_t*)(a->ws + WS_X1B); bf16_t* H2 = (bf16_t*)(a->ws + WS_S0);
    int* TKI = (int*)(a->ws + WS_TKI); float* TKW = (float*)(a->ws + WS_TKW); int* RANK = (int*)(a->ws + WS_RANK); int* COUNTS = (int*)(a->ws + WS_COUNTS);
    LAS int* cnt = (LAS int*)(lds + 131072);
    __syncthreads();
    { const u32x4* src = (const u32x4*)(a->ws + WS_WR);
        for (int ch = tid; ch < 8192; ch += NTHREADS) { const int hl = ch >> 12, e = (ch >> 7) & 31, kc = ch & 127;
            *(LAS u32x4*)(lds + hl * 65536 + e * 2048 + ((kc ^ (e & 15)) << 4)) = src[ch]; } }
    for (int rb = vcu * 128; rb < T; rb += G * 128) {
        if (tid < 32) cnt[tid] = 0;
        __syncthreads();
        const int r0 = rb + wave * 16, b = rb >> 12, row = r0 + rr;
        const bf16_t* xr = X1 + (size_t)row * D + 16 * g;
        float ss;
        { const f32x4* pq = (const f32x4*)((const float*)(a->ws + WS_PSQX) + (size_t)row * 16); const f32x4 q0 = pq[0], q1 = pq[1], q2 = pq[2], q3 = pq[3];
            ss = (((q0[0] + q0[1]) + (q0[2] + q0[3])) + ((q1[0] + q1[1]) + (q1[2] + q1[3]))) + (((q2[0] + q2[1]) + (q2[2] + q2[3])) + ((q3[0] + q3[1]) + (q3[2] + q3[3]))); }
        const float rstd = rsqrtf(ss * (1.0f / D) + EPS);
        f32x4 acc0 = (f32x4){0.f, 0.f, 0.f, 0.f}, acc1 = acc0;
        LAS float* mgs = (LAS float*)(lds + 131072 + 1024); LAS float* msh = mgs + 1024;
        for (int i = tid; i < 1024; i += NTHREADS) { mgs[i] = a->in[I_GFFN][i] * (MOD[b * 6144 + 4 * 1024 + i] + 1.0f); msh[i] = MOD[b * 6144 + 3 * 1024 + i]; }
        __syncthreads();
#pragma unroll 1
        for (int sh_ = 0; sh_ < 2; ++sh_) {
        u32x4 xv[16]; u32x4 h2w = (u32x4){0u, 0u, 0u, 0u};
#pragma unroll
        for (int q = 0; q < 16; ++q) xv[q] = *(const u32x4*)(xr + 64 * (8 * sh_ + (q >> 1)) + 8 * (q & 1));
#pragma unroll
        for (int q = 0; q < 16; ++q) { const int s = 16 * sh_ + q;
            float xf[8]; unpack8(xv[q], xf); const f32x4 x0 = (f32x4){xf[0], xf[1], xf[2], xf[3]}, x1 = (f32x4){xf[4], xf[5], xf[6], xf[7]};
            const int c0_ = 64 * (s >> 1) + 16 * g + 8 * (s & 1);
            const LAS float* gp = mgs + c0_; const LAS float* sp = msh + c0_;
            const f32x4 h0 = x0 * rstd * *(const LAS f32x4*)gp + *(const LAS f32x4*)sp, h1 = x1 * rstd * *(const LAS f32x4*)(gp + 4) + *(const LAS f32x4*)(sp + 4);
            u32x4 hi; hi.x = pk2(h0[0], h0[1]); hi.y = pk2(h0[2], h0[3]); hi.z = pk2(h1[0], h1[1]); hi.w = pk2(h1[2], h1[3]);
            { const unsigned qa = pk4_fp8(h0[0], h0[1], h0[2], h0[3]), qb = pk4_fp8(h1[0], h1[1], h1[2], h1[3]);
                if (q & 1) { h2w.z = qa; h2w.w = qb; *(u32x4*)((unsigned char*)H2 + (size_t)row * D + 64 * (s >> 1) + 16 * g) = h2w; } else { h2w.x = qa; h2w.y = qb; } }
            float hf[8]; unpack8(hi, hf);
            u32x4 lo; lo.x = pk2(h0[0] - hf[0], h0[1] - hf[1]); lo.y = pk2(h0[2] - hf[2], h0[3] - hf[3]); lo.z = pk2(h1[0] - hf[4], h1[1] - hf[5]); lo.w = pk2(h1[2] - hf[6], h1[3] - hf[7]);
            const bf16x8 Ah = __builtin_bit_cast(bf16x8, hi), Al = __builtin_bit_cast(bf16x8, lo);
            const int kc = 8 * (s >> 1) + 2 * g + (s & 1);
            const bf16x8 Bh0 = *(const LAS bf16x8*)(lds + rr * 2048 + ((kc ^ rr) << 4)), Bh1 = *(const LAS bf16x8*)(lds + (16 + rr) * 2048 + ((kc ^ rr) << 4));
            const bf16x8 Bl0 = *(const LAS bf16x8*)(lds + 65536 + rr * 2048 + ((kc ^ rr) << 4)), Bl1 = *(const LAS bf16x8*)(lds + 65536 + (16 + rr) * 2048 + ((kc ^ rr) << 4));
            acc0 = __builtin_amdgcn_mfma_f32_16x16x32_bf16(Ah, Bh0, acc0, 0, 0, 0); acc0 = __builtin_amdgcn_mfma_f32_16x16x32_bf16(Al, Bh0, acc0, 0, 0, 0); acc0 = __builtin_amdgcn_mfma_f32_16x16x32_bf16(Ah, Bl0, acc0, 0, 0, 0);
            acc1 = __builtin_amdgcn_mfma_f32_16x16x32_bf16(Ah, Bh1, acc1, 0, 0, 0); acc1 = __builtin_amdgcn_mfma_f32_16x16x32_bf16(Al, Bh1, acc1, 0, 0, 0); acc1 = __builtin_amdgcn_mfma_f32_16x16x32_bf16(Ah, Bl1, acc1, 0, 0, 0);
        }
        }
        const float br0 = a->in[I_BR][rr], br1 = a->in[I_BR][16 + rr];
#pragma unroll
        for (int reg = 0; reg < 4; ++reg) {
            float v0 = acc0[reg] + br0, v1 = acc1[reg] + br1; float tv[4]; int ti[4];
#pragma unroll
            for (int k = 0; k < 4; ++k) {
                float bv = v0; int bi = rr; if (v1 > bv) { bv = v1; bi = 16 + rr; }
#pragma unroll
                for (int o = 1; o < 16; o <<= 1) { const float ov = __shfl_xor(bv, o); const int oi = __shfl_xor(bi, o); if (ov > bv || (ov == bv && oi < bi)) { bv = ov; bi = oi; } }
                tv[k] = bv; ti[k] = bi; if (bi == rr) v0 = -INFINITY; if (bi == 16 + rr) v1 = -INFINITY;
            }
            if (rr == 0) { const int t = r0 + 4 * g + reg;
                const float e1 = __expf(tv[1] - tv[0]), e2 = __expf(tv[2] - tv[0]), e3 = __expf(tv[3] - tv[0]), inv = 1.0f / (1.0f + e1 + e2 + e3);
                *(f32x4*)(TKW + (size_t)t * 4) = (f32x4){inv, e1 * inv, e2 * inv, e3 * inv};
                int rk[4];
#pragma unroll
                for (int k = 0; k < 4; ++k) rk[k] = __hip_atomic_fetch_add(cnt + ti[k], 1, __ATOMIC_RELAXED, __HIP_MEMORY_SCOPE_WORKGROUP);
                *(u32x4*)(TKI + (size_t)t * 4) = (u32x4){(unsigned)ti[0], (unsigned)ti[1], (unsigned)ti[2], (unsigned)ti[3]};
                *(u32x4*)(RANK + (size_t)t * 4) = (u32x4){(unsigned)rk[0], (unsigned)rk[1], (unsigned)rk[2], (unsigned)rk[3]}; }
        }
        __syncthreads();
        if (tid < 32) COUNTS[(rb >> 7) * 32 + tid] = cnt[tid];
        __syncthreads();
    }
}

__device__ __forceinline__ void p8_scatter(KArgP a, LAS unsigned char* lds, int vcu, int G) {
    const int tid = tid_fresh(), lane = tid & 63, wave = tid >> 6;
    const int* COUNTS = (const int*)(a->ws + WS_COUNTS); const int* TKI = (const int*)(a->ws + WS_TKI); const float* TKW = (const float*)(a->ws + WS_TKW); const int* RANK = (const int*)(a->ws + WS_RANK);
    int* SLOTROW = (int*)(a->ws + WS_SLOTROW); float* ROWW = (float*)(a->ws + WS_ROWW); int* TILEE = (int*)(a->ws + WS_TILEE);
    int* ROWTOK = (int*)(a->ws + WS_ROWTOK);
    LAS int* ptot = (LAS int*)lds;
    LAS int* pbef = ptot + 512;
    LAS int* base = pbef + 512;
    for (int rb = vcu * 128; rb < T; rb += G * 128) {
        const int blk = rb >> 7;
        __syncthreads();
        { const int e = tid & 31, pt = tid >> 5; int st = 0, sb = 0;
            for (int bb = pt * 16; bb < pt * 16 + 16; ++bb) { const int cv = COUNTS[bb * 32 + e]; st += cv; if (bb < blk) sb += cv; }
            ptot[pt * 32 + e] = st; pbef[pt * 32 + e] = sb; }
        __syncthreads();
        if (tid < 64) {
            const int e = tid & 31; int tot = 0, bef = 0;
#pragma unroll
            for (int pt = 0; pt < 16; ++pt) { tot += ptot[pt * 32 + e]; bef += pbef[pt * 32 + e]; }
            const int ntl = (tot + 255) >> 8; int inc = ntl << 8;
#pragma unroll
            for (int d = 1; d < 32; d <<= 1) { const int o = __shfl_up(inc, d, 32); if (e >= d) inc += o; }
            const int ps = inc - (ntl << 8);
            if (tid < 32) { base[e] = ps + bef;
                if (blk == 0) { for (int q = 0; q < ntl; ++q) TILEE[(ps >> 8) + q] = e;
                    if (e == 31) TILEE[1023] = inc >> 8; } } }
        __syncthreads();
        { const int t = rb + (tid >> 2), k = tid & 3;
            const int e = TKI[(size_t)t * 4 + k], dest = base[e] + RANK[(size_t)t * 4 + k];
            SLOTROW[(size_t)t * 4 + k] = dest; ROWW[dest] = TKW[(size_t)t * 4 + k]; ROWTOK[dest] = t; }
    }
    __syncthreads();
}

__device__ __forceinline__ void p11_final(KArgP a, int vcu, int G) {
    const int tid = tid_fresh(), lane = tid & 63, wave = tid >> 6;
    const float* MOD = (const float*)(a->ws + WS_MOD); const float* FMOD = (const float*)(a->ws + WS_FMOD); const int* SLOTROW = (const int*)(a->ws + WS_SLOTROW);
    const bf16_t* Y = (const bf16_t*)(a->ws + WS_XS); float* OUT = a->out; const bf16_t* X1 = (const bf16_t*)(a->ws + WS_X1B);
    for (int rb = vcu * 128; rb < T; rb += G * 128) {
        const int b = rb >> 12;
        f32x4 g2[4], gs[4], sh[4];
#pragma unroll
        for (int j = 0; j < 4; ++j) { const int c = 4 * lane + 256 * j; g2[j] = *(const f32x4*)(MOD + b * 6144 + 5 * 1024 + c) * (1.0f / YSCALE);
            gs[j] = *(const f32x4*)(a->in[I_GFIN] + c) * (*(const f32x4*)(FMOD + b * 2048 + 1024 + c) + 1.0f); sh[j] = *(const f32x4*)(FMOD + b * 2048 + c); }
        const int ywi = ((lane >> 3) & 3) * 16 + ((lane >> 1) & 3) * 4 + (lane >> 5) * 2 + (lane & 1);
        u32x4 srl = (u32x4){0u, 0u, 0u, 0u};
        if (lane < 16) srl = *(const u32x4*)(SLOTROW + (size_t)(rb + wave * 16 + lane) * 4);
#pragma unroll 1
        for (int i0 = 0; i0 < 16; i0 += 2) {
            int yw[2][4][4]; u32x2 xw[2][4];
#pragma unroll
            for (int q = 0; q < 2; ++q) { const int t = rb + wave * 16 + i0 + q; const u32x2* x1r = (const u32x2*)(X1 + (size_t)t * D) + lane;
                unsigned sr[4];
#pragma unroll
                for (int k = 0; k < 4; ++k) sr[k] = (unsigned)__builtin_amdgcn_readlane((int)srl[k], i0 + q);
#pragma unroll
                for (int j = 0; j < 4; ++j) {
#pragma unroll
                    for (int k = 0; k < 4; ++k) yw[q][j][k] = *((const int*)((const unsigned char*)Y + (size_t)sr[k] * D) + ywi + 64 * j);
                    xw[q][j] = x1r[64 * j]; } }
#pragma unroll
            for (int q = 0; q < 2; ++q) { const int t = rb + wave * 16 + i0 + q; f32x4* xr = (f32x4*)(OUT + (size_t)t * D) + lane; f32x4 v[4]; float s = 0.f;
#pragma unroll
                for (int j = 0; j < 4; ++j) { f32x4 mo = (f32x4){0.f, 0.f, 0.f, 0.f};
#pragma unroll
                    for (int k = 0; k < 4; ++k) { const int w = yw[q][j][k]; const f32x2 lo = __builtin_amdgcn_cvt_pk_f32_fp8(w, false), hi2 = __builtin_amdgcn_cvt_pk_f32_fp8(w, true);
                        mo[0] += lo.x; mo[1] += lo.y; mo[2] += hi2.x; mo[3] += hi2.y; }
                    v[j] = (f32x4){bflo(xw[q][j].x), bfhi(xw[q][j].x), bflo(xw[q][j].y), bfhi(xw[q][j].y)} + g2[j] * mo; s += (v[j][0] * v[j][0] + v[j][1] * v[j][1]) + (v[j][2] * v[j][2] + v[j][3] * v[j][3]); }
                const float rstd = rsqrtf(wave_sum(s) * (1.0f / D) + EPS);
#pragma unroll
                for (int j = 0; j < 4; ++j) __builtin_nontemporal_store(v[j] * rstd * gs[j] + sh[j], xr + 64 * j); } }
    }
}

#define RLX_AGENT __ATOMIC_RELAXED, __HIP_MEMORY_SCOPE_AGENT
#define XB_TMO      128
#define XB_XCNT(j)  (256  + 64 * (j))
#define XB_XSUB(j)  (1280 + 64 * (j))
#define XB_XGEN(j)  (2304 + 64 * (j))
#define XB_TOP      3328
#define XB_TOPGEN   3392
#define XCD_BAR_WORDS 3456
#define XB_SPIN_CAP (1u << 18)
__device__ __forceinline__ unsigned xb_ld(unsigned* p)              { return __hip_atomic_load(p, __ATOMIC_RELAXED, __HIP_MEMORY_SCOPE_AGENT); }
__device__ __forceinline__ unsigned xb_add(unsigned* p, unsigned v) { return __hip_atomic_fetch_add(p, v, __ATOMIC_RELAXED, __HIP_MEMORY_SCOPE_AGENT); }
__device__ __forceinline__ unsigned xb_xcc_id() { return (unsigned)__builtin_amdgcn_s_getreg((3 << 11) | 20) & 0xFu; }
#define XB_SPIN(cond, bar) do { unsigned _sp = 0; while (cond) { __builtin_amdgcn_s_sleep(1); \
    if ((++_sp & 255u) == 0u) { if (xb_ld(&(bar)[XB_TMO])) break; if (_sp > XB_SPIN_CAP) { atomicAdd(&(bar)[XB_TMO], 1u); break; } } } } while (0)
struct XcdBarrier { unsigned* bar; unsigned x; volatile LAS unsigned* st; };
__device__ __forceinline__ XcdBarrier xcd_barrier_post(unsigned* bar, volatile LAS unsigned* st) {
    XcdBarrier b; b.bar = bar; b.x = xb_xcc_id(); b.st = st;
    if (threadIdx.x == 0) (void)xb_add(&bar[XB_XCNT(b.x)], 1u);
    return b;
}
__device__ __forceinline__ void xcd_barrier_complete(unsigned* bar, unsigned x, unsigned& nloc, unsigned& nx) {
    const unsigned G = gridDim.x * gridDim.y * gridDim.z;
    unsigned sum, cnt, mine, sp = 0u;
    for (;;) {
        sum = 0u; cnt = 0u; mine = 0u;
#pragma unroll
        for (unsigned j = 0; j < 16; ++j) { const unsigned c = xb_ld(&bar[XB_XCNT(j)]); sum += c; cnt += (c > 0u) ? 1u : 0u; mine = (j == x) ? c : mine; }
        if (sum == G) break;
        __builtin_amdgcn_s_sleep(1);
        if ((++sp & 255u) == 0u) { if (xb_ld(&bar[XB_TMO])) break; if (sp > XB_SPIN_CAP) { atomicAdd(&bar[XB_TMO], 1u); break; } }
    }
    nloc = mine > 0u ? mine : 1u; nx = cnt > 0u ? cnt : 1u;
}
__device__ __forceinline__ void xcd_barrier(const XcdBarrier& b) {
    asm volatile("s_waitcnt vmcnt(0)" ::: "memory");
    __syncthreads();
    if (threadIdx.x == 0) {
        unsigned* bar = b.bar;
        __builtin_amdgcn_s_waitcnt(0);
        unsigned nloc = b.st[0], nx = b.st[1];
        if (nloc == 0u) { xcd_barrier_complete(bar, b.x, nloc, nx); b.st[0] = nloc; b.st[1] = nx; }
        const unsigned old = xb_add(&bar[XB_XSUB(b.x)], 1u);
        const unsigned gen = old / nloc;
        if (old + 1u == (gen + 1u) * nloc) {
            __builtin_amdgcn_fence(__ATOMIC_RELEASE, "agent");
            asm volatile("s_waitcnt vmcnt(0)" ::: "memory");
            const unsigned og = xb_add(&bar[XB_TOP], 1u);
            const unsigned tg = og / nx;
            if (og + 1u == (tg + 1u) * nx) xb_add(&bar[XB_TOPGEN], 1u);
            else XB_SPIN(xb_ld(&bar[XB_TOPGEN]) == tg, bar);
            __builtin_amdgcn_fence(__ATOMIC_ACQUIRE, "agent");
            xb_add(&bar[XB_XGEN(b.x)], 1u);
            asm volatile("s_waitcnt vmcnt(0)" ::: "memory");
        } else {
            XB_SPIN(xb_ld(&bar[XB_XGEN(b.x)]) == gen, bar);
            __builtin_amdgcn_fence(__ATOMIC_ACQUIRE, "agent");
            asm volatile("s_waitcnt vmcnt(0)" ::: "memory");
        }
    }
    __syncthreads();
}

__global__ void __launch_bounds__(NTHREADS, 2) mk_fwd(Args a_) {
    extern __shared__ __attribute__((aligned(16))) unsigned char lds_raw[];
    LAS unsigned char* lds = (LAS unsigned char*)lds_raw;
    const int G = gridDim.x, bx = blockIdx.x; const int vcu = (G % 8 == 0) ? (bx % 8) * (G / 8) + bx / 8 : bx;
    KArgP a = (KArgP)__builtin_amdgcn_kernarg_segment_ptr();
    const int lo = a->ph_lo, hi = a->ph_hi;
    volatile LAS unsigned* misc = (volatile LAS unsigned*)(lds + LDS_BYTES - 64);
    if (threadIdx.x < 16) misc[threadIdx.x] = 0u;
    __syncthreads();
    XcdBarrier xbar; xbar.bar = (unsigned*)a->ws + 1024; xbar.x = 0; xbar.st = misc;
#if ONE_LAUNCH
    xbar = xcd_barrier_post((unsigned*)a->ws + 1024, misc);
    if (lo < 0) cg::this_grid().sync();
#endif
#define PHASE_ARGS() asm volatile("" : "+s"(a)); unsigned char* ws = a->ws; (void)ws
#ifndef REPEAT_MASK
#define REPEAT_MASK 0
#endif
#define REPS(k) ((((REPEAT_MASK) >> (k)) & 1) ? 2 : 1)
#ifndef PHASE_MASK
#define PHASE_MASK 0xFFF
#endif
#define IN(k) ((((PHASE_MASK) >> (k)) & 1) && lo <= (k) && (k) < hi)
#if ONE_LAUNCH
#ifndef SYNC_REPEAT
#define SYNC_REPEAT 1
#endif
#define SEAM(k) do { if (IN(k) && IN((k) + 1)) { for (int _r = 0; _r < SYNC_REPEAT; ++_r) { xcd_barrier(xbar); } } } while (0)
#else
#define SEAM(k) do { } while (0)
#endif
    for (int _rep = 0; _rep < REPS(0); ++_rep) if (IN(0)) { PHASE_ARGS(); p0_prep(a, lds, vcu, G); } SEAM(0);
    for (int _rep = 0; _rep < REPS(1); ++_rep) if (IN(1)) { PHASE_ARGS(); p1_hb(a, vcu, G); } SEAM(1);
    for (int _rep = 0; _rep < REPS(2); ++_rep) if (IN(2)) { PHASE_ARGS();
        EpiIn E{(bf16_t*)(ws + WS_S1), (bf16_t*)(ws + WS_QLAT), (bf16_t*)(ws + WS_KVLAT), (bf16_t*)(ws + WS_KPE), (bf16_t*)(ws + WS_GATES), (float*)(ws + WS_PSQQ), (float*)(ws + WS_PSQKV), a->in[I_BGATE], (const f32x2*)(ws + WS_CS), 0};
        { Gemm g{(const bf16_t*)(ws + WS_HB8), (const bf16_t*)(ws + WS_WIN8), D, D, D, nullptr, SCALE_ONE, SCALE_W8}; DenseSched S; S.init(T / 256, 16, G, bx, D, D, 0, 1);
            gemm_phase<EpiIn, DenseSched, false, true>(lds, g, S, E); }
    } SEAM(2);
    for (int _rep = 0; _rep < REPS(3); ++_rep) if (IN(3)) { PHASE_ARGS();
        for (int _q = 0; _q < ((P3REP & 1) ? 2 : 1); ++_q) p3_kpe(a, lds, vcu, G);
        for (int _q = 0; _q < ((P3REP & 2) ? 2 : 1); ++_q) p3_mixed(a, vcu, G);
        { Gemm g{(const bf16_t*)(ws + WS_QLAT), (const bf16_t*)(ws + WS_WQ), QL, QL, QL, nullptr, SCALE_ONE, SCALE_W8}; DenseSched S; S.init(T / 256, 6, G, bx, QL, QL, 0, 1);
            EpiQ E{(bf16_t*)(ws + WS_Q), (const float*)(ws + WS_PSQQ), (const f32x2*)(ws + WS_CS)}; for (int _q = 0; _q < ((P3REP & 4) ? 2 : 1); ++_q) gemm_phase<EpiQ, DenseSched, false, true>(lds, g, S, E); }
        { Gemm g{(const bf16_t*)(ws + WS_KVLAT), (const bf16_t*)(ws + WS_WK), KVL, KVL, KVL, nullptr, SCALE_ONE, SCALE_W8}; DenseSched S; S.init(T / 256, 4, G, bx, KVL, KVL, 0, 1);
            EpiK E{(bf16_t*)(ws + WS_KN), (const float*)(ws + WS_PSQKV)}; for (int _q = 0; _q < ((P3REP & 8) ? 2 : 1); ++_q) gemm_phase<EpiK, DenseSched, false, true>(lds, g, S, E); }
        { Gemm g{(const bf16_t*)(ws + WS_WV), (const bf16_t*)(ws + WS_KVLAT), KVL, KVL, KVL, nullptr, SCALE_W8, SCALE_ONE}; DenseSched S; S.init(4, T / 256, G, bx, KVL, KVL, 0, 1);
            EpiVT E{(bf16_t*)(ws + WS_VT), (const float*)(ws + WS_PSQKV)}; for (int _q = 0; _q < ((P3REP & 16) ? 2 : 1); ++_q) gemm_phase<EpiVT, DenseSched, false, true>(lds, g, S, E); }
    } SEAM(3);
    for (int _rep = 0; _rep < REPS(4); ++_rep) if (IN(4)) { PHASE_ARGS();
        attn_fast(a, lds, vcu, G);
    } SEAM(4);
    for (int _rep = 0; _rep < REPS(5); ++_rep) if (IN(5)) { PHASE_ARGS();
        DualSched S; S.B.init(T / 256, 4, G, bx, D, D, 0); S.a2 = (unsigned)(WS_O - WS_S0); S.b2 = (unsigned)(WS_WMO - WS_WPO);
        Gemm g{(const bf16_t*)(ws + WS_S0), (const bf16_t*)(ws + WS_WPO), D, D, D, nullptr, 0, 0}; EpiMergeDual E{(bf16_t*)(ws + WS_S1), (const bf16_t*)(ws + WS_GATES)}; gemm_phase(lds, g, S, E);
    } SEAM(5);
    for (int _rep = 0; _rep < REPS(6); ++_rep) if (IN(6)) { PHASE_ARGS();
        Gemm g{(const bf16_t*)(ws + WS_S1), (const bf16_t*)(ws + WS_WOUT), D, D, D, nullptr, 0, 0}; DenseSched S; S.init(T / 256, 4, G, bx, D, D, 0);
        EpiOut E{a->in[I_X], (bf16_t*)(ws + WS_X1B), (const float*)(ws + WS_MOD), (float*)(ws + WS_PSQX)}; gemm_phase(lds, g, S, E);
    } SEAM(6);
    for (int _rep = 0; _rep < REPS(7); ++_rep) if (IN(7)) { PHASE_ARGS(); p7_router(a, lds, vcu, G); } SEAM(7);
    for (int _rep = 0; _rep < REPS(8); ++_rep) if (IN(8)) { PHASE_ARGS(); p8_scatter(a, lds, vcu, G); } SEAM(8);
    for (int _rep = 0; _rep < REPS(9); ++_rep) if (IN(9)) { PHASE_ARGS();
        Gemm g{(const bf16_t*)(ws + WS_S0), (const bf16_t*)(ws + WS_WGU), D, D, D, (const int*)(ws + WS_ROWTOK), SCALE_ONE, SCALE_W8}; MoeSched S; S.init(moe_table_to_lds((const int*)(ws + WS_TILEE), lds), 8, G, bx, D, D, 1);
        EpiGU E{(bf16_t*)(ws + WS_ACT), a->in[I_BGU]}; gemm_phase<EpiGU, MoeSched, true, true>(lds, g, S, E, SKEW_MOE);
    } SEAM(9);
    for (int _rep = 0; _rep < REPS(10); ++_rep) if (IN(10)) { PHASE_ARGS();
        Gemm g{(const bf16_t*)(ws + WS_ACT), (const bf16_t*)(ws + WS_WDN), D, D, D, nullptr, SCALE_ONE, SCALE_W8}; MoeSched S; S.init(moe_table_to_lds((const int*)(ws + WS_TILEE), lds), 4, G, bx, D, D, 1);
        EpiDown E{(bf16_t*)(ws + WS_XS), a->in[I_BDN], (const float*)(ws + WS_ROWW)}; gemm_phase<EpiDown, MoeSched, false, true>(lds, g, S, E, SKEW_MOE);
    } SEAM(10);
    for (int _rep = 0; _rep < REPS(11); ++_rep) if (IN(11)) { PHASE_ARGS(); p11_final(a, vcu, G); }
#undef IN
#undef SEAM
}

constexpr int NPHASES = 12;
extern "C" void kernel_launch(void* const* d_in, const int* in_sizes, int n_in, void* d_out, int out_size, void* d_ws, size_t ws_size, hipStream_t stream) {
    static int grid = 0;
    if (grid == 0) {
        if (n_in != 27 || out_size != T * D || ws_size < WS_END) { fprintf(stderr, "kernel_launch: unexpected problem (n_in %d out %d ws %zu)\n", n_in, out_size, ws_size); grid = -1; return; }
        int dev = 0, cus = 0, per_cu = 0;
        hipGetDevice(&dev); hipDeviceGetAttribute(&cus, hipDeviceAttributeMultiprocessorCount, dev);
        hipFuncSetAttribute((const void*)mk_fwd, hipFuncAttributeMaxDynamicSharedMemorySize, LDS_BYTES);
        hipOccupancyMaxActiveBlocksPerMultiprocessor(&per_cu, (const void*)mk_fwd, NTHREADS, LDS_BYTES);
        (void)hipGetLastError();
        if (per_cu < 1) { fprintf(stderr, "kernel_launch: occupancy query says %d blocks per CU\n", per_cu); per_cu = 1; }
        grid = cus;
    }
    if (grid < 0) return;
    Args a{};
    for (int i = 0; i < 27; ++i) a.in[i] = (const float*)d_in[i];
    a.out = (float*)d_out; a.ws = (unsigned char*)d_ws;
#if ONE_LAUNCH
    if (hipMemsetAsync(d_ws, 0, 65536, stream) != hipSuccess) { fprintf(stderr, "kernel_launch: memset of the barrier words failed\n"); return; }
    a.ph_lo = 0; a.ph_hi = NPHASES;
    void* args[] = {&a};
    hipError_t e = hipLaunchCooperativeKernel((const void*)mk_fwd, dim3(grid), dim3(NTHREADS), args, LDS_BYTES, stream);
    if (e != hipSuccess) fprintf(stderr, "cooperative launch failed: %s (grid %d)\n", hipGetErrorString(e), grid);
#else
    for (int p = 0; p < NPHASES; ++p) { a.ph_lo = p; a.ph_hi = p + 1; hipLaunchKernelGGL(mk_fwd, dim3(grid), dim3(NTHREADS), LDS_BYTES, stream, a); }
#endif
}
```

```cpp
#include <hip/hip_runtime.h>
#include <hip/hip_cooperative_groups.h>
#include <cstdio>
#include <cstdint>
namespace cg = cooperative_groups;

#ifndef ONE_LAUNCH
#define ONE_LAUNCH 1
#endif
#ifndef FAST_GEMM
#define FAST_GEMM 1
#endif
#ifndef EPI_REPEAT
#define EPI_REPEAT 1
#endif
#ifndef P3REP
#define P3REP 0
#endif
#ifndef SKEW_MOE
#define SKEW_MOE 0
#endif

#define LAS __attribute__((address_space(3)))
typedef unsigned short bf16_t;
typedef short bf16x8 __attribute__((ext_vector_type(8)));
typedef float f32x4 __attribute__((ext_vector_type(4)));
typedef float f32x2 __attribute__((ext_vector_type(2)));
typedef unsigned u32x4 __attribute__((ext_vector_type(4)));
typedef unsigned u32x2 __attribute__((ext_vector_type(2)));
typedef __bf16 bf16x2_t __attribute__((ext_vector_type(2)));
typedef int v4i32 __attribute__((ext_vector_type(4)));
typedef int v8i32 __attribute__((ext_vector_type(8)));

constexpr int D = 1024, NB = 8, SEQ = 4096, T = NB * SEQ;
constexpr int QL = 768, KVL = 256, ROPE = 64, NH = 8, NOPE = 128, VH = 128, QKD = NOPE + ROPE;
constexpr int IN_W = 4160, INP = 4096;
constexpr int NE = 32, TOPK = 4, DE = 1024;
constexpr int NSLOT = T * TOPK;
constexpr int RT_MAX = 543;
constexpr float EPS = 1e-6f;
constexpr float W8SCALE = 64.0f;
constexpr float Q8SCALE = 16.0f;
constexpr int SCALE_Q8 = 0x7b7b7b7b;
constexpr float GUC = 1.702f * 1.4426950408889634f, GUCI = 1.0f / GUC;
constexpr float YSCALE = 16.0f;
constexpr int SCALE_ONE = 0x7f7f7f7f, SCALE_W8 = 0x79797979;
constexpr float QSCALE = 0.07216878364870322f * 1.4426950408889634f;

constexpr size_t MiB = 1u << 20;
constexpr size_t WS_MOD = 1 * MiB;
constexpr size_t WS_FMOD = 1 * MiB + 256 * 1024;
constexpr size_t WS_CS = 2 * MiB;
constexpr size_t WS_PSQQ = 10 * MiB;
constexpr size_t WS_PSQKV = 12 * MiB;
constexpr size_t WS_TKI = 13 * MiB;
constexpr size_t WS_TKW = 13 * MiB + 512 * 1024;
constexpr size_t WS_RANK = 14 * MiB;
constexpr size_t WS_SLOTROW = 14 * MiB + 512 * 1024;
constexpr size_t WS_COUNTS = 15 * MiB;
constexpr size_t WS_ROWW = 16 * MiB;
constexpr size_t WS_TILEE = 17 * MiB;
constexpr size_t WS_ROWTOK = 19 * MiB;
constexpr size_t WS_WIN8 = 22 * MiB;
constexpr size_t WS_HB8 = 864 * MiB;
constexpr size_t WS_X1B = 456 * MiB;
constexpr size_t WS_PSQX = 26 * MiB;
constexpr size_t WS_WKPE = 20 * MiB;
constexpr size_t WS_WR = 18 * MiB;
constexpr size_t WS_WIN = 32 * MiB;
constexpr size_t WS_WQ = 41 * MiB;
constexpr size_t WS_WK = 44 * MiB;
constexpr size_t WS_WV = 45 * MiB;
constexpr size_t WS_WGRP = 46 * MiB;
constexpr size_t WS_WPO = 47 * MiB;
constexpr size_t WS_WMO = 49 * MiB;
constexpr size_t WS_WOUT = 51 * MiB;
constexpr size_t WS_WGU = 54 * MiB;
constexpr size_t WS_WDN = 182 * MiB;
constexpr size_t WS_S0 = 256 * MiB;
constexpr size_t WS_S1 = 320 * MiB;
constexpr size_t WS_QLAT = 384 * MiB;
constexpr size_t WS_KVLAT = 432 * MiB;
constexpr size_t WS_KPE = 448 * MiB;
constexpr size_t WS_GATES = 452 * MiB;
constexpr size_t WS_Q = 580 * MiB;
constexpr size_t WS_KN = 676 * MiB;
constexpr size_t WS_VT = 740 * MiB;
constexpr size_t WS_O = 804 * MiB;
constexpr size_t WS_XS = 320 * MiB;
constexpr size_t WS_ACT = 592 * MiB;
constexpr size_t WS_END = 896 * MiB;

constexpr int LDS_BYTES = 148480;
constexpr int NTHREADS = 512;

__device__ __forceinline__ unsigned pk2(float lo, float hi) { f32x2 v = {lo, hi}; bf16x2_t b = __builtin_convertvector(v, bf16x2_t); return __builtin_bit_cast(unsigned, b); }
__device__ __forceinline__ float bflo(unsigned u) { return __uint_as_float(u << 16); }
__device__ __forceinline__ float bfhi(unsigned u) { return __uint_as_float(u & 0xffff0000u); }
__device__ __forceinline__ void unpack8(const u32x4 w, float (&f)[8]) { f[0] = bflo(w.x); f[1] = bfhi(w.x); f[2] = bflo(w.y); f[3] = bfhi(w.y); f[4] = bflo(w.z); f[5] = bfhi(w.z); f[6] = bflo(w.w); f[7] = bfhi(w.w); }
__device__ __forceinline__ u32x4 pack8(const float (&f)[8]) { u32x4 w; w.x = pk2(f[0], f[1]); w.y = pk2(f[2], f[3]); w.z = pk2(f[4], f[5]); w.w = pk2(f[6], f[7]); return w; }
__device__ __forceinline__ unsigned pk4_fp8(float a, float b, float c, float d) { int w = 0; w = __builtin_amdgcn_cvt_pk_fp8_f32(a, b, w, false); w = __builtin_amdgcn_cvt_pk_fp8_f32(c, d, w, true); return (unsigned)w; }
__device__ __forceinline__ float wave_sum(float v) {
#pragma unroll
    for (int o = 1; o < 64; o <<= 1) v += __shfl_xor(v, o);
    return v;
}
__device__ __forceinline__ int tid_fresh() { int t = threadIdx.x; asm volatile("" : "+v"(t)); return t; }
__device__ __forceinline__ float sigmoidf_(float x) { return __builtin_amdgcn_rcpf(1.0f + __builtin_amdgcn_exp2f(-1.4426950408889634f * x)); }

struct Args {
    const float* in[27]; float* out; unsigned char* ws; int ph_lo, ph_hi;
};
typedef const Args __attribute__((address_space(4)))* KArgP;
enum { I_X = 0, I_C, I_POS, I_WMOD, I_BMOD, I_GMIX, I_WIN, I_BGATE, I_WPG, I_PSCALE, I_WPO, I_GQA, I_WQB, I_GKVA, I_WKVB, I_WMO, I_WOUT, I_GFFN, I_WR, I_BR, I_WGU, I_BGU, I_WDN, I_BDN, I_GFIN, I_WFMOD, I_BFMOD };

struct Unit { int pm, pn, e; unsigned ao, bo; };
struct Gemm { const bf16_t* A; const bf16_t* Bt; int lda, ldb, K; const int* gather; int scaleA, scaleB; };
constexpr int NXCD = 8, WGM = 8;
__host__ __device__ __forceinline__ int perm32(int rho) { const int n = rho >> 4, i = rho & 15; return 8 * (i >> 2) + 4 * n + (i & 3); }

struct DenseSched {
    int nM, nN, nwg, G, c; unsigned a_tile, a_col, b_tile;
    __device__ void init(int nM_, int nN_, int G_, int c_, int lda, int ldb, unsigned a_col_, int eb = 2) { nM = nM_; nN = nN_; nwg = nM * nN; G = G_; c = c_; a_tile = 256u * lda * eb; b_tile = 256u * ldb * eb; a_col = a_col_; }
    __device__ bool next(int i, Unit& u) const {
        const long L = (long)i * G + c; if (L >= nwg) return false;
        int wgid = (int)L; { const int q = nwg / NXCD, r = nwg % NXCD, xcd = wgid % NXCD, off = wgid / NXCD; wgid = (xcd < r ? xcd * (q + 1) : r * (q + 1) + (xcd - r) * q) + off; }
        const int nig = WGM * nN, gid = wgid / nig, fm = gid * WGM, gsz = (nM - fm) < WGM ? (nM - fm) : WGM;
        u.pm = fm + ((wgid % nig) % gsz); u.pn = (wgid % nig) / gsz; u.e = 0;
        u.ao = (unsigned)u.pm * a_tile + (unsigned)u.pn * a_col; u.bo = (unsigned)u.pn * b_tile; return true;
    }
};
struct MoeSched {
    const LAS int* tile_e; int R, NT, G, c; unsigned a_tile, b_tile;
    __device__ void init(const LAS int* te, int NT_, int G_, int c_, int lda, int ldb, int eb) { tile_e = te; R = te[1023]; NT = NT_; G = G_; c = c_; a_tile = 256u * lda * eb; b_tile = 256u * ldb * eb; }
    __device__ bool next(int i, Unit& u) const {
        int rt, pn;
        if (G == 256) { const int x = c & 7, j = c >> 3, rpr = 256 / NT, pxc = rpr / 8; rt = i * rpr + x * pxc + j / NT; pn = j % NT; }
        else { const long L = (long)i * G + c; rt = (int)(L / NT); pn = (int)(L % NT); }
        if (rt >= R) return false;
        const int e = tile_e[rt];
        u.pm = rt; u.pn = pn; u.e = e; u.ao = (unsigned)rt * a_tile; u.bo = (unsigned)(e * NT + pn) * b_tile; return true;
    }
};
__device__ __forceinline__ const LAS int* moe_table_to_lds(const int* tile_e, LAS unsigned char* lds) {
    LAS int* t = (LAS int*)(lds + 131072 + 1024);
    for (int i = threadIdx.x; i < 1023; i += NTHREADS) t[i] = tile_e[i] & 31;
    if (threadIdx.x == 0) t[1023] = tile_e[1023];
    __syncthreads();
    return t;
}
struct DualSched {
    DenseSched B; unsigned a2, b2;
    __device__ bool next(int i, Unit& u) const { if (!B.next(i >> 1, u)) return false; if (i & 1) { u.ao += a2; u.bo += b2; u.e = 0; } else u.e = 1; return true; }
};
template <class Base> struct DupSched {
    Base B;
    __device__ bool next(int i, Unit& u) const { const bool r = B.next(i >> 1, u); if (!(i & 1)) u.e = -1; return r; }
};
struct NoPre {};
struct NoCtx {};
struct Ctx8 { float s[8]; };
__device__ __forceinline__ Ctx8 load8f(const float* p) { const f32x4 a = *(const f32x4*)p, b = *(const f32x4*)(p + 4); Ctx8 c; c.s[0] = a[0]; c.s[1] = a[1]; c.s[2] = a[2]; c.s[3] = a[3]; c.s[4] = b[0]; c.s[5] = b[1]; c.s[6] = b[2]; c.s[7] = b[3]; return c; }
__device__ __forceinline__ Ctx8 load8f_lds(const LAS float* p) { const f32x4 a = *(const LAS f32x4*)p, b = *(const LAS f32x4*)(p + 4); Ctx8 c; c.s[0] = a[0]; c.s[1] = a[1]; c.s[2] = a[2]; c.s[3] = a[3]; c.s[4] = b[0]; c.s[5] = b[1]; c.s[6] = b[2]; c.s[7] = b[3]; return c; }
template <class E, class = void> struct EpiPaired { static constexpr bool value = false; };
template <class E> struct EpiPaired<E, decltype((void)E::PAIRED)> { static constexpr bool value = E::PAIRED; };
template <class Epi, bool BI = false>
__device__ __forceinline__ void run_epi(const Epi& E, const f32x4 (&acc)[2][2][4][2], const Unit& u, int wr, int wc, int fr, int fq, const LAS float* bslot = nullptr) {
    const int col0 = wc * 32 + 8 * fq, rowb = u.pm * 256 + wr * 64 + fr;
    if constexpr (Epi::COLMAJOR) {
#pragma unroll
        for (int bj = 0; bj < 2; ++bj) {
            const int col = bj * 128 + col0;
            const typename Epi::ColCtx cc = E.col_ctx(u, col);
            asm volatile("" ::: "memory");
#pragma unroll
            for (int ai = 0; ai < 2; ++ai)
#pragma unroll
                for (int m = 0; m < 4; ++m) {
                    float v[8];
#pragma unroll
                    for (int j = 0; j < 4; ++j) { v[j] = acc[ai][bj][m][0][j]; v[4 + j] = acc[ai][bj][m][1][j]; }
                    E.template apply<false>(u, rowb + ai * 128 + m * 16, col, v, 0.f, cc, NoPre{});
                }
            asm volatile("" ::: "memory");
        }
    } else {
        typename Epi::ColCtx cc[2];
        if constexpr (BI) { cc[0] = typename Epi::ColCtx{}; cc[1] = typename Epi::ColCtx{}; }
        else if constexpr (Epi::LDSBIAS) { if (bslot) { cc[0] = load8f_lds(bslot + col0); cc[1] = load8f_lds(bslot + 128 + col0); } else { cc[0] = E.col_ctx(u, col0); cc[1] = E.col_ctx(u, 128 + col0); } }
        else { cc[0] = E.col_ctx(u, col0); cc[1] = E.col_ctx(u, 128 + col0); }
        const bool wp = Epi::SUMSQ && E.want_partial(u);
        constexpr int DP = Epi::PRE_DEPTH, NS = DP + 1;
        typename Epi::RowPre rp[NS]; typename Epi::Pre pp[NS][2];
#define EPI_ROW(r_) (rowb + ((r_) >> 2) * 128 + ((r_) & 3) * 16)
#pragma unroll
        for (int r = 0; r < DP; ++r) { rp[r] = E.row_pre(u, EPI_ROW(r)); pp[r][0] = E.pre(u, EPI_ROW(r), col0); pp[r][1] = E.pre(u, EPI_ROW(r), 128 + col0); }
        asm volatile("" ::: "memory");
#pragma unroll
        for (int r = 0; r < 8; ++r) {
            const int ai = r >> 2, m = r & 3, row = EPI_ROW(r);
            if (r + DP < 8) { const int rn = EPI_ROW(r + DP);
                rp[(r + DP) % NS] = E.row_pre(u, rn); pp[(r + DP) % NS][0] = E.pre(u, rn, col0); pp[(r + DP) % NS][1] = E.pre(u, rn, 128 + col0); }
            asm volatile("" ::: "memory");
            const float rc = E.row_ctx(rp[r % NS]); float part = 0.f;
            if constexpr (EpiPaired<Epi>::value) {
                float v0[8], v1[8];
#pragma unroll
                for (int j = 0; j < 4; ++j) { v0[j] = acc[ai][0][m][0][j]; v0[4 + j] = acc[ai][0][m][1][j]; v1[j] = acc[ai][1][m][0][j]; v1[4 + j] = acc[ai][1][m][1][j]; }
                E.apply2(u, row, col0, v0, v1, rc);
            } else
#pragma unroll
            for (int bj = 0; bj < 2; ++bj) {
                float v[8];
#pragma unroll
                for (int j = 0; j < 4; ++j) { v[j] = acc[ai][bj][m][0][j]; v[4 + j] = acc[ai][bj][m][1][j]; }
                part += E.template apply<BI>(u, row, bj * 128 + col0, v, rc, cc[bj], pp[r % NS][bj]);
            }
            if constexpr (Epi::SUMSQ) { if (wp) { float sq = part; sq += __shfl_xor(sq, 16); sq += __shfl_xor(sq, 32); if (fq == 0) E.partial(u, row, wc, sq); } }
            asm volatile("" ::: "memory");
        }
#undef EPI_ROW
    }
}

template <class Epi>
__device__ __forceinline__ void run_mid(const Epi& E, f32x4 (&acc)[2][2][4][2], const Unit& u, int wr, int wc, int fr, int fq) {
    const int col0 = wc * 32 + 8 * fq, rowb = u.pm * 256 + wr * 64 + fr;
    u32x4 ga[3][2], gb[3][2];
#define EPI_ROW(r_) (rowb + ((r_) >> 2) * 128 + ((r_) & 3) * 16)
#pragma unroll
    for (int r = 0; r < 2; ++r)
#pragma unroll
        for (int bj = 0; bj < 2; ++bj) E.load_gates(u, EPI_ROW(r), bj * 128 + col0, ga[r][bj], gb[r][bj]);
    asm volatile("" ::: "memory");
#pragma unroll
    for (int r = 0; r < 8; ++r) {
        const int ai = r >> 2, m = r & 3;
        if (r + 2 < 8) {
#pragma unroll
            for (int bj = 0; bj < 2; ++bj) E.load_gates(u, EPI_ROW(r + 2), bj * 128 + col0, ga[(r + 2) % 3][bj], gb[(r + 2) % 3][bj]); }
        asm volatile("" ::: "memory");
#pragma unroll
        for (int bj = 0; bj < 2; ++bj) { float g0[8], g1[8]; unpack8(ga[r % 3][bj], g0); unpack8(gb[r % 3][bj], g1);
#pragma unroll
            for (int j = 0; j < 4; ++j) { acc[ai][bj][m][0][j] *= g0[j] * __builtin_amdgcn_rcpf(fmaxf(g1[j], 1e-30f)); acc[ai][bj][m][1][j] *= g0[4 + j] * __builtin_amdgcn_rcpf(fmaxf(g1[4 + j], 1e-30f)); } }
        asm volatile("" ::: "memory");
    }
#undef EPI_ROW
}

template <class Epi, class Sched>
__device__ __forceinline__ void gemm_simple(LAS unsigned char* lds, const Gemm g, const Sched& S, const Epi& E) {
    const int tid = tid_fresh(), wid = __builtin_amdgcn_readfirstlane(tid >> 6), lane = tid & 63, wr = wid >> 2, wc = wid & 3, fr = lane & 15, fq = lane >> 4;
    const int nt = g.K / 64;
    Unit u;
    for (int ui = 0; S.next(ui, u); ++ui) {
        f32x4 acc[2][2][4][2];
#pragma unroll
        for (int a = 0; a < 2; ++a)
#pragma unroll
            for (int b = 0; b < 2; ++b)
#pragma unroll
                for (int m = 0; m < 4; ++m)
#pragma unroll
                    for (int n = 0; n < 2; ++n) acc[a][b][m][n] = (f32x4){0.f, 0.f, 0.f, 0.f};
        const char* cA = (const char*)g.A + u.ao; const char* cB = (const char*)g.Bt + u.bo;
#pragma unroll 1
        for (int kt = 0; kt < nt; ++kt) {
            __syncthreads();
#pragma unroll
            for (int i = 0; i < 4; ++i) { const int c = tid + 512 * i, row = c >> 3, kc = c & 7, rb = (row & ~31) + perm32(row & 31);
                const u32x4 va = g.gather ? *(const u32x4*)((const char*)g.A + (size_t)g.gather[u.pm * 256 + row] * g.lda * 2 + kt * 128 + kc * 16)
                                          : *(const u32x4*)(cA + (size_t)row * g.lda * 2 + kt * 128 + kc * 16);
                const u32x4 vb = *(const u32x4*)(cB + (size_t)rb * g.ldb * 2 + kt * 128 + kc * 16);
                *(LAS u32x4*)(lds + row * 144 + kc * 16) = va; *(LAS u32x4*)(lds + 36864 + row * 144 + kc * 16) = vb; }
            __syncthreads();
#pragma unroll
            for (int k = 0; k < 2; ++k) {
                bf16x8 Af[2][4], Bf[2][2];
#pragma unroll
                for (int ai = 0; ai < 2; ++ai)
#pragma unroll
                    for (int m = 0; m < 4; ++m) Af[ai][m] = *(const LAS bf16x8*)(lds + (ai * 128 + wr * 64 + m * 16 + fr) * 144 + (k * 32 + fq * 8) * 2);
#pragma unroll
                for (int bj = 0; bj < 2; ++bj)
#pragma unroll
                    for (int n = 0; n < 2; ++n) Bf[bj][n] = *(const LAS bf16x8*)(lds + 36864 + (bj * 128 + wc * 32 + n * 16 + fr) * 144 + (k * 32 + fq * 8) * 2);
#pragma unroll
                for (int ai = 0; ai < 2; ++ai)
#pragma unroll
                    for (int bj = 0; bj < 2; ++bj)
#pragma unroll
                        for (int m = 0; m < 4; ++m)
#pragma unroll
                            for (int n = 0; n < 2; ++n) acc[ai][bj][m][n] = __builtin_amdgcn_mfma_f32_16x16x32_bf16(Bf[bj][n], Af[ai][m], acc[ai][bj][m][n], 0, 0, 0);
            }
        }
        run_epi(E, acc, u, wr, wc, fr, fq);
    }
    __syncthreads();
}

template <class E, class = void> struct EpiNStore { static constexpr int value = 0; };
template <class E> struct EpiNStore<E, decltype((void)E::NSTORE)> { static constexpr int value = E::NSTORE; };
namespace pg8 {
template <int N> __device__ __forceinline__ void wait_vm() { asm volatile("s_waitcnt vmcnt(%0)" :: "n"(N) : "memory"); }
constexpr int BK = 64, HALF = 128, HTB = HALF * BK * 2  , STAGE_BYTES = 8 * HTB;
__device__ __forceinline__ int lds_byte(int r, int c) { const int st = (r >> 4) * 2 + (c >> 5), rr = r & 15, cc = c & 31, ob = rr * 64 + cc * 2; return st * 1024 + (ob ^ (((ob >> 9) & 1) << 5)); }
__device__ __forceinline__ void stage_rc(int b, int& R, int& C) { const int st = b / 1024, sb = b % 1024, swz = sb ^ (((sb >> 9) & 1) << 5); R = (st >> 1) * 16 + swz / 64; C = (st & 1) * 32 + (swz % 64) / 2; }

template <class Epi, class Sched, bool GATHER, bool FP8>
__device__ __forceinline__ void gemm_fast(LAS unsigned char* lds, const Gemm g, const Sched& S, const Epi& E, int skew_ticks) {
    const int tid = tid_fresh(), wid = __builtin_amdgcn_readfirstlane(tid >> 6), lane = tid & 63, wr = wid >> 2, wc = wid & 3, fr = lane & 15, fq = lane >> 4;
    constexpr int EB = FP8 ? 1 : 2;
    const int nt = g.K * EB / 128;
    unsigned voffA[2], voffB[2];
#pragma unroll
    for (int i = 0; i < 2; ++i) { int R, C; stage_rc(tid * 16 + i * 8192, R, C); const int Rb = (R & ~31) + perm32(R & 31);
        voffA[i] = (unsigned)(R * g.lda * EB + C * 2); voffB[i] = (unsigned)(Rb * g.ldb * EB + C * 2); }
    const size_t kstep = (size_t)(BK * 2);
    const size_t hstepA = GATHER ? (size_t)0 : (size_t)HALF * g.lda * EB, hstepB = (size_t)HALF * g.ldb * EB;
    unsigned cV0[2], cV1[2], nV0[2], nV1[2];
#define PG8_GATHER(pm_, V0, V1) do { _Pragma("unroll") for (int _i = 0; _i < 2; ++_i) { int R_, C_; stage_rc(tid * 16 + _i * 8192, R_, C_); \
        V0[_i] = (unsigned)(g.gather[(pm_) * 256 + R_] * g.lda * EB + C_ * 2); V1[_i] = (unsigned)(g.gather[(pm_) * 256 + 128 + R_] * g.lda * EB + C_ * 2); } } while (0)
    const unsigned ldsw = (unsigned)wid * 1024u;
    const int aoff = lds_byte(wr * 64 + fr, fq * 8), boff = lds_byte(wc * 32 + fr, fq * 8);
#define PG8_SA(b, h) (((b) * 2 + (h)) * HTB)
#define PG8_SB(b, h) ((4 + (b) * 2 + (h)) * HTB)
#define PG8_STAGE(bufoff, gbase, voff) do { _Pragma("unroll") for (int _i = 0; _i < 2; ++_i) \
        __builtin_amdgcn_global_load_lds((const unsigned*)((const char*)(gbase) + (voff)[_i]), (LAS unsigned*)(lds + (bufoff) + ldsw + _i * 8192), 16, 0, 0); } while (0)
#define PG8_LD8(p) __builtin_shufflevector(*(const LAS v4i32*)(p), *(const LAS v4i32*)((p) + 1024), 0, 1, 2, 3, 4, 5, 6, 7)
#define PG8_LDA(dst, b, h) do { _Pragma("unroll") for (int m = 0; m < 4; ++m) dst[m] = PG8_LD8(lds + PG8_SA(b, h) + aoff + m * 2048); } while (0)
#define PG8_LDB(dst, b, h) do { _Pragma("unroll") for (int n = 0; n < 2; ++n) dst[n] = PG8_LD8(lds + PG8_SB(b, h) + boff + n * 2048); } while (0)
#define PG8_HALF0(v) __builtin_bit_cast(bf16x8, __builtin_shufflevector(v, v, 0, 1, 2, 3))
#define PG8_HALF1(v) __builtin_bit_cast(bf16x8, __builtin_shufflevector(v, v, 4, 5, 6, 7))
#define PG8_MMA(ai, bj, At, Bt) do { __builtin_amdgcn_s_setprio(1); \
        if constexpr (FP8) { _Pragma("unroll") for (int m = 0; m < 4; ++m) _Pragma("unroll") for (int n = 0; n < 2; ++n) \
            asm volatile("v_mfma_scale_f32_16x16x128_f8f6f4 %0, %1, %2, %0, %3, %4 op_sel_hi:[0,0,0]" : "+v"(acc[ai][bj][m][n]) : "v"(Bt[n]), "v"(At[m]), "v"(sclW), "v"(sclX)); } \
        else { _Pragma("unroll") for (int m = 0; m < 4; ++m) _Pragma("unroll") for (int n = 0; n < 2; ++n) { \
            acc[ai][bj][m][n] = __builtin_amdgcn_mfma_f32_16x16x32_bf16(PG8_HALF0(Bt[n]), PG8_HALF0(At[m]), acc[ai][bj][m][n], 0, 0, 0); \
            acc[ai][bj][m][n] = __builtin_amdgcn_mfma_f32_16x16x32_bf16(PG8_HALF1(Bt[n]), PG8_HALF1(At[m]), acc[ai][bj][m][n], 0, 0, 0); } } \
        __builtin_amdgcn_s_setprio(0); } while (0)
#define PG8_WAIT_V(n) asm volatile("s_waitcnt vmcnt(" #n ")" ::: "memory")
#define PG8_WAIT_L(n) asm volatile("s_waitcnt lgkmcnt(" #n ")" ::: "memory")
#define PG8_BAR __builtin_amdgcn_s_barrier()
#define PG8_SCHED __builtin_amdgcn_sched_barrier(0)
    Unit cur, nxt; int ui = 0;
    constexpr int NSTR = EpiNStore<Epi>::value; bool stored_prev = false, pre11 = false;
    if (!S.next(0, cur)) return;
    if (skew_ticks > 0) {
        const unsigned long long t0 = __builtin_amdgcn_s_memrealtime(); const unsigned long long d = (unsigned long long)(((blockIdx.x * 167u + 13u) & 255u) * (unsigned)skew_ticks) >> 8;
        while (__builtin_amdgcn_s_memrealtime() - t0 < d) __builtin_amdgcn_s_sleep(8);
    }
    f32x4 acc[2][2][4][2];
#define PG8_INIT(un, slot_) do { const LAS float* bs0_ = nullptr; if constexpr (Epi::BIASINIT) { if (E.bias_ptr(un) != nullptr) bs0_ = (const LAS float*)(lds + 131072 + 8192 + (slot_) * 1024) + wc * 32 + 8 * fq; } \
        _Pragma("unroll") for (int b = 0; b < 2; ++b) { f32x4 lo_ = (f32x4){0.f, 0.f, 0.f, 0.f}, hi_ = lo_; \
            if constexpr (Epi::BIASINIT) { if (bs0_) { lo_ = *(const LAS f32x4*)(bs0_ + b * 128); hi_ = *(const LAS f32x4*)(bs0_ + b * 128 + 4); } } \
            _Pragma("unroll") for (int n = 0; n < 2; ++n) { f32x4 iv = (f32x4){0.f, 0.f, 0.f, 0.f}; if constexpr (Epi::BIASINIT) { if (bs0_) iv = E.init_vec(lo_, hi_, n); } \
                _Pragma("unroll") for (int a = 0; a < 2; ++a) _Pragma("unroll") for (int m = 0; m < 4; ++m) acc[a][b][m][n] = iv; } } } while (0)
    v8i32 At[4], B0[2], B1[2];
    const int sclW = g.scaleB, sclX = g.scaleA;
    const char* cA = (const char*)g.A + (GATHER ? 0u : cur.ao); const char* cB = (const char*)g.Bt + cur.bo;
#define PG8_BIAS(un, ui_) do { if constexpr (Epi::LDSBIAS) { const float* bp_ = E.bias_ptr(un); if (bp_ != nullptr && wid == 0) \
        __builtin_amdgcn_global_load_lds((const unsigned*)(bp_ + lane * 4), (LAS unsigned*)(lds + 131072 + 8192 + (ui_) * 1024), 16, 0, 0); } } while (0)
    int bsl = 0;
    PG8_BIAS(cur, 0);
    if constexpr (GATHER) { PG8_GATHER(cur.pm, cV0, cV1); } else { cV0[0] = cV1[0] = voffA[0]; cV0[1] = cV1[1] = voffA[1]; }
    nV0[0] = cV0[0]; nV0[1] = cV0[1]; nV1[0] = cV1[0]; nV1[1] = cV1[1];
    PG8_STAGE(PG8_SB(0, 0), cB, voffB); PG8_STAGE(PG8_SB(0, 1), cB + hstepB, voffB); PG8_STAGE(PG8_SA(0, 0), cA, cV0); PG8_STAGE(PG8_SA(0, 1), cA + hstepA, cV1);
    if (wr == 1) PG8_BAR;
    PG8_WAIT_V(2); PG8_BAR;
    PG8_STAGE(PG8_SB(1, 0), cB + kstep, voffB); PG8_STAGE(PG8_SA(1, 0), cA + kstep, cV0); PG8_STAGE(PG8_SB(1, 1), cB + hstepB + kstep, voffB);
    PG8_WAIT_V(6); PG8_BAR;
    PG8_INIT(cur, 0);
    for (;;) {
        const bool has_next = S.next(ui + 1, nxt);
        const int bsn = (bsl == 2) ? 0 : bsl + 1;
        if (has_next) PG8_BIAS(nxt, bsn);
        const char* nA = (has_next && !GATHER) ? (const char*)g.A + nxt.ao : cA; const char* nB = has_next ? (const char*)g.Bt + nxt.bo : cB;
        if constexpr (GATHER) { if (has_next) PG8_GATHER(nxt.pm, nV0, nV1); }
#pragma unroll 1
        for (int t = 0; t < nt; t += 2) {
            const bool last = (t == nt - 2);
            const char* a1 = cA + (size_t)(t + 1) * kstep;
            const char* a2 = last ? nA : cA + (size_t)(t + 2) * kstep; const char* b2 = last ? nB : cB + (size_t)(t + 2) * kstep;
            const char* a3 = a2 + kstep; const char* b3 = b2 + kstep;
            unsigned sV0[2], sV1[2];
            sV0[0] = last ? nV0[0] : cV0[0]; sV0[1] = last ? nV0[1] : cV0[1]; sV1[0] = last ? nV1[0] : cV1[0]; sV1[1] = last ? nV1[1] : cV1[1];
            const bool rlx = NSTR > 0 && t == 0 && stored_prev;
            PG8_LDB(B0, 0, 0); PG8_LDB(B1, 0, 1); PG8_SCHED; PG8_LDA(At, 0, 0); if (!(pre11 && t == 0)) PG8_STAGE(PG8_SA(1, 1), a1 + hstepA, cV1);
            if (rlx) wait_vm<8 + NSTR>(); else PG8_WAIT_V(8);
            PG8_WAIT_L(0); PG8_BAR; PG8_MMA(0, 0, At, B0); PG8_MMA(0, 1, At, B1); PG8_BAR; PG8_SCHED;
            PG8_LDA(At, 0, 1); PG8_STAGE(PG8_SB(0, 0), b2, voffB); PG8_STAGE(PG8_SB(0, 1), b2 + hstepB, voffB); PG8_STAGE(PG8_SA(0, 0), a2, sV0);
            if (rlx) wait_vm<8 + NSTR>(); else PG8_WAIT_V(8);
            PG8_WAIT_L(0); PG8_BAR; PG8_MMA(1, 0, At, B0); PG8_MMA(1, 1, At, B1); PG8_BAR; PG8_SCHED;
            PG8_LDB(B0, 1, 0); PG8_LDB(B1, 1, 1); PG8_SCHED; PG8_LDA(At, 1, 0); PG8_STAGE(PG8_SA(0, 1), a2 + hstepA, sV1);
            if (rlx && pre11) wait_vm<8 + NSTR>(); else PG8_WAIT_V(8);
            PG8_WAIT_L(0); PG8_BAR; PG8_MMA(0, 0, At, B0); PG8_MMA(0, 1, At, B1); PG8_BAR; PG8_SCHED;
            PG8_LDA(At, 1, 1); PG8_STAGE(PG8_SB(1, 0), b3, voffB); PG8_STAGE(PG8_SB(1, 1), b3 + hstepB, voffB); PG8_STAGE(PG8_SA(1, 0), a3, sV0);
            PG8_WAIT_V(8); PG8_WAIT_L(0); PG8_BAR; PG8_MMA(1, 0, At, B0); PG8_MMA(1, 1, At, B1); PG8_BAR; PG8_SCHED;
        }
        if (wr == 0) PG8_BAR;
        const bool pre11n = has_next;
        if (has_next) PG8_STAGE(PG8_SA(1, 1), nA + kstep + hstepA, nV1);
        if constexpr (FP8) asm volatile("s_nop 15\n\ts_nop 15" ::: "memory");
        stored_prev = Epi::DUAL ? cur.e != 1 : cur.e >= 0;
        if constexpr (Epi::DUAL) { if (cur.e == 1) run_mid(E, acc, cur, wr, wc, fr, fq); else run_epi<Epi, false>(E, acc, cur, wr, wc, fr, fq); }
        else if (cur.e >= 0) { const LAS float* bs_ = nullptr; if constexpr (Epi::LDSBIAS) { if (E.bias_ptr(cur) != nullptr) bs_ = (const LAS float*)(lds + 131072 + 8192 + bsl * 1024); }
            run_epi<Epi, Epi::BIASINIT>(E, acc, cur, wr, wc, fr, fq, bs_); }
        if (!has_next) break;
        { const bool keep_ = Epi::DUAL && cur.e == 1;
            cur = nxt; cA = nA; cB = nB; ++ui; bsl = bsn; pre11 = pre11n;
            if (!keep_) PG8_INIT(cur, bsl); }
        cV0[0] = nV0[0]; cV0[1] = nV0[1]; cV1[0] = nV1[0]; cV1[1] = nV1[1];
        if (wr == 1) PG8_BAR;
    }
    PG8_WAIT_V(0);
    PG8_BAR;
#undef PG8_GATHER
#undef PG8_BIAS
#undef PG8_INIT
#undef PG8_SA
#undef PG8_SB
#undef PG8_STAGE
#undef PG8_LD8
#undef PG8_HALF0
#undef PG8_HALF1
#undef PG8_LDA
#undef PG8_LDB
#undef PG8_MMA
#undef PG8_WAIT_V
#undef PG8_WAIT_L
#undef PG8_BAR
#undef PG8_SCHED
}
}

template <class Epi, class Sched, bool GATHER = false, bool FP8 = false>
__device__ __forceinline__ void gemm_phase(LAS unsigned char* lds, const Gemm g, const Sched& S, const Epi& E, int skew_ticks = 0) {
#if FAST_GEMM
    pg8::gemm_fast<Epi, Sched, GATHER, FP8>(lds, g, S, E, skew_ticks);
#else
    gemm_simple<Epi, Sched>(lds, g, S, E);
#endif
}

#define EPI_DEFAULTS_NOROW typedef NoPre RowPre; __device__ __forceinline__ NoPre row_pre(const Unit&, int) const { return NoPre{}; } __device__ __forceinline__ float row_ctx(const NoPre&) const { return 0.f; }
#define EPI_DEFAULTS_NOPRE typedef NoPre Pre; __device__ __forceinline__ NoPre pre(const Unit&, int, int) const { return NoPre{}; }
#define EPI_INITVEC_PLAIN __device__ __forceinline__ f32x4 init_vec(f32x4 lo, f32x4 hi, int n) const { return n ? hi : lo; }
#define EPI_NOBIAS static constexpr bool LDSBIAS = false, BIASINIT = false; EPI_INITVEC_PLAIN __device__ __forceinline__ const float* bias_ptr(const Unit&) const { return nullptr; }
#define EPI_DEFAULTS_NOPART static constexpr bool DUAL = false; __device__ __forceinline__ bool want_partial(const Unit&) const { return false; } __device__ __forceinline__ void partial(const Unit&, int, int, float) const {}
struct EpiIn {
    static constexpr int NSTORE = 16;
    static constexpr int PRE_DEPTH = 1; static constexpr bool SUMSQ = true, COLMAJOR = false, LDSBIAS = true, BIASINIT = true; typedef Ctx8 ColCtx; EPI_DEFAULTS_NOROW EPI_DEFAULTS_NOPRE
    EPI_INITVEC_PLAIN
    __device__ __forceinline__ int ltile(const Unit& u) const { return u.pn; }
    __device__ __forceinline__ const float* bias_ptr(const Unit& u) const { return u.pn >= 8 ? bgate + (u.pn - 8) * 256 : nullptr; }
    static constexpr bool DUAL = false;
    bf16_t *U, *QLp, *KVLp, *KPE, *GATES; float *PSQQ, *PSQKV; const float* bgate; const f32x2* CS; int pn0;
    __device__ __forceinline__ Ctx8 col_ctx(const Unit& u, int col) const { if (u.pn >= 8) return load8f(bgate + (u.pn - 8) * 256 + col); Ctx8 c;
#pragma unroll
        for (int j = 0; j < 8; ++j) c.s[j] = 0.f;
        return c; }
    __device__ __forceinline__ bool want_partial(const Unit& u) const { return u.pn >= 4 && u.pn < 8; }
    __device__ __forceinline__ void partial(const Unit& u, int row, int wc, float s) const {
        if (u.pn < 7) PSQQ[(size_t)row * 12 + (u.pn - 4) * 4 + wc] = s; else PSQKV[(size_t)row * 4 + wc] = s; }
    template <bool BI> __device__ __forceinline__ float apply(const Unit& u, int row, int col, float (&v)[8], float, const Ctx8& cc, NoPre) const {
        const int pn = ltile(u);
        if (pn < 4) { *(u32x4*)(U + (size_t)row * D + pn * 256 + col) = pack8(v); return 0.f; }
        if (pn < 8) {
            float s = 0.f;
#pragma unroll
            for (int j = 0; j < 8; ++j) s += v[j] * v[j];
            if (pn < 7) { u32x2 w; w.x = pk4_fp8(v[0], v[1], v[2], v[3]); w.y = pk4_fp8(v[4], v[5], v[6], v[7]); *(u32x2*)((unsigned char*)QLp + (size_t)row * QL + (pn - 4) * 256 + col) = w; }
            else { u32x2 w; w.x = pk4_fp8(v[0], v[1], v[2], v[3]); w.y = pk4_fp8(v[4], v[5], v[6], v[7]); *(u32x2*)((unsigned char*)KVLp + (size_t)row * KVL + col) = w; }
            return s;
        }
        {
            float o[8];
#pragma unroll
            for (int j = 0; j < 8; ++j) o[j] = sigmoidf_(BI ? v[j] : v[j] + cc.s[j]);
            *(u32x4*)(GATES + (size_t)row * 2048 + (pn - 8) * 256 + col) = pack8(o);
        }
        return 0.f;
    }
};
struct Pre12 { f32x4 a, b, c; };
struct EpiQ {
    static constexpr int NSTORE = 16;
    static constexpr int PRE_DEPTH = 2; static constexpr bool SUMSQ = false, COLMAJOR = false; typedef NoCtx ColCtx; typedef Pre12 RowPre; typedef Ctx8 Pre; EPI_DEFAULTS_NOPART EPI_NOBIAS
    bf16_t* Q; const float* PSQQ; const f32x2* CS;
    __device__ __forceinline__ Pre12 row_pre(const Unit&, int row) const { const f32x4* p = (const f32x4*)(PSQQ + (size_t)row * 12); Pre12 r; r.a = p[0]; r.b = p[1]; r.c = p[2]; return r; }
    __device__ __forceinline__ float row_ctx(const Pre12& r) const {
        const float s = ((r.a[0] + r.a[1]) + (r.a[2] + r.a[3])) + ((r.b[0] + r.b[1]) + (r.b[2] + r.b[3])) + ((r.c[0] + r.c[1]) + (r.c[2] + r.c[3]));
        return rsqrtf(s * (1.0f / QL) + EPS) * (QSCALE * Q8SCALE); }
    __device__ __forceinline__ NoCtx col_ctx(const Unit&, int) const { return NoCtx{}; }
    __device__ __forceinline__ Ctx8 pre(const Unit& u, int row, int col) const {
        if (u.pn >= 4) { const int g = (((u.pn - 4) * 256 + col) & 63) >> 3; return load8f((const float*)(CS + (size_t)row * 32 + 4 * g)); }
        Ctx8 c;
#pragma unroll
        for (int j = 0; j < 8; ++j) c.s[j] = 0.f;
        return c; }
    template <bool BI> __device__ __forceinline__ float apply(const Unit& u, int row, int col, float (&v)[8], float rs, NoCtx, const Ctx8& cs) const {
#pragma unroll
        for (int j = 0; j < 8; ++j) v[j] *= rs;
        unsigned char* Q8 = (unsigned char*)Q + (size_t)row * (NH * QKD);
        if (u.pn < 4) { const int p = u.pn * 256 + col, hh = p >> 7, d = p & 127; u32x2 w; w.x = pk4_fp8(v[0], v[1], v[2], v[3]); w.y = pk4_fp8(v[4], v[5], v[6], v[7]); *(u32x2*)(Q8 + hh * QKD + d) = w; }
        else { const int r = (u.pn - 4) * 256 + col, hh = r >> 6, g = (r & 63) >> 3; float y1[4], y2[4];
#pragma unroll
            for (int i = 0; i < 4; ++i) { const float c = cs.s[2 * i], sn = cs.s[2 * i + 1]; y1[i] = v[i] * c - v[4 + i] * sn; y2[i] = v[4 + i] * c + v[i] * sn; }
            unsigned char* q = Q8 + hh * QKD + NOPE; *(unsigned*)(q + 4 * g) = pk4_fp8(y1[0], y1[1], y1[2], y1[3]); *(unsigned*)(q + 32 + 4 * g) = pk4_fp8(y2[0], y2[1], y2[2], y2[3]); }
        return 0.f;
    }
};
__device__ __forceinline__ float rstd_kv4(const f32x4 a) { return rsqrtf(((a[0] + a[1]) + (a[2] + a[3])) * (1.0f / KVL) + EPS); }
struct Pre4 { f32x4 a; };
struct EpiK {
    static constexpr int NSTORE = 16;
    static constexpr int PRE_DEPTH = 4; static constexpr bool SUMSQ = false, COLMAJOR = false; typedef NoCtx ColCtx; typedef Pre4 RowPre; EPI_DEFAULTS_NOPRE EPI_DEFAULTS_NOPART EPI_NOBIAS
    bf16_t* KN; const float* PSQKV;
    __device__ __forceinline__ Pre4 row_pre(const Unit&, int row) const { Pre4 r; r.a = *(const f32x4*)(PSQKV + (size_t)row * 4); return r; }
    __device__ __forceinline__ float row_ctx(const Pre4& r) const { return rstd_kv4(r.a); }
    __device__ __forceinline__ NoCtx col_ctx(const Unit&, int) const { return NoCtx{}; }
    template <bool BI> __device__ __forceinline__ float apply(const Unit& u, int row, int col, float (&v)[8], float rs, NoCtx, NoPre) const {
#pragma unroll
        for (int j = 0; j < 8; ++j) v[j] *= rs;
        u32x2 w; w.x = pk4_fp8(v[0], v[1], v[2], v[3]); w.y = pk4_fp8(v[4], v[5], v[6], v[7]);
        *(u32x2*)((unsigned char*)KN + (size_t)row * D + u.pn * 256 + col) = w; return 0.f; }
};
struct EpiVT {
    static constexpr int NSTORE = 16;
    static constexpr int PRE_DEPTH = 1; static constexpr bool SUMSQ = false, COLMAJOR = true; typedef Ctx8 ColCtx; EPI_NOBIAS static constexpr bool DUAL = false;
    bf16_t* VT; const float* PSQKV;
    __device__ __forceinline__ Ctx8 col_ctx(const Unit& u, int col) const { Ctx8 c; const int t0 = u.pn * 256 + col;
#pragma unroll
        for (int j = 0; j < 8; ++j) c.s[j] = rstd_kv4(*(const f32x4*)(PSQKV + (size_t)(t0 + j) * 4));
        return c; }
    template <bool BI> __device__ __forceinline__ float apply(const Unit& u, int row, int col, float (&v)[8], float, const Ctx8& cc, NoPre) const {
#pragma unroll
        for (int j = 0; j < 8; ++j) v[j] *= cc.s[j];
        u32x2 w; w.x = pk4_fp8(v[0], v[1], v[2], v[3]); w.y = pk4_fp8(v[4], v[5], v[6], v[7]);
        *(u32x2*)((unsigned char*)VT + (size_t)row * T + u.pn * 256 + col) = w; return 0.f; }
};
struct EpiPlain {
    static constexpr int PRE_DEPTH = 1; static constexpr bool SUMSQ = false, COLMAJOR = false; typedef NoCtx ColCtx; EPI_DEFAULTS_NOROW EPI_DEFAULTS_NOPRE EPI_DEFAULTS_NOPART EPI_NOBIAS
    bf16_t* O; int ldc;
    __device__ __forceinline__ NoCtx col_ctx(const Unit&, int) const { return NoCtx{}; }
    template <bool BI> __device__ __forceinline__ float apply(const Unit& u, int row, int col, float (&v)[8], float, NoCtx, NoPre) const {
        *(u32x4*)(O + (size_t)row * ldc + u.pn * 256 + col) = pack8(v); return 0.f; }
};
struct PreG { u32x4 g; };
struct EpiMergeDual {
    static constexpr int NSTORE = 16;
    static constexpr int PRE_DEPTH = 3; static constexpr bool SUMSQ = false, COLMAJOR = false, DUAL = true; typedef NoCtx ColCtx; typedef PreG Pre; EPI_DEFAULTS_NOROW EPI_NOBIAS
    __device__ __forceinline__ bool want_partial(const Unit&) const { return false; } __device__ __forceinline__ void partial(const Unit&, int, int, float) const {}
    bf16_t* MG; const bf16_t* GATES;
    __device__ __forceinline__ NoCtx col_ctx(const Unit&, int) const { return NoCtx{}; }
    __device__ __forceinline__ void load_gates(const Unit& u, int row, int col, u32x4& ga, u32x4& gb) const { const bf16_t* p = GATES + (size_t)row * 2048 + u.pn * 256 + col; ga = *(const u32x4*)p; gb = *(const u32x4*)(p + 1024); }
    __device__ __forceinline__ PreG pre(const Unit& u, int row, int col) const { PreG p; p.g = *(const u32x4*)(GATES + (size_t)row * 2048 + 1024 + u.pn * 256 + col); return p; }
    template <bool BI> __device__ __forceinline__ float apply(const Unit& u, int row, int col, float (&v)[8], float, NoCtx, const PreG& pr) const {
        float g[8]; unpack8(pr.g, g);
#pragma unroll
        for (int j = 0; j < 8; ++j) v[j] *= g[j];
        *(u32x4*)(MG + (size_t)row * D + u.pn * 256 + col) = pack8(v); return 0.f; }
};
struct PreX { f32x4 a, b; };
struct EpiOut {
    static constexpr int NSTORE = 16;
    static constexpr int PRE_DEPTH = 3; static constexpr bool SUMSQ = true, COLMAJOR = false, LDSBIAS = true, BIASINIT = false, DUAL = false; typedef Ctx8 ColCtx; typedef PreX Pre; EPI_DEFAULTS_NOROW
    __device__ __forceinline__ bool want_partial(const Unit&) const { return true; }
    __device__ __forceinline__ void partial(const Unit& u, int row, int wc, float sq) const { PSQX[(size_t)row * 16 + u.pn * 4 + wc] = sq; }
    EPI_INITVEC_PLAIN
    __device__ __forceinline__ const float* bias_ptr(const Unit& u) const { return MOD + ((u.pm * 256) >> 12) * 6144 + 2 * 1024 + u.pn * 256; }
    const float* X; bf16_t* X1; const float* MOD; float* PSQX;
    __device__ __forceinline__ Ctx8 col_ctx(const Unit& u, int col) const { return load8f(MOD + ((u.pm * 256) >> 12) * 6144 + 2 * 1024 + u.pn * 256 + col); }
    __device__ __forceinline__ PreX pre(const Unit& u, int row, int col) const { const float* xr = X + (size_t)row * D + u.pn * 256 + col; PreX p; p.a = *(const f32x4*)xr; p.b = *(const f32x4*)(xr + 4); return p; }
    template <bool BI> __device__ __forceinline__ float apply(const Unit& u, int row, int col, float (&v)[8], float, const Ctx8& g1, const PreX& x) const {
        float o[8];
#pragma unroll
        for (int j = 0; j < 4; ++j) { o[j] = x.a[j] + g1.s[j] * v[j]; o[4 + j] = x.b[j] + g1.s[4 + j] * v[4 + j]; }
        *(u32x4*)(X1 + (size_t)row * D + u.pn * 256 + col) = pack8(o);
        float sq = 0.f;
#pragma unroll
        for (int j = 0; j < 8; ++j) sq += o[j] * o[j];
        return sq; }
};
__device__ __forceinline__ constexpr int ACT_SRC(int pos) { return ((pos >> 2) & 1) * 64 + (pos >> 5) * 16 + ((pos >> 3) & 3) * 4 + (pos & 3); }
struct EpiGU {
    static constexpr int NSTORE = 8; static constexpr bool PAIRED = true;
    __device__ __forceinline__ unsigned swiglu4(const float (&v)[8]) const { float a[4];
#pragma unroll
        for (int i = 0; i < 4; ++i) { const float gt = fminf(v[i], 7.0f * GUC), up1 = __builtin_amdgcn_fmed3f(v[4 + i], -6.0f * GUCI, 8.0f * GUCI);
            a[i] = up1 * (gt * __builtin_amdgcn_rcpf(1.0f + __builtin_amdgcn_exp2f(-gt))); }
        return pk4_fp8(a[0], a[1], a[2], a[3]); }
    __device__ __forceinline__ void apply2(const Unit& u, int row, int col0, const float (&v0)[8], const float (&v1)[8], float) const {
        u32x2 w; w.x = swiglu4(v0); w.y = swiglu4(v1);
        *(u32x2*)((unsigned char*)ACT + (size_t)row * DE + u.pn * 128 + col0) = w; }
    static constexpr int PRE_DEPTH = 1; static constexpr bool SUMSQ = false, COLMAJOR = false, LDSBIAS = true, BIASINIT = true; typedef Ctx8 ColCtx; EPI_DEFAULTS_NOROW EPI_DEFAULTS_NOPRE EPI_DEFAULTS_NOPART
    __device__ __forceinline__ const float* bias_ptr(const Unit& u) const { return bgu + (size_t)u.e * 2048 + u.pn * 256; }
    __device__ __forceinline__ f32x4 init_vec(f32x4 lo, f32x4 hi, int n) const { return n ? (f32x4){lo[1] + 1.0f, lo[3] + 1.0f, hi[1] + 1.0f, hi[3] + 1.0f} * GUCI : (f32x4){lo[0], lo[2], hi[0], hi[2]} * GUC; }
    bf16_t* ACT; const float* bgu;
    __device__ __forceinline__ Ctx8 col_ctx(const Unit& u, int col) const { return load8f(bgu + (size_t)u.e * 2048 + u.pn * 256 + col); }
    template <bool BI> __device__ __forceinline__ float apply(const Unit& u, int row, int col, float (&v)[8], float, const Ctx8& bb, NoPre) const {
        const int p = u.pn * 256 + col; float a[4];
#pragma unroll
        for (int i = 0; i < 4; ++i) { float gt = BI ? v[i] : v[i] + bb.s[2 * i] * GUC, up1 = BI ? v[4 + i] : v[4 + i] + (bb.s[2 * i + 1] + 1.0f) * GUCI;
            gt = fminf(gt, 7.0f * GUC); up1 = __builtin_amdgcn_fmed3f(up1, -6.0f * GUCI, 8.0f * GUCI);
            a[i] = up1 * (gt * __builtin_amdgcn_rcpf(1.0f + __builtin_amdgcn_exp2f(-gt))); }
        *(unsigned*)((unsigned char*)ACT + (size_t)row * DE + (p >> 1)) = pk4_fp8(a[0], a[1], a[2], a[3]); return 0.f; }
};
struct Pre1 { float w; };
struct EpiDown {
    static constexpr int NSTORE = 8; static constexpr bool PAIRED = true;
    __device__ __forceinline__ void apply2(const Unit& u, int row, int col0, const float (&v0)[8], const float (&v1)[8], float rw) const {
        const float rs = rw * YSCALE;
        u32x4 w; w.x = pk4_fp8(v0[0] * rs, v0[1] * rs, v0[2] * rs, v0[3] * rs); w.y = pk4_fp8(v0[4] * rs, v0[5] * rs, v0[6] * rs, v0[7] * rs);
        w.z = pk4_fp8(v1[0] * rs, v1[1] * rs, v1[2] * rs, v1[3] * rs); w.w = pk4_fp8(v1[4] * rs, v1[5] * rs, v1[6] * rs, v1[7] * rs);
        *(u32x4*)((unsigned char*)Y + (size_t)row * D + u.pn * 256 + 2 * col0) = w; }
    static constexpr int PRE_DEPTH = 7; static constexpr bool SUMSQ = false, COLMAJOR = false, LDSBIAS = true, BIASINIT = true; typedef Ctx8 ColCtx; typedef Pre1 RowPre; EPI_DEFAULTS_NOPRE EPI_DEFAULTS_NOPART EPI_INITVEC_PLAIN
    __device__ __forceinline__ const float* bias_ptr(const Unit& u) const { return bdn + (size_t)u.e * D + u.pn * 256; }
    bf16_t* Y; const float* bdn; const float* ROWW;
    __device__ __forceinline__ Pre1 row_pre(const Unit&, int row) const { Pre1 r; r.w = ROWW[row]; return r; }
    __device__ __forceinline__ float row_ctx(const Pre1& r) const { return r.w; }
    __device__ __forceinline__ Ctx8 col_ctx(const Unit& u, int col) const { return load8f(bdn + (size_t)u.e * D + u.pn * 256 + col); }
    template <bool BI> __device__ __forceinline__ float apply(const Unit& u, int row, int col, float (&v)[8], float rw, const Ctx8& bb, NoPre) const {
        const float rs = rw * YSCALE;
#pragma unroll
        for (int j = 0; j < 8; ++j) v[j] = (BI ? v[j] : v[j] + bb.s[j]) * rs;
        u32x2 w; w.x = pk4_fp8(v[0], v[1], v[2], v[3]); w.y = pk4_fp8(v[4], v[5], v[6], v[7]);
        *(u32x2*)((unsigned char*)Y + (size_t)row * D + u.pn * 256 + col) = w; return 0.f; }
};

struct TrItem { const float* src; unsigned char* dst; const float* rs; const float* cs; int Nsrc, K, kb, pb, lb, perm; bool fp8, valid, kperm; };
__device__ __forceinline__ void tr_load(const TrItem& t, f32x4 (&R)[16], int lane) {
    if (t.kperm) {
        const float* p = t.src + (size_t)((t.kb >> 1) * 128 + ACT_SRC(16 * (lane >> 3))) * t.Nsrc + t.lb + 32 * (t.kb & 1) + 4 * (lane & 7);
#pragma unroll
        for (int it = 0; it < 16; ++it) R[it] = __builtin_nontemporal_load((const f32x4*)(p + (size_t)ACT_SRC(it) * t.Nsrc));
        return; }
    const float* p = t.src + (size_t)((t.kb >> 1) * 128 + 16 * (lane >> 3)) * t.Nsrc + t.lb + 32 * (t.kb & 1) + 4 * (lane & 7);
#pragma unroll
    for (int it = 0; it < 16; ++it) R[it] = __builtin_nontemporal_load((const f32x4*)(p + (size_t)it * t.Nsrc));
}
__device__ __forceinline__ void tr_process(const TrItem& t, const f32x4 (&R)[16], int lane) {
    const int k0 = (t.kb >> 1) * 128 + 16 * (lane >> 3), o4 = 32 * (t.kb & 1) + 4 * (lane & 7);
    f32x4 csv = (f32x4){1.f, 1.f, 1.f, 1.f}; if (t.cs) csv = *(const f32x4*)(t.cs + t.lb + o4);
    if (t.fp8) csv *= W8SCALE;
    f32x4 rs[4];
#pragma unroll
    for (int q = 0; q < 4; ++q) rs[q] = (f32x4){1.f, 1.f, 1.f, 1.f};
    if (t.rs) {
#pragma unroll
        for (int q = 0; q < 4; ++q) rs[q] = *(const f32x4*)(t.rs + k0 + 4 * q); }
#pragma unroll
    for (int e = 0; e < 4; ++e) {
        const int o = o4 + e;
        int ph;
        if (t.perm == 1) ph = 8 * ((o & 31) >> 2) + 4 * (o >> 5) + (o & 3);
        else if (t.perm == 2) ph = 8 * (o >> 3) + 4 * (o & 1) + ((o & 7) >> 1);
        else ph = o;
        float v[16];
        const float ce = csv[e] * (t.perm == 2 ? ((e & 1) ? GUCI : GUC) : 1.0f);
#pragma unroll
        for (int it = 0; it < 16; ++it) v[it] = R[it][e] * ce * rs[it >> 2][it & 3];
        const size_t off = (size_t)(t.pb * 64 + ph) * t.K + k0;
        if (t.fp8) { u32x4 w; w.x = pk4_fp8(v[0], v[1], v[2], v[3]); w.y = pk4_fp8(v[4], v[5], v[6], v[7]); w.z = pk4_fp8(v[8], v[9], v[10], v[11]); w.w = pk4_fp8(v[12], v[13], v[14], v[15]);
            *(u32x4*)(t.dst + off) = w; }
        else { u32x4 w0, w1; w0.x = pk2(v[0], v[1]); w0.y = pk2(v[2], v[3]); w0.z = pk2(v[4], v[5]); w0.w = pk2(v[6], v[7]); w1.x = pk2(v[8], v[9]); w1.y = pk2(v[10], v[11]); w1.z = pk2(v[12], v[13]); w1.w = pk2(v[14], v[15]);
            *(u32x4*)(t.dst + off * 2) = w0; *(u32x4*)(t.dst + off * 2 + 16) = w1; }
    }
}
constexpr int TR_N_IN = 16 * 65, TR_N_Q = 12 * 24, TR_N_K = 4 * 16, TR_N_V = 4 * 16, TR_N_SQ = 16 * 16, TR_N_GU = 32 * 16 * 32, TR_N_DN = 32 * 16 * 16;
constexpr int TR_NITEMS = TR_N_IN + TR_N_Q + TR_N_K + TR_N_V + 2 * TR_N_SQ + TR_N_GU + TR_N_DN;
__device__ __forceinline__ TrItem tr_decode(KArgP a, int it, int last) {
    unsigned char* ws = a->ws; TrItem t; t.rs = nullptr; t.cs = nullptr; t.perm = 0; t.fp8 = false; t.kperm = false; t.valid = it < last;
    if (!t.valid) it = 0;
    int r = it;
    if (r < TR_N_IN) { const int pb = r % 65; t.kb = r / 65; t.src = a->in[I_WIN]; t.Nsrc = IN_W; t.K = 1024;
        if (pb < 32) { t.dst = ws + WS_WIN8; t.pb = pb; t.lb = pb * 64; t.fp8 = true; }
        else if (pb < 64) { t.dst = ws + WS_WIN8; t.pb = pb; t.lb = pb * 64 + 64; t.fp8 = true; }
        else { t.dst = ws + WS_WKPE; t.pb = 0; t.lb = 2048; t.fp8 = true; }
        return t; } r -= TR_N_IN;
    if (r < TR_N_Q) { const int pb = r % 24; t.kb = r / 24; t.src = a->in[I_WQB]; t.Nsrc = NH * QKD; t.K = QL; t.dst = ws + WS_WQ; t.pb = pb; t.rs = a->in[I_GQA]; t.fp8 = true;
        if (pb < 16) t.lb = (pb >> 1) * QKD + (pb & 1) * 64; else { t.lb = (pb - 16) * QKD + NOPE; t.perm = 1; }
        return t; } r -= TR_N_Q;
    if (r < TR_N_K) { const int pb = r % 16; t.kb = r / 16; t.src = a->in[I_WKVB]; t.Nsrc = NH * 256; t.K = KVL; t.dst = ws + WS_WK; t.pb = pb; t.rs = a->in[I_GKVA]; t.lb = (pb >> 1) * 256 + (pb & 1) * 64; t.fp8 = true; return t; } r -= TR_N_K;
    if (r < TR_N_V) { const int pb = r % 16; t.kb = r / 16; t.src = a->in[I_WKVB]; t.Nsrc = NH * 256; t.K = KVL; t.dst = ws + WS_WV; t.pb = pb; t.rs = a->in[I_GKVA]; t.lb = (pb >> 1) * 256 + 128 + (pb & 1) * 64; t.fp8 = true; return t; } r -= TR_N_V;
    if (r < 2 * TR_N_SQ) { const int which = r / TR_N_SQ, q = r % TR_N_SQ; t.pb = q % 16; t.kb = q / 16; t.src = which == 0 ? a->in[I_WMO] : a->in[I_WOUT];
        t.dst = ws + (which == 0 ? WS_WMO : WS_WOUT); t.Nsrc = 1024; t.K = 1024; t.lb = t.pb * 64; return t; } r -= 2 * TR_N_SQ;
    if (r < TR_N_GU) { const int e = r / 512, q = r % 512; t.pb = q % 32; t.kb = q / 32; t.src = a->in[I_WGU] + (size_t)e * 1024 * 2048; t.Nsrc = 2048; t.K = 1024; t.dst = ws + WS_WGU + (size_t)e * 2048 * 1024; t.lb = t.pb * 64; t.perm = 2; t.fp8 = true; return t; } r -= TR_N_GU;
    { const int e = r / 256, q = r % 256; t.pb = q % 16; t.kb = q / 16; t.src = a->in[I_WDN] + (size_t)e * 1024 * 1024; t.Nsrc = 1024; t.K = 1024; t.dst = ws + WS_WDN + (size_t)e * 1024 * 1024; t.lb = t.pb * 64; t.fp8 = true; t.kperm = true; }
    return t;
}

constexpr int TR_EARLY = TR_NITEMS - TR_N_GU - TR_N_DN;
__device__ __forceinline__ void tr_range(KArgP a, LAS unsigned char* lds, int vcu, int G, int first, int last) {
    const int tid = tid_fresh(), lane = tid & 63, wave = __builtin_amdgcn_readfirstlane(tid >> 6);
    const int gw = first + vcu * 8 + wave, NGW = G * 8;
    f32x4 R0[16], R1[16];
    TrItem c0 = tr_decode(a, gw, last);
    if (c0.valid) tr_load(c0, R0, lane);
#pragma unroll 1
    for (int it = gw; it < last; it += 2 * NGW) {
        const TrItem c1 = tr_decode(a, it + NGW, last);
        if (c1.valid) tr_load(c1, R1, lane);
        tr_process(c0, R0, lane);
        c0 = tr_decode(a, it + 2 * NGW, last);
        if (c0.valid) tr_load(c0, R0, lane);
        if (c1.valid) tr_process(c1, R1, lane);
    }
}
__device__ __forceinline__ void p0_prep(KArgP a, LAS unsigned char* lds, int vcu, int G) {
    const int tid = tid_fresh(), lane = tid & 63, wave = __builtin_amdgcn_readfirstlane(tid >> 6);
    unsigned char* ws = a->ws;
    __syncthreads();
    for (int item = vcu; item < 128; item += G) {
        LAS float* cact = (LAS float*)lds;
        LAS float* part = (LAS float*)(lds + 32768);
        for (int i = tid; i < 8 * 1024; i += NTHREADS) { const float cv = a->in[I_C][i]; cact[i] = cv / (1.0f + __expf(-cv)); }
        __syncthreads();
        const bool isf = item >= 96; const float* W = isf ? a->in[I_WFMOD] : a->in[I_WMOD]; const int N = isf ? 2048 : 6144, j0 = (isf ? item - 96 : item) * 64;
        float acc[8];
#pragma unroll
        for (int b = 0; b < 8; ++b) acc[b] = 0.f;
        for (int k0 = wave * 128; k0 < wave * 128 + 128; k0 += 32) {
            float wv[32];
#pragma unroll
            for (int q = 0; q < 32; ++q) wv[q] = W[(size_t)(k0 + q) * N + j0 + lane];
#pragma unroll
            for (int q = 0; q < 32; ++q)
#pragma unroll
                for (int b = 0; b < 8; ++b) acc[b] += cact[b * 1024 + k0 + q] * wv[q]; }
#pragma unroll
        for (int b = 0; b < 8; ++b) part[(wave * 8 + b) * 64 + lane] = acc[b];
        __syncthreads();
        { const int b = tid >> 6, col = tid & 63; float s = 0.f;
#pragma unroll
            for (int w = 0; w < 8; ++w) s += part[(w * 8 + b) * 64 + col];
            if (isf) ((float*)(ws + WS_FMOD))[b * 2048 + j0 + col] = s + a->in[I_BFMOD][j0 + col];
            else ((float*)(ws + WS_MOD))[b * 6144 + j0 + col] = s + a->in[I_BMOD][j0 + col]; }
        __syncthreads();
    }
    { const int* pos = (const int*)a->in[I_POS]; f32x2* CS = (f32x2*)(ws + WS_CS);
        for (int idx = vcu * NTHREADS + tid; idx < T * 32; idx += G * NTHREADS) { const int t = idx >> 5, i = idx & 31;
            const double invf = exp(-(double)i * (9.210340371976184 / 32.0));
            const double ang = (double)pos[t] * invf; const double n = rint(ang * 0.15915494309189535); const float r = (float)(ang - n * 6.283185307179586);
            CS[idx] = (f32x2){__cosf(r), __sinf(r)}; } }
    { int* RT = (int*)(ws + WS_ROWTOK); for (int idx = vcu * NTHREADS + tid; idx < RT_MAX * 256; idx += G * NTHREADS) RT[idx] = 0; }
    { bf16_t* WR = (bf16_t*)(ws + WS_WR);
        for (int idx = vcu * NTHREADS + tid; idx < 1024 * 32; idx += G * NTHREADS) { const int e = idx & 31, k = idx >> 5; const float v = a->in[I_WR][idx];
            const unsigned h = pk2(v, 0.f) & 0xffffu; const float lo = v - bflo(h); WR[e * 1024 + k] = (bf16_t)h; WR[32768 + e * 1024 + k] = (bf16_t)(pk2(lo, 0.f) & 0xffffu); } }
    for (int item = vcu; item < 256; item += G) {
        const int kg8 = item >> 1, nb = (item & 1) * 512, g = kg8 >> 5, kl0 = (kg8 & 31) * 8;
        LAS float* wg8 = (LAS float*)lds;
        __syncthreads();
        for (int i = tid; i < 2048; i += NTHREADS) { const int kk = i >> 8, j = i & 255; wg8[j * 8 + kk] = a->in[I_WPG][(size_t)g * 65536 + (size_t)(kl0 + kk) * 256 + j] * a->in[I_PSCALE][g * 256 + j]; }
        __syncthreads();
        const int n = nb + tid; const float* wp = a->in[I_WPO] + (size_t)(g * 256) * 1024 + n;
        float acc[8];
#pragma unroll
        for (int i = 0; i < 8; ++i) acc[i] = 0.f;
        for (int j0 = 0; j0 < 256; j0 += 32) {
            float wv[32];
#pragma unroll
            for (int q = 0; q < 32; ++q) wv[q] = wp[(size_t)(j0 + q) * 1024];
#pragma unroll
            for (int q = 0; q < 32; ++q) { const f32x4 c0 = *(const LAS f32x4*)(wg8 + (j0 + q) * 8), c1 = *(const LAS f32x4*)(wg8 + (j0 + q) * 8 + 4);
#pragma unroll
                for (int i = 0; i < 4; ++i) { acc[i] += wv[q] * c0[i]; acc[4 + i] += wv[q] * c1[i]; } }
        }
        *(u32x4*)((bf16_t*)(ws + WS_WPO) + (size_t)n * 1024 + g * 256 + kl0) = pack8(acc);
        __syncthreads();
    }
    tr_range(a, lds, vcu, G, 0, TR_EARLY);
}

__device__ __forceinline__ void quad_transpose4(unsigned (&w)[4], int lane) {
    const bool o1 = lane & 1, o2 = lane & 2;
    { const unsigned s0 = o1 ? w[0] : w[1], s1 = o1 ? w[2] : w[3];
        const unsigned t0 = (unsigned)__builtin_amdgcn_mov_dpp((int)s0, 0xB1, 0xF, 0xF, true), t1 = (unsigned)__builtin_amdgcn_mov_dpp((int)s1, 0xB1, 0xF, 0xF, true);
        if (o1) { w[0] = t0; w[2] = t1; } else { w[1] = t0; w[3] = t1; } }
    { const unsigned s0 = o2 ? w[0] : w[2], s1 = o2 ? w[1] : w[3];
        const unsigned t0 = (unsigned)__builtin_amdgcn_mov_dpp((int)s0, 0x4E, 0xF, 0xF, true), t1 = (unsigned)__builtin_amdgcn_mov_dpp((int)s1, 0x4E, 0xF, 0xF, true);
        if (o2) { w[0] = t0; w[1] = t1; } else { w[2] = t0; w[3] = t1; } }
}
__device__ __forceinline__ void p1_hb(KArgP a, int vcu, int G) {
    const int tid = tid_fresh(), lane = tid & 63, wave = tid >> 6;
    const float* MOD = (const float*)(a->ws + WS_MOD); bf16_t* HB = (bf16_t*)(a->ws + WS_S0);
    for (int rb = vcu * 128; rb < T; rb += G * 128) {
        const int b = rb >> 12;
        f32x4 gs[4], sh[4];
#pragma unroll
        for (int j = 0; j < 4; ++j) { const int c = 4 * lane + 256 * j; const f32x4 g = *(const f32x4*)(a->in[I_GMIX] + c), sc = *(const f32x4*)(MOD + b * 6144 + 1024 + c);
            gs[j] = g * (sc + 1.0f); sh[j] = *(const f32x4*)(MOD + b * 6144 + c); }
#pragma unroll 1
        for (int i0 = 0; i0 < 16; i0 += 4) {
            f32x4 v[4][4];
#pragma unroll
            for (int q = 0; q < 4; ++q) { const f32x4* xr = (const f32x4*)(a->in[I_X] + (size_t)(rb + wave * 16 + i0 + q) * D) + lane;
#pragma unroll
                for (int j = 0; j < 4; ++j) v[q][j] = __builtin_nontemporal_load(xr + 64 * j); }
#pragma unroll
            for (int q = 0; q < 4; ++q) { const int r = rb + wave * 16 + i0 + q; float s = 0.f;
#pragma unroll
                for (int j = 0; j < 4; ++j) s += (v[q][j][0] * v[q][j][0] + v[q][j][1] * v[q][j][1]) + (v[q][j][2] * v[q][j][2] + v[q][j][3] * v[q][j][3]);
                const float rstd = rsqrtf(wave_sum(s) * (1.0f / D) + EPS);
                unsigned w[4];
#pragma unroll
                for (int j = 0; j < 4; ++j) { const f32x4 h = v[q][j] * rstd * gs[j] + sh[j]; w[j] = pk4_fp8(h[0], h[1], h[2], h[3]); }
                quad_transpose4(w, lane);
                *(u32x4*)(a->ws + WS_HB8 + (size_t)r * D + 16 * (lane >> 2) + 256 * (lane & 3)) = (u32x4){w[0], w[1], w[2], w[3]}; } }
    }
}

__device__ __forceinline__ void p3_kpe(KArgP a, LAS unsigned char* lds, int vcu, int G) {
    const int tid = tid_fresh(), lane = tid & 63, wave = tid >> 6, rr = lane & 15, g = lane >> 4;
    const unsigned char* HB8 = a->ws + WS_HB8; unsigned char* KPE = a->ws + WS_KPE; const f32x2* CS = (const f32x2*)(a->ws + WS_CS);
    __syncthreads();
    { const u32x4* src = (const u32x4*)(a->ws + WS_WKPE);
        for (int ch = tid; ch < 4096; ch += NTHREADS) { const int e = ch >> 6, kc = ch & 63; *(LAS u32x4*)(lds + e * 1024 + ((kc ^ (e & 15)) << 4)) = src[ch]; } }
    __syncthreads();
    const int sclX = SCALE_ONE, sclW = SCALE_W8;
    for (int rb = vcu * 128; rb < T; rb += G * 128) {
        const int r0 = rb + wave * 16;
        const unsigned char* hr = HB8 + (size_t)(r0 + rr) * D + 32 * g;
        f32x4 acc[4];
#pragma unroll
        for (int c = 0; c < 4; ++c) acc[c] = (f32x4){0.f, 0.f, 0.f, 0.f};
        v8i32 Ah[8];
#pragma unroll
        for (int s = 0; s < 8; ++s) Ah[s] = __builtin_shufflevector(*(const v4i32*)(hr + 128 * s), *(const v4i32*)(hr + 128 * s + 16), 0, 1, 2, 3, 4, 5, 6, 7);
#pragma unroll
        for (int s = 0; s < 8; ++s) { const int kc = 8 * s + 2 * g; v8i32 Bw[4];
#pragma unroll
            for (int c = 0; c < 4; ++c) { const LAS unsigned char* wr = lds + (16 * c + rr) * 1024;
                Bw[c] = __builtin_shufflevector(*(const LAS v4i32*)(wr + ((kc ^ rr) << 4)), *(const LAS v4i32*)(wr + (((kc + 1) ^ rr) << 4)), 0, 1, 2, 3, 4, 5, 6, 7); }
            __builtin_amdgcn_sched_barrier(0);
#pragma unroll
            for (int c = 0; c < 4; ++c)
                asm volatile("v_mfma_scale_f32_16x16x128_f8f6f4 %0, %1, %2, %0, %3, %4 op_sel_hi:[0,0,0]" : "+v"(acc[c]) : "v"(Ah[s]), "v"(Bw[c]), "v"(sclX), "v"(sclW)); }
        asm volatile("s_nop 15\n\ts_nop 15" : "+v"(acc[0]), "+v"(acc[1]), "+v"(acc[2]), "+v"(acc[3]));
#pragma unroll
        for (int reg = 0; reg < 4; ++reg) { const int t = r0 + 4 * g + reg;
#pragma unroll
            for (int c = 0; c < 2; ++c) { const int f = 16 * c + rr; const f32x2 cs = CS[(size_t)t * 32 + f]; const float x1 = acc[c][reg], x2 = acc[c + 2][reg];
                unsigned char* kp8 = KPE + (size_t)t * 64; kp8[f] = (unsigned char)(pk4_fp8(x1 * cs.x - x2 * cs.y, 0.f, 0.f, 0.f) & 0xffu); kp8[32 + f] = (unsigned char)(pk4_fp8(x2 * cs.x + x1 * cs.y, 0.f, 0.f, 0.f) & 0xffu); } }
    }
    __syncthreads();
}

__device__ __forceinline__ void p3_mixed(KArgP a, int vcu, int G) {
    const int tid = tid_fresh(); const bf16_t* U = (const bf16_t*)(a->ws + WS_S1); bf16_t* MX = (bf16_t*)(a->ws + WS_S0);
    for (int rb = vcu * 128; rb < T; rb += G * 128) {
        for (int q = 0; q < 2; ++q) { const int item = tid + NTHREADS * q, cgi = item & 127, seg = item >> 7;
            const int w = 2 << (cgi >> 5), row0 = rb + seg * 16, s0 = row0 & (SEQ - 1);
            const bf16_t* up = U + (size_t)row0 * D + cgi * 8;
            u32x4 R[31];
#pragma unroll
            for (int i = 0; i < 15; ++i) { R[i] = (u32x4){0u, 0u, 0u, 0u}; if (15 - i < w && s0 - (15 - i) >= 0) R[i] = *(const u32x4*)(up - (size_t)(15 - i) * D); }
#pragma unroll
            for (int i = 0; i < 16; ++i) R[15 + i] = *(const u32x4*)(up + (size_t)i * D);
            float sum[8];
#pragma unroll
            for (int j = 0; j < 8; ++j) sum[j] = 0.f;
#pragma unroll
            for (int i = 0; i < 15; ++i) { float f[8]; unpack8(R[i], f);
#pragma unroll
                for (int j = 0; j < 8; ++j) sum[j] += f[j]; }
#pragma unroll
            for (int i = 0; i < 16; ++i) { const int s = s0 + i; float cur[8]; unpack8(R[15 + i], cur);
                const float inv = 1.0f / (float)(s + 1 < w ? s + 1 : w); float o[8];
#pragma unroll
                for (int j = 0; j < 8; ++j) { sum[j] += cur[j]; o[j] = sum[j] * inv - cur[j]; }
                *(u32x4*)(MX + (size_t)(row0 + i) * D + cgi * 8) = pack8(o);
                const u32x4 dr = w == 2 ? R[15 + i - 1] : w == 4 ? R[15 + i - 3] : w == 8 ? R[15 + i - 7] : R[i]; float fd[8]; unpack8(dr, fd);
#pragma unroll
                for (int j = 0; j < 8; ++j) sum[j] -= fd[j]; }
        }
    }
}

typedef float f32x16 __attribute__((ext_vector_type(16)));
__device__ __forceinline__ float max3f(float a, float b, float c) { float r; asm("v_max3_f32 %0, %1, %2, %3" : "=v"(r) : "v"(a), "v"(b), "v"(c)); return r; }
constexpr int CV_NLOOP = 70;
constexpr float ATT_THR = 8.0f;
__device__ __forceinline__ int kperm(int r) { return (r & ~36) | ((r & 4) << 3) | ((r & 32) >> 3); }
__device__ __forceinline__ void attn_fast(KArgP a, LAS unsigned char* lds, int vcu, int G) {
    const int tid = tid_fresh(), lane = tid & 63, wid = __builtin_amdgcn_readfirstlane(tid >> 6), i32 = lane & 31, hi = lane >> 5;
    const bool isB = wid >= 4;
    const unsigned char* Q8 = a->ws + WS_Q; const unsigned char* KN8 = a->ws + WS_KN; const unsigned char* KPE8 = a->ws + WS_KPE; const unsigned char* VT = a->ws + WS_VT; bf16_t* O = (bf16_t*)(a->ws + WS_O);
    constexpr int KBUF = 12288, KP_OFF = 8192, KPAIR = 2 * KBUF, V_BASE = 2 * KPAIR, VBUF = 8192, VPAIR = 2 * VBUF;
    const int rK = 8 * wid + (lane >> 3); const unsigned srcK = (unsigned)(kperm(rK) * 1024 + (((lane & 7) ^ ((rK >> 1) & 7)) * 16));
    const int rP = 16 * (wid & 3) + (lane >> 2); const unsigned srcP = (unsigned)(kperm(rP) * 64 + (((lane & 3) ^ ((rP >> 2) & 3)) * 16));
    const int dV = 16 * wid + (lane >> 2); const size_t srcV = (size_t)dV * T + (size_t)(((lane & 3) ^ ((dV >> 2) & 3)) * 16);
    const int xk = (i32 >> 1) & 7, xq = (i32 >> 2) & 3;
    int koff[2][2], poff[2], voff[2];
#pragma unroll
    for (int s2 = 0; s2 < 2; ++s2)
#pragma unroll
        for (int c = 0; c < 2; ++c) koff[s2][c] = i32 * 128 + (((4 * s2 + 2 * hi + c) ^ xk) << 4);
#pragma unroll
    for (int c = 0; c < 2; ++c) { poff[c] = KP_OFF + i32 * 64 + (((2 * hi + c) ^ xq) << 4); voff[c] = V_BASE + i32 * 64 + (((2 * hi + c) ^ xq) << 4); }
    const unsigned lds0 = (unsigned)(size_t)lds;
    const int sclK = SCALE_ONE, sclQ = SCALE_Q8;
    const int nun = (G == 256) ? 4 : (NB * NH * 16 + G - 1) / G;
    const int trslot = (vcu >> 2) & 3;
    const int ncl = (G == 256) ? CV_NLOOP : 0;
    constexpr int CV_BASE = 98304;
    int cst = 0, cpr = 0;
#define CV_DECODE(n_) int r_ = (n_) * G + vcu; const bool gu_ = r_ < TR_N_GU; if (!gu_) r_ -= TR_N_GU; \
        const int e_ = gu_ ? r_ >> 9 : r_ >> 8, q_ = gu_ ? r_ & 511 : r_ & 255, pb_ = gu_ ? q_ & 31 : q_ & 15, kb_ = gu_ ? q_ >> 5 : q_ >> 4
#define CV_LANE() int ln_ = lane; asm volatile("" : "+v"(ln_)); const int cvp = 8 * wid + (ln_ >> 3), cvc = ln_ & 7
#define CV_READ() do { CV_LANE(); const int cvrd = (8 * cvc) * 256 + (((cvp >> 2) ^ (2 * cvc)) << 4) + (cvp & 3) * 4; const LAS float* sp_ = (const LAS float*)(lds + CV_BASE + (cpr % 3) * 16384 + cvrd); \
        _Pragma("unroll") for (int i_ = 0; i_ < 8; ++i_) cv[i_] = sp_[i_ * 64]; cvpend = true; } while (0)
#define CV_STORE() do { CV_DECODE(cpr); CV_LANE(); \
        const int ph_ = gu_ ? (cvp & ~7) + 4 * (cvp & 1) + ((cvp & 7) >> 1) : cvp; \
        unsigned char* dp_ = ws_b + (gu_ ? WS_WGU + (size_t)e_ * 2048 * 1024 : WS_WDN + (size_t)e_ * 1024 * 1024) + (size_t)(pb_ * 64 + ph_) * 1024 + kb_ * 64 + 8 * cvc; \
        const float f_ = gu_ ? ((cvp & 1) ? W8SCALE * GUCI : W8SCALE * GUC) : W8SCALE; \
        u32x2 w_; w_.x = pk4_fp8(cv[0] * f_, cv[1] * f_, cv[2] * f_, cv[3] * f_); w_.y = pk4_fp8(cv[4] * f_, cv[5] * f_, cv[6] * f_, cv[7] * f_); \
        *(u32x2*)dp_ = w_; ++cpr; cvpend = false; } while (0)
    const float* const wgu_s = a->in[I_WGU]; const float* const wdn_s = a->in[I_WDN]; unsigned char* const ws_b = a->ws;
    float cv[8]; bool cvpend = false;
#pragma unroll
    for (int i_ = 0; i_ < 8; ++i_) cv[i_] = 0.f;
    for (int ui = 0; ui < nun; ++ui) {
        if (ui == trslot && ui < 3) tr_range(a, lds, vcu, G, TR_EARLY + G * ncl, TR_NITEMS);
        int bh, qb;
        if (G == 256) { const int s4 = vcu & 3; bh = vcu >> 2; qb = ui == 0 ? 15 - s4 : ui == 1 ? 11 - s4 : ui == 2 ? s4 : 4 + s4; }
        else { const int it = vcu + ui * G; if (it >= NB * NH * 16) break; bh = it >> 4; qb = 15 - (it & 15); }
        const int b = bh >> 3, h = bh & 7, t0 = b * SEQ + qb * 256, NT = 4 * qb + 4, myjmax = 4 * qb + (wid >> 1);
        const unsigned char* gK = KN8 + (size_t)b * SEQ * 1024 + h * 128 + srcK; const unsigned char* gP = KPE8 + (size_t)b * SEQ * 64 + srcP; const unsigned char* gV = VT + (size_t)(h * 128) * T + (size_t)b * SEQ + srcV;
#define ATT_GLDS(gp, ldsoff) do { unsigned keep_; const unsigned dst_ = (unsigned)__builtin_amdgcn_readfirstlane((int)(lds0 + (unsigned)(ldsoff))); \
        asm volatile("s_mov_b32 %0, m0\n\ts_mov_b32 m0, %2\n\ts_nop 0\n\tglobal_load_lds_dwordx4 %1, off\n\ts_mov_b32 m0, %0" : "=&s"(keep_) : "v"(gp), "s"(dst_) : "memory"); } while (0)
#define ATT_STAGE(jp_, ko, vo) do { const size_t j0_ = (size_t)(2 * (jp_)); \
        ATT_GLDS(gK + j0_ * 65536, (ko) + wid * 1024); ATT_GLDS(gK + (j0_ + 1) * 65536, (ko) + KBUF + wid * 1024); \
        ATT_GLDS(gP + (j0_ + (wid >> 2)) * 4096, (ko) + (wid >> 2) * KBUF + KP_OFF + (wid & 3) * 1024); \
        ATT_GLDS(gV + j0_ * 64, V_BASE + (vo) + wid * 1024); ATT_GLDS(gV + (j0_ + 1) * 64, V_BASE + (vo) + VBUF + wid * 1024); } while (0)
#define ATT_LD2(p0_, p1_) __builtin_shufflevector(*(const LAS v4i32*)(p0_), *(const LAS v4i32*)(p1_), 0, 1, 2, 3, 4, 5, 6, 7)
#define ATT_PV(vo) do { const LAS unsigned char* vb_ = lds + (vo); \
        _Pragma("unroll") for (int d = 0; d < 4; ++d) { const v8i32 va_ = ATT_LD2(vb_ + voff[0] + d * 2048, vb_ + voff[1] + d * 2048); \
            asm volatile("s_nop 1\n\tv_mfma_scale_f32_32x32x64_f8f6f4 %0, %1, %2, %0, %3, %3 op_sel_hi:[0,0,0]" : "+v"(o[d]) : "v"(va_), "v"(pq), "v"(sclK)); } } while (0)
        ATT_STAGE(0, 0, 0);
        v8i32 qf[3];
        { const unsigned char* qp = Q8 + (size_t)(t0 + 32 * wid + i32) * (NH * QKD) + h * QKD + 32 * hi;
#pragma unroll
            for (int s2 = 0; s2 < 3; ++s2) qf[s2] = __builtin_shufflevector(*(const v4i32*)(qp + 64 * s2), *(const v4i32*)(qp + 64 * s2 + 16), 0, 1, 2, 3, 4, 5, 6, 7); }
        { const int qtouch = qf[0][0] ^ qf[0][4] ^ qf[1][0] ^ qf[1][4] ^ qf[2][0] ^ qf[2][4]; asm volatile("" :: "v"(qtouch)); }
        f32x16 o[4];
#pragma unroll
        for (int d = 0; d < 4; ++d)
#pragma unroll
            for (int r = 0; r < 16; ++r) o[d][r] = 0.f;
        v8i32 pq = (v8i32){0, 0, 0, 0, 0, 0, 0, 0};
        f32x16 negm;
#pragma unroll
        for (int r = 0; r < 16; ++r) negm[r] = 0.f;
        float m = 0.f, l = 0.f;
        int vprev = 0, vcur = 0, vnext = VPAIR;
        asm volatile("s_waitcnt vmcnt(0)" ::: "memory");
        __syncthreads();
        const int NP = NT >> 1;
        for (int jp = 0; jp <= NP; ++jp) {
            const int kop = (jp & 1) * KPAIR;
            if (jp + 1 < NP) ATT_STAGE(jp + 1, KPAIR - kop, vnext);
            if (cpr + 1 < cst) CV_READ();
            const bool cvnow = cst < ncl;
            if (cvnow) { CV_DECODE(cst); const int ns_ = gu_ ? 2048 : 1024;
                const float* gp_ = (gu_ ? wgu_s + (size_t)e_ * 1024 * 2048 : wdn_s + (size_t)e_ * 1024 * 1024) + (size_t)(gu_ ? kb_ * 64 + 8 * wid + (lane >> 4) : (kb_ >> 1) * 128 + ACT_SRC((kb_ & 1) * 64 + 8 * wid + (lane >> 4))) * ns_ + pb_ * 64 + 4 * ((lane & 15) ^ (2 * wid));
                const int so_ = CV_BASE + (cst % 3) * 16384 + wid * 2048;
                ATT_GLDS(gp_, so_); ATT_GLDS(gp_ + (gu_ ? 4 : 64) * ns_, so_ + 1024); ++cst; }
#pragma unroll
            for (int sub = 0; sub < 2; ++sub) {
                const int j = 2 * jp + sub, ko = kop + sub * KBUF;
                if (isB && j >= 1 && j - 1 <= myjmax && j - 1 < NT) ATT_PV(sub == 0 ? vprev + VBUF : vcur);
                if (j < NT && j <= myjmax) {
                    const LAS unsigned char* kb = lds + ko;
                    f32x16 p0, p1;
                    {   const v8i32 k00 = ATT_LD2(kb + koff[0][0], kb + koff[0][1]), k01 = ATT_LD2(kb + koff[0][0] + 4096, kb + koff[0][1] + 4096);
                        const v8i32 k10 = ATT_LD2(kb + koff[1][0], kb + koff[1][1]), k11 = ATT_LD2(kb + koff[1][0] + 4096, kb + koff[1][1] + 4096);
                        const v8i32 k20 = ATT_LD2(kb + poff[0], kb + poff[1]), k21 = ATT_LD2(kb + poff[0] + 2048, kb + poff[1] + 2048);
                        asm volatile("v_mfma_scale_f32_32x32x64_f8f6f4 %0, %1, %2, %3, %4, %5 op_sel_hi:[0,0,0]" : "=&v"(p0) : "v"(k00), "v"(qf[0]), "v"(negm), "v"(sclK), "v"(sclQ));
                        asm volatile("v_mfma_scale_f32_32x32x64_f8f6f4 %0, %1, %2, %3, %4, %5 op_sel_hi:[0,0,0]" : "=&v"(p1) : "v"(k01), "v"(qf[0]), "v"(negm), "v"(sclK), "v"(sclQ));
                        asm volatile("v_mfma_scale_f32_32x32x64_f8f6f4 %0, %1, %2, %0, %3, %4 op_sel_hi:[0,0,0]" : "+v"(p0) : "v"(k10), "v"(qf[1]), "v"(sclK), "v"(sclQ));
                        asm volatile("v_mfma_scale_f32_32x32x64_f8f6f4 %0, %1, %2, %0, %3, %4 op_sel_hi:[0,0,0]" : "+v"(p1) : "v"(k11), "v"(qf[1]), "v"(sclK), "v"(sclQ));
                        asm volatile("v_mfma_scale_f32_32x32x64_f8f6f4 %0, %1, %2, %0, %3, %4 op_sel_hi:[0,0,0]" : "+v"(p0) : "v"(k20), "v"(qf[2]), "v"(sclK), "v"(sclQ));
                        asm volatile("v_mfma_scale_f32_32x32x64_f8f6f4 %0, %1, %2, %0, %3, %4 op_sel_hi:[0,0,0]" : "+v"(p1) : "v"(k21), "v"(qf[2]), "v"(sclK), "v"(sclQ));
                    }
                    if (cvpend) CV_STORE();
                    asm volatile("s_nop 15\n\ts_nop 15" : "+v"(p0), "+v"(p1));
                    float mx;
                    { float ma = max3f(p0[0], p0[1], p1[0]), mb = max3f(p0[2], p0[3], p1[1]); ma = max3f(ma, p1[2], p1[3]);
    #pragma unroll
                        for (int r = 4; r < 16; r += 4) { ma = max3f(ma, p0[r], p0[r + 1]); mb = max3f(mb, p0[r + 2], p0[r + 3]); ma = max3f(ma, p1[r], p1[r + 1]); mb = max3f(mb, p1[r + 2], p1[r + 3]); }
                        mx = max3f(ma, mb, mb); }
                    mx = max3f(mx, __shfl_xor(mx, 32), mx);
                    if (j == 0) {
                        m = mx;
    #pragma unroll
                        for (int r = 0; r < 16; ++r) { p0[r] -= mx; p1[r] -= mx; negm[r] = -mx; }
                    } else if (__any(mx > ATT_THR)) {
                        const float dl = max3f(mx, 0.f, 0.f), alpha = __builtin_amdgcn_exp2f(-dl); m += dl; l *= alpha;
    #pragma unroll
                        for (int r = 0; r < 16; ++r) { p0[r] -= dl; p1[r] -= dl; negm[r] = -m; }
    #pragma unroll
                        for (int d = 0; d < 4; ++d)
    #pragma unroll
                            for (int r = 0; r < 16; ++r) o[d][r] *= alpha;
                    }
                    float ls = 0.f;
    #pragma unroll
                    for (int r = 0; r < 16; ++r) { p0[r] = __builtin_amdgcn_exp2f(p0[r]); p1[r] = __builtin_amdgcn_exp2f(p1[r]); ls += p0[r] + p1[r]; }
                    l += ls;
    #pragma unroll
                    for (int g4 = 0; g4 < 4; ++g4) {
                        pq[2 * g4] = (int)pk4_fp8(p0[4 * g4], p0[4 * g4 + 1], p0[4 * g4 + 2], p0[4 * g4 + 3]);
                        pq[2 * g4 + 1] = (int)pk4_fp8(p1[4 * g4], p1[4 * g4 + 1], p1[4 * g4 + 2], p1[4 * g4 + 3]); }
                    if (!isB) ATT_PV(vcur + sub * VBUF);
                }
            }
            if (cvpend) CV_STORE();
            vprev = vcur; vcur = vnext; vnext = (vnext == 2 * VPAIR) ? 0 : vnext + VPAIR;
            if (cvnow) asm volatile("s_waitcnt vmcnt(2)" ::: "memory");
            else asm volatile("s_waitcnt vmcnt(0)" ::: "memory");
            __syncthreads();
        }
#undef ATT_STAGE
#undef ATT_PV
#undef ATT_LD2
        l += __shfl_xor(l, 32);
        const float il = __builtin_amdgcn_rcpf(l);
        bf16_t* op = O + (size_t)(t0 + 32 * wid + i32) * D + h * 128 + 8 * hi;
#pragma unroll
        for (int d = 0; d < 4; ++d) {
            u32x2 wv[4];
#pragma unroll
            for (int g4 = 0; g4 < 4; ++g4) { wv[g4].x = pk2(o[d][4 * g4] * il, o[d][4 * g4 + 1] * il); wv[g4].y = pk2(o[d][4 * g4 + 2] * il, o[d][4 * g4 + 3] * il); }
#pragma unroll
            for (int k = 0; k < 4; k += 2) {
                const auto r0 = __builtin_amdgcn_permlane32_swap(wv[k].x, wv[k + 1].x, false, false), r1 = __builtin_amdgcn_permlane32_swap(wv[k].y, wv[k + 1].y, false, false);
                *(u32x4*)(op + 32 * d + 8 * k) = (u32x4){(unsigned)r0[0], (unsigned)r1[0], (unsigned)r0[1], (unsigned)r1[1]}; } }
    }
    asm volatile("s_waitcnt vmcnt(0)" ::: "memory");
    __syncthreads();
    while (cpr < cst) { CV_READ(); CV_STORE(); }
#undef CV_READ
#undef CV_LANE
#undef CV_STORE
#undef CV_DECODE
#undef ATT_GLDS
    if (trslot >= 3 || trslot >= nun) tr_range(a, lds, vcu, G, TR_EARLY + G * ncl, TR_NITEMS);
    __syncthreads();
}

__device__ __forceinline__ void p7_router(KArgP a, LAS unsigned char* lds, int vcu, int G) {
    const int tid = tid_fresh(), lane = tid & 63, wave = tid >> 6, rr = lane & 15, g = lane >> 4;
    const float* MOD = (const float*)(a->ws + WS_MOD); const bf16_t* X1 = (const bf16_t*)(a->ws + WS_X1B); bf16_t* H2 = (bf16_t*)(a->ws + WS_S0);
    int* TKI = (int*)(a->ws + WS_TKI); float* TKW = (float*)(a->ws + WS_TKW); int* RANK = (int*)(a->ws + WS_RANK); int* COUNTS = (int*)(a->ws + WS_COUNTS);
    LAS int* cnt = (LAS int*)(lds + 131072);
    __syncthreads();
    { const u32x4* src = (const u32x4*)(a->ws + WS_WR);
        for (int ch = tid; ch < 8192; ch += NTHREADS) { const int hl = ch >> 12, e = (ch >> 7) & 31, kc = ch & 127;
            *(LAS u32x4*)(lds + hl * 65536 + e * 2048 + ((kc ^ (e & 15)) << 4)) = src[ch]; } }
    for (int rb = vcu * 128; rb < T; rb += G * 128) {
        if (tid < 32) cnt[tid] = 0;
        __syncthreads();
        const int r0 = rb + wave * 16, b = rb >> 12, row = r0 + rr;
        const bf16_t* xr = X1 + (size_t)row * D + 16 * g;
        float ss;
        { const f32x4* pq = (const f32x4*)((const float*)(a->ws + WS_PSQX) + (size_t)row * 16); const f32x4 q0 = pq[0], q1 = pq[1], q2 = pq[2], q3 = pq[3];
            ss = (((q0[0] + q0[1]) + (q0[2] + q0[3])) + ((q1[0] + q1[1]) + (q1[2] + q1[3]))) + (((q2[0] + q2[1]) + (q2[2] + q2[3])) + ((q3[0] + q3[1]) + (q3[2] + q3[3]))); }
        const float rstd = rsqrtf(ss * (1.0f / D) + EPS);
        f32x4 acc0 = (f32x4){0.f, 0.f, 0.f, 0.f}, acc1 = acc0;
        LAS float* mgs = (LAS float*)(lds + 131072 + 1024); LAS float* msh = mgs + 1024;
        for (int i = tid; i < 1024; i += NTHREADS) { mgs[i] = a->in[I_GFFN][i] * (MOD[b * 6144 + 4 * 1024 + i] + 1.0f); msh[i] = MOD[b * 6144 + 3 * 1024 + i]; }
        __syncthreads();
#pragma unroll 1
        for (int sh_ = 0; sh_ < 2; ++sh_) {
        u32x4 xv[16]; u32x4 h2w = (u32x4){0u, 0u, 0u, 0u};
#pragma unroll
        for (int q = 0; q < 16; ++q) xv[q] = *(const u32x4*)(xr + 64 * (8 * sh_ + (q >> 1)) + 8 * (q & 1));
#pragma unroll
        for (int q = 0; q < 16; ++q) { const int s = 16 * sh_ + q;
            float xf[8]; unpack8(xv[q], xf); const f32x4 x0 = (f32x4){xf[0], xf[1], xf[2], xf[3]}, x1 = (f32x4){xf[4], xf[5], xf[6], xf[7]};
            const int c0_ = 64 * (s >> 1) + 16 * g + 8 * (s & 1);
            const LAS float* gp = mgs + c0_; const LAS float* sp = msh + c0_;
            const f32x4 h0 = x0 * rstd * *(const LAS f32x4*)gp + *(const LAS f32x4*)sp, h1 = x1 * rstd * *(const LAS f32x4*)(gp + 4) + *(const LAS f32x4*)(sp + 4);
            u32x4 hi; hi.x = pk2(h0[0], h0[1]); hi.y = pk2(h0[2], h0[3]); hi.z = pk2(h1[0], h1[1]); hi.w = pk2(h1[2], h1[3]);
            { const unsigned qa = pk4_fp8(h0[0], h0[1], h0[2], h0[3]), qb = pk4_fp8(h1[0], h1[1], h1[2], h1[3]);
                if (q & 1) { h2w.z = qa; h2w.w = qb; *(u32x4*)((unsigned char*)H2 + (size_t)row * D + 64 * (s >> 1) + 16 * g) = h2w; } else { h2w.x = qa; h2w.y = qb; } }
            float hf[8]; unpack8(hi, hf);
            u32x4 lo; lo.x = pk2(h0[0] - hf[0], h0[1] - hf[1]); lo.y = pk2(h0[2] - hf[2], h0[3] - hf[3]); lo.z = pk2(h1[0] - hf[4], h1[1] - hf[5]); lo.w = pk2(h1[2] - hf[6], h1[3] - hf[7]);
            const bf16x8 Ah = __builtin_bit_cast(bf16x8, hi), Al = __builtin_bit_cast(bf16x8, lo);
            const int kc = 8 * (s >> 1) + 2 * g + (s & 1);
            const bf16x8 Bh0 = *(const LAS bf16x8*)(lds + rr * 2048 + ((kc ^ rr) << 4)), Bh1 = *(const LAS bf16x8*)(lds + (16 + rr) * 2048 + ((kc ^ rr) << 4));
            const bf16x8 Bl0 = *(const LAS bf16x8*)(lds + 65536 + rr * 2048 + ((kc ^ rr) << 4)), Bl1 = *(const LAS bf16x8*)(lds + 65536 + (16 + rr) * 2048 + ((kc ^ rr) << 4));
            acc0 = __builtin_amdgcn_mfma_f32_16x16x32_bf16(Ah, Bh0, acc0, 0, 0, 0); acc0 = __builtin_amdgcn_mfma_f32_16x16x32_bf16(Al, Bh0, acc0, 0, 0, 0); acc0 = __builtin_amdgcn_mfma_f32_16x16x32_bf16(Ah, Bl0, acc0, 0, 0, 0);
            acc1 = __builtin_amdgcn_mfma_f32_16x16x32_bf16(Ah, Bh1, acc1, 0, 0, 0); acc1 = __builtin_amdgcn_mfma_f32_16x16x32_bf16(Al, Bh1, acc1, 0, 0, 0); acc1 = __builtin_amdgcn_mfma_f32_16x16x32_bf16(Ah, Bl1, acc1, 0, 0, 0);
        }
        }
        const float br0 = a->in[I_BR][rr], br1 = a->in[I_BR][16 + rr];
#pragma unroll
        for (int reg = 0; reg < 4; ++reg) {
            float v0 = acc0[reg] + br0, v1 = acc1[reg] + br1; float tv[4]; int ti[4];
#pragma unroll
            for (int k = 0; k < 4; ++k) {
                float bv = v0; int bi = rr; if (v1 > bv) { bv = v1; bi = 16 + rr; }
#pragma unroll
                for (int o = 1; o < 16; o <<= 1) { const float ov = __shfl_xor(bv, o); const int oi = __shfl_xor(bi, o); if (ov > bv || (ov == bv && oi < bi)) { bv = ov; bi = oi; } }
                tv[k] = bv; ti[k] = bi; if (bi == rr) v0 = -INFINITY; if (bi == 16 + rr) v1 = -INFINITY;
            }
            if (rr == 0) { const int t = r0 + 4 * g + reg;
                const float e1 = __expf(tv[1] - tv[0]), e2 = __expf(tv[2] - tv[0]), e3 = __expf(tv[3] - tv[0]), inv = 1.0f / (1.0f + e1 + e2 + e3);
                *(f32x4*)(TKW + (size_t)t * 4) = (f32x4){inv, e1 * inv, e2 * inv, e3 * inv};
                int rk[4];
#pragma unroll
                for (int k = 0; k < 4; ++k) rk[k] = __hip_atomic_fetch_add(cnt + ti[k], 1, __ATOMIC_RELAXED, __HIP_MEMORY_SCOPE_WORKGROUP);
                *(u32x4*)(TKI + (size_t)t * 4) = (u32x4){(unsigned)ti[0], (unsigned)ti[1], (unsigned)ti[2], (unsigned)ti[3]};
                *(u32x4*)(RANK + (size_t)t * 4) = (u32x4){(unsigned)rk[0], (unsigned)rk[1], (unsigned)rk[2], (unsigned)rk[3]}; }
        }
        __syncthreads();
        if (tid < 32) COUNTS[(rb >> 7) * 32 + tid] = cnt[tid];
        __syncthreads();
    }
}

__device__ __forceinline__ void p8_scatter(KArgP a, LAS unsigned char* lds, int vcu, int G) {
    const int tid = tid_fresh(), lane = tid & 63, wave = tid >> 6;
    const int* COUNTS = (const int*)(a->ws + WS_COUNTS); const int* TKI = (const int*)(a->ws + WS_TKI); const float* TKW = (const float*)(a->ws + WS_TKW); const int* RANK = (const int*)(a->ws + WS_RANK);
    int* SLOTROW = (int*)(a->ws + WS_SLOTROW); float* ROWW = (float*)(a->ws + WS_ROWW); int* TILEE = (int*)(a->ws + WS_TILEE);
    int* ROWTOK = (int*)(a->ws + WS_ROWTOK);
    LAS int* ptot = (LAS int*)lds;
    LAS int* pbef = ptot + 512;
    LAS int* base = pbef + 512;
    for (int rb = vcu * 128; rb < T; rb += G * 128) {
        const int blk = rb >> 7;
        __syncthreads();
        { const int e = tid & 31, pt = tid >> 5; int st = 0, sb = 0;
            for (int bb = pt * 16; bb < pt * 16 + 16; ++bb) { const int cv = COUNTS[bb * 32 + e]; st += cv; if (bb < blk) sb += cv; }
            ptot[pt * 32 + e] = st; pbef[pt * 32 + e] = sb; }
        __syncthreads();
        if (tid < 64) {
            const int e = tid & 31; int tot = 0, bef = 0;
#pragma unroll
            for (int pt = 0; pt < 16; ++pt) { tot += ptot[pt * 32 + e]; bef += pbef[pt * 32 + e]; }
            const int ntl = (tot + 255) >> 8; int inc = ntl << 8;
#pragma unroll
            for (int d = 1; d < 32; d <<= 1) { const int o = __shfl_up(inc, d, 32); if (e >= d) inc += o; }
            const int ps = inc - (ntl << 8);
            if (tid < 32) { base[e] = ps + bef;
                if (blk == 0) { for (int q = 0; q < ntl; ++q) TILEE[(ps >> 8) + q] = e;
                    if (e == 31) TILEE[1023] = inc >> 8; } } }
        __syncthreads();
        { const int t = rb + (tid >> 2), k = tid & 3;
            const int e = TKI[(size_t)t * 4 + k], dest = base[e] + RANK[(size_t)t * 4 + k];
            SLOTROW[(size_t)t * 4 + k] = dest; ROWW[dest] = TKW[(size_t)t * 4 + k]; ROWTOK[dest] = t; }
    }
    __syncthreads();
}

__device__ __forceinline__ void p11_final(KArgP a, int vcu, int G) {
    const int tid = tid_fresh(), lane = tid & 63, wave = tid >> 6;
    const float* MOD = (const float*)(a->ws + WS_MOD); const float* FMOD = (const float*)(a->ws + WS_FMOD); const int* SLOTROW = (const int*)(a->ws + WS_SLOTROW);
    const bf16_t* Y = (const bf16_t*)(a->ws + WS_XS); float* OUT = a->out; const bf16_t* X1 = (const bf16_t*)(a->ws + WS_X1B);
    for (int rb = vcu * 128; rb < T; rb += G * 128) {
        const int b = rb >> 12;
        f32x4 g2[4], gs[4], sh[4];
#pragma unroll
        for (int j = 0; j < 4; ++j) { const int c = 4 * lane + 256 * j; g2[j] = *(const f32x4*)(MOD + b * 6144 + 5 * 1024 + c) * (1.0f / YSCALE);
            gs[j] = *(const f32x4*)(a->in[I_GFIN] + c) * (*(const f32x4*)(FMOD + b * 2048 + 1024 + c) + 1.0f); sh[j] = *(const f32x4*)(FMOD + b * 2048 + c); }
        const int ywi = ((lane >> 3) & 3) * 16 + ((lane >> 1) & 3) * 4 + (lane >> 5) * 2 + (lane & 1);
        u32x4 srl = (u32x4){0u, 0u, 0u, 0u};
        if (lane < 16) srl = *(const u32x4*)(SLOTROW + (size_t)(rb + wave * 16 + lane) * 4);
#pragma unroll 1
        for (int i0 = 0; i0 < 16; i0 += 2) {
            int yw[2][4][4]; u32x2 xw[2][4];
#pragma unroll
            for (int q = 0; q < 2; ++q) { const int t = rb + wave * 16 + i0 + q; const u32x2* x1r = (const u32x2*)(X1 + (size_t)t * D) + lane;
                unsigned sr[4];
#pragma unroll
                for (int k = 0; k < 4; ++k) sr[k] = (unsigned)__builtin_amdgcn_readlane((int)srl[k], i0 + q);
#pragma unroll
                for (int j = 0; j < 4; ++j) {
#pragma unroll
                    for (int k = 0; k < 4; ++k) yw[q][j][k] = *((const int*)((const unsigned char*)Y + (size_t)sr[k] * D) + ywi + 64 * j);
                    xw[q][j] = x1r[64 * j]; } }
#pragma unroll
            for (int q = 0; q < 2; ++q) { const int t = rb + wave * 16 + i0 + q; f32x4* xr = (f32x4*)(OUT + (size_t)t * D) + lane; f32x4 v[4]; float s = 0.f;
#pragma unroll
                for (int j = 0; j < 4; ++j) { f32x4 mo = (f32x4){0.f, 0.f, 0.f, 0.f};
#pragma unroll
                    for (int k = 0; k < 4; ++k) { const int w = yw[q][j][k]; const f32x2 lo = __builtin_amdgcn_cvt_pk_f32_fp8(w, false), hi2 = __builtin_amdgcn_cvt_pk_f32_fp8(w, true);
                        mo[0] += lo.x; mo[1] += lo.y; mo[2] += hi2.x; mo[3] += hi2.y; }
                    v[j] = (f32x4){bflo(xw[q][j].x), bfhi(xw[q][j].x), bflo(xw[q][j].y), bfhi(xw[q][j].y)} + g2[j] * mo; s += (v[j][0] * v[j][0] + v[j][1] * v[j][1]) + (v[j][2] * v[j][2] + v[j][3] * v[j][3]); }
                const float rstd = rsqrtf(wave_sum(s) * (1.0f / D) + EPS);
#pragma unroll
                for (int j = 0; j < 4; ++j) __builtin_nontemporal_store(v[j] * rstd * gs[j] + sh[j], xr + 64 * j); } }
    }
}

#define RLX_AGENT __ATOMIC_RELAXED, __HIP_MEMORY_SCOPE_AGENT
#define XB_TMO      128
#define XB_XCNT(j)  (256  + 64 * (j))
#define XB_XSUB(j)  (1280 + 64 * (j))
#define XB_XGEN(j)  (2304 + 64 * (j))
#define XB_TOP      3328
#define XB_TOPGEN   3392
#define XCD_BAR_WORDS 3456
#define XB_SPIN_CAP (1u << 18)
__device__ __forceinline__ unsigned xb_ld(unsigned* p)              { return __hip_atomic_load(p, __ATOMIC_RELAXED, __HIP_MEMORY_SCOPE_AGENT); }
__device__ __forceinline__ unsigned xb_add(unsigned* p, unsigned v) { return __hip_atomic_fetch_add(p, v, __ATOMIC_RELAXED, __HIP_MEMORY_SCOPE_AGENT); }
__device__ __forceinline__ unsigned xb_xcc_id() { return (unsigned)__builtin_amdgcn_s_getreg((3 << 11) | 20) & 0xFu; }
#define XB_SPIN(cond, bar) do { unsigned _sp = 0; while (cond) { __builtin_amdgcn_s_sleep(1); \
    if ((++_sp & 255u) == 0u) { if (xb_ld(&(bar)[XB_TMO])) break; if (_sp > XB_SPIN_CAP) { atomicAdd(&(bar)[XB_TMO], 1u); break; } } } } while (0)
struct XcdBarrier { unsigned* bar; unsigned x; volatile LAS unsigned* st; };
__device__ __forceinline__ XcdBarrier xcd_barrier_post(unsigned* bar, volatile LAS unsigned* st) {
    XcdBarrier b; b.bar = bar; b.x = xb_xcc_id(); b.st = st;
    if (threadIdx.x == 0) (void)xb_add(&bar[XB_XCNT(b.x)], 1u);
    return b;
}
__device__ __forceinline__ void xcd_barrier_complete(unsigned* bar, unsigned x, unsigned& nloc, unsigned& nx) {
    const unsigned G = gridDim.x * gridDim.y * gridDim.z;
    unsigned sum, cnt, mine, sp = 0u;
    for (;;) {
        sum = 0u; cnt = 0u; mine = 0u;
#pragma unroll
        for (unsigned j = 0; j < 16; ++j) { const unsigned c = xb_ld(&bar[XB_XCNT(j)]); sum += c; cnt += (c > 0u) ? 1u : 0u; mine = (j == x) ? c : mine; }
        if (sum == G) break;
        __builtin_amdgcn_s_sleep(1);
        if ((++sp & 255u) == 0u) { if (xb_ld(&bar[XB_TMO])) break; if (sp > XB_SPIN_CAP) { atomicAdd(&bar[XB_TMO], 1u); break; } }
    }
    nloc = mine > 0u ? mine : 1u; nx = cnt > 0u ? cnt : 1u;
}
__device__ __forceinline__ void xcd_barrier(const XcdBarrier& b) {
    asm volatile("s_waitcnt vmcnt(0)" ::: "memory");
    __syncthreads();
    if (threadIdx.x == 0) {
        unsigned* bar = b.bar;
        __builtin_amdgcn_s_waitcnt(0);
        unsigned nloc = b.st[0], nx = b.st[1];
        if (nloc == 0u) { xcd_barrier_complete(bar, b.x, nloc, nx); b.st[0] = nloc; b.st[1] = nx; }
        const unsigned old = xb_add(&bar[XB_XSUB(b.x)], 1u);
        const unsigned gen = old / nloc;
        if (old + 1u == (gen + 1u) * nloc) {
            __builtin_amdgcn_fence(__ATOMIC_RELEASE, "agent");
            asm volatile("s_waitcnt vmcnt(0)" ::: "memory");
            const unsigned og = xb_add(&bar[XB_TOP], 1u);
            const unsigned tg = og / nx;
            if (og + 1u == (tg + 1u) * nx) xb_add(&bar[XB_TOPGEN], 1u);
            else XB_SPIN(xb_ld(&bar[XB_TOPGEN]) == tg, bar);
            __builtin_amdgcn_fence(__ATOMIC_ACQUIRE, "agent");
            xb_add(&bar[XB_XGEN(b.x)], 1u);
            asm volatile("s_waitcnt vmcnt(0)" ::: "memory");
        } else {
            XB_SPIN(xb_ld(&bar[XB_XGEN(b.x)]) == gen, bar);
            __builtin_amdgcn_fence(__ATOMIC_ACQUIRE, "agent");
            asm volatile("s_waitcnt vmcnt(0)" ::: "memory");
        }
    }
    __syncthreads();
}

__global__ void __launch_bounds__(NTHREADS, 2) mk_fwd(Args a_) {
    extern __shared__ __attribute__((aligned(16))) unsigned char lds_raw[];
    LAS unsigned char* lds = (LAS unsigned char*)lds_raw;
    const int G = gridDim.x, bx = blockIdx.x; const int vcu = (G % 8 == 0) ? (bx % 8) * (G / 8) + bx / 8 : bx;
    KArgP a = (KArgP)__builtin_amdgcn_kernarg_segment_ptr();
    const int lo = a->ph_lo, hi = a->ph_hi;
    volatile LAS unsigned* misc = (volatile LAS unsigned*)(lds + LDS_BYTES - 64);
    if (threadIdx.x < 16) misc[threadIdx.x] = 0u;
    __syncthreads();
    XcdBarrier xbar; xbar.bar = (unsigned*)a->ws + 1024; xbar.x = 0; xbar.st = misc;
#if ONE_LAUNCH
    xbar = xcd_barrier_post((unsigned*)a->ws + 1024, misc);
    if (lo < 0) cg::this_grid().sync();
#endif
#define PHASE_ARGS() asm volatile("" : "+s"(a)); unsigned char* ws = a->ws; (void)ws
#ifndef REPEAT_MASK
#define REPEAT_MASK 0
#endif
#define REPS(k) ((((REPEAT_MASK) >> (k)) & 1) ? 2 : 1)
#ifndef PHASE_MASK
#define PHASE_MASK 0xFFF
#endif
#define IN(k) ((((PHASE_MASK) >> (k)) & 1) && lo <= (k) && (k) < hi)
#if ONE_LAUNCH
#ifndef SYNC_REPEAT
#define SYNC_REPEAT 1
#endif
#define SEAM(k) do { if (IN(k) && IN((k) + 1)) { for (int _r = 0; _r < SYNC_REPEAT; ++_r) { xcd_barrier(xbar); } } } while (0)
#else
#define SEAM(k) do { } while (0)
#endif
    for (int _rep = 0; _rep < REPS(0); ++_rep) if (IN(0)) { PHASE_ARGS(); p0_prep(a, lds, vcu, G); } SEAM(0);
    for (int _rep = 0; _rep < REPS(1); ++_rep) if (IN(1)) { PHASE_ARGS(); p1_hb(a, vcu, G); } SEAM(1);
    for (int _rep = 0; _rep < REPS(2); ++_rep) if (IN(2)) { PHASE_ARGS();
        EpiIn E{(bf16_t*)(ws + WS_S1), (bf16_t*)(ws + WS_QLAT), (bf16_t*)(ws + WS_KVLAT), (bf16_t*)(ws + WS_KPE), (bf16_t*)(ws + WS_GATES), (float*)(ws + WS_PSQQ), (float*)(ws + WS_PSQKV), a->in[I_BGATE], (const f32x2*)(ws + WS_CS), 0};
        { Gemm g{(const bf16_t*)(ws + WS_HB8), (const bf16_t*)(ws + WS_WIN8), D, D, D, nullptr, SCALE_ONE, SCALE_W8}; DenseSched S; S.init(T / 256, 16, G, bx, D, D, 0, 1);
            gemm_phase<EpiIn, DenseSched, false, true>(lds, g, S, E); }
    } SEAM(2);
    for (int _rep = 0; _rep < REPS(3); ++_rep) if (IN(3)) { PHASE_ARGS();
        for (int _q = 0; _q < ((P3REP & 1) ? 2 : 1); ++_q) p3_kpe(a, lds, vcu, G);
        for (int _q = 0; _q < ((P3REP & 2) ? 2 : 1); ++_q) p3_mixed(a, vcu, G);
        { Gemm g{(const bf16_t*)(ws + WS_QLAT), (const bf16_t*)(ws + WS_WQ), QL, QL, QL, nullptr, SCALE_ONE, SCALE_W8}; DenseSched S; S.init(T / 256, 6, G, bx, QL, QL, 0, 1);
            EpiQ E{(bf16_t*)(ws + WS_Q), (const float*)(ws + WS_PSQQ), (const f32x2*)(ws + WS_CS)}; for (int _q = 0; _q < ((P3REP & 4) ? 2 : 1); ++_q) gemm_phase<EpiQ, DenseSched, false, true>(lds, g, S, E); }
        { Gemm g{(const bf16_t*)(ws + WS_KVLAT), (const bf16_t*)(ws + WS_WK), KVL, KVL, KVL, nullptr, SCALE_ONE, SCALE_W8}; DenseSched S; S.init(T / 256, 4, G, bx, KVL, KVL, 0, 1);
            EpiK E{(bf16_t*)(ws + WS_KN), (const float*)(ws + WS_PSQKV)}; for (int _q = 0; _q < ((P3REP & 8) ? 2 : 1); ++_q) gemm_phase<EpiK, DenseSched, false, true>(lds, g, S, E); }
        { Gemm g{(const bf16_t*)(ws + WS_WV), (const bf16_t*)(ws + WS_KVLAT), KVL, KVL, KVL, nullptr, SCALE_W8, SCALE_ONE}; DenseSched S; S.init(4, T / 256, G, bx, KVL, KVL, 0, 1);
            EpiVT E{(bf16_t*)(ws + WS_VT), (const float*)(ws + WS_PSQKV)}; for (int _q = 0; _q < ((P3REP & 16) ? 2 : 1); ++_q) gemm_phase<EpiVT, DenseSched, false, true>(lds, g, S, E); }
    } SEAM(3);
    for (int _rep = 0; _rep < REPS(4); ++_rep) if (IN(4)) { PHASE_ARGS();
        attn_fast(a, lds, vcu, G);
    } SEAM(4);
    for (int _rep = 0; _rep < REPS(5); ++_rep) if (IN(5)) { PHASE_ARGS();
        DualSched S; S.B.init(T / 256, 4, G, bx, D, D, 0); S.a2 = (unsigned)(WS_O - WS_S0); S.b2 = (unsigned)(WS_WMO - WS_WPO);
        Gemm g{(const bf16_t*)(ws + WS_S0), (const bf16_t*)(ws + WS_WPO), D, D, D, nullptr, 0, 0}; EpiMergeDual E{(bf16_t*)(ws + WS_S1), (const bf16_t*)(ws + WS_GATES)}; gemm_phase(lds, g, S, E);
    } SEAM(5);
    for (int _rep = 0; _rep < REPS(6); ++_rep) if (IN(6)) { PHASE_ARGS();
        Gemm g{(const bf16_t*)(ws + WS_S1), (const bf16_t*)(ws + WS_WOUT), D, D, D, nullptr, 0, 0}; DenseSched S; S.init(T / 256, 4, G, bx, D, D, 0);
        EpiOut E{a->in[I_X], (bf16_t*)(ws + WS_X1B), (const float*)(ws + WS_MOD), (float*)(ws + WS_PSQX)}; gemm_phase(lds, g, S, E);
    } SEAM(6);
    for (int _rep = 0; _rep < REPS(7); ++_rep) if (IN(7)) { PHASE_ARGS(); p7_router(a, lds, vcu, G); } SEAM(7);
    for (int _rep = 0; _rep < REPS(8); ++_rep) if (IN(8)) { PHASE_ARGS(); p8_scatter(a, lds, vcu, G); } SEAM(8);
    for (int _rep = 0; _rep < REPS(9); ++_rep) if (IN(9)) { PHASE_ARGS();
        Gemm g{(const bf16_t*)(ws + WS_S0), (const bf16_t*)(ws + WS_WGU), D, D, D, (const int*)(ws + WS_ROWTOK), SCALE_ONE, SCALE_W8}; MoeSched S; S.init(moe_table_to_lds((const int*)(ws + WS_TILEE), lds), 8, G, bx, D, D, 1);
        EpiGU E{(bf16_t*)(ws + WS_ACT), a->in[I_BGU]}; gemm_phase<EpiGU, MoeSched, true, true>(lds, g, S, E, SKEW_MOE);
    } SEAM(9);
    for (int _rep = 0; _rep < REPS(10); ++_rep) if (IN(10)) { PHASE_ARGS();
        Gemm g{(const bf16_t*)(ws + WS_ACT), (const bf16_t*)(ws + WS_WDN), D, D, D, nullptr, SCALE_ONE, SCALE_W8}; MoeSched S; S.init(moe_table_to_lds((const int*)(ws + WS_TILEE), lds), 4, G, bx, D, D, 1);
        EpiDown E{(bf16_t*)(ws + WS_XS), a->in[I_BDN], (const float*)(ws + WS_ROWW)}; gemm_phase<EpiDown, MoeSched, false, true>(lds, g, S, E, SKEW_MOE);
    } SEAM(10);
    for (int _rep = 0; _rep < REPS(11); ++_rep) if (IN(11)) { PHASE_ARGS(); p11_final(a, vcu, G); }
#undef IN
#undef SEAM
}

constexpr int NPHASES = 12;
extern "C" void kernel_launch(void* const* d_in, const int* in_sizes, int n_in, void* d_out, int out_size, void* d_ws, size_t ws_size, hipStream_t stream) {
    static int grid = 0;
    if (grid == 0) {
        if (n_in != 27 || out_size != T * D || ws_size < WS_END) { fprintf(stderr, "kernel_launch: unexpected problem (n_in %d out %d ws %zu)\n", n_in, out_size, ws_size); grid = -1; return; }
        int dev = 0, cus = 0, per_cu = 0;
        hipGetDevice(&dev); hipDeviceGetAttribute(&cus, hipDeviceAttributeMultiprocessorCount, dev);
        hipFuncSetAttribute((const void*)mk_fwd, hipFuncAttributeMaxDynamicSharedMemorySize, LDS_BYTES);
        hipOccupancyMaxActiveBlocksPerMultiprocessor(&per_cu, (const void*)mk_fwd, NTHREADS, LDS_BYTES);
        (void)hipGetLastError();
        if (per_cu < 1) { fprintf(stderr, "kernel_launch: occupancy query says %d blocks per CU\n", per_cu); per_cu = 1; }
        grid = cus;
    }
    if (grid < 0) return;
    Args a{};
    for (int i = 0; i < 27; ++i) a.in[i] = (const float*)d_in[i];
    a.out = (float*)d_out; a.ws = (unsigned char*)d_ws;
#if ONE_LAUNCH
    if (hipMemsetAsync(d_ws, 0, 65536, stream) != hipSuccess) { fprintf(stderr, "kernel_launch: memset of the barrier words failed\n"); return; }
    a.ph_lo = 0; a.ph_hi = NPHASES;
    void* args[] = {&a};
    hipError_t e = hipLaunchCooperativeKernel((const void*)mk_fwd, dim3(grid), dim3(NTHREADS), args, LDS_BYTES, stream);
    if (e != hipSuccess) fprintf(stderr, "cooperative launch failed: %s (grid %d)\n", hipGetErrorString(e), grid);
#else
    for (int p = 0; p < NPHASES; ++p) { a.ph_lo = p; a.ph_hi = p + 1; hipLaunchKernelGGL(mk_fwd, dim3(grid), dim3(NTHREADS), LDS_BYTES, stream, a); }
#endif
}
```

```cpp
#include <hip/hip_runtime.h>
#include <hip/hip_cooperative_groups.h>
#include <cstdio>
#include <cstdint>
namespace cg = cooperative_groups;

#ifndef ONE_LAUNCH
#define ONE_LAUNCH 1
#endif
#ifndef FAST_GEMM
#define FAST_GEMM 1
#endif
#ifndef EPI_REPEAT
#define EPI_REPEAT 1
#endif
#ifndef P3REP
#define P3REP 0
#endif
#ifndef SKEW_MOE
#define SKEW_MOE 0
#endif

#define LAS __attribute__((address_space(3)))
typedef unsigned short bf16_t;
typedef short bf16x8 __attribute__((ext_vector_type(8)));
typedef float f32x4 __attribute__((ext_vector_type(4)));
typedef float f32x2 __attribute__((ext_vector_type(2)));
typedef unsigned u32x4 __attribute__((ext_vector_type(4)));
typedef unsigned u32x2 __attribute__((ext_vector_type(2)));
typedef __bf16 bf16x2_t __attribute__((ext_vector_type(2)));
typedef int v4i32 __attribute__((ext_vector_type(4)));
typedef int v8i32 __attribute__((ext_vector_type(8)));

constexpr int D = 1024, NB = 8, SEQ = 4096, T = NB * SEQ;
constexpr int QL = 768, KVL = 256, ROPE = 64, NH = 8, NOPE = 128, VH = 128, QKD = NOPE + ROPE;
constexpr int IN_W = 4160, INP = 4096;
constexpr int NE = 32, TOPK = 4, DE = 1024;
constexpr int NSLOT = T * TOPK;
constexpr int RT_MAX = 543;
constexpr float EPS = 1e-6f;
constexpr float W8SCALE = 64.0f;
constexpr float Q8SCALE = 16.0f;
constexpr int SCALE_Q8 = 0x7b7b7b7b;
constexpr float GUC = 1.702f * 1.4426950408889634f, GUCI = 1.0f / GUC;
constexpr float YSCALE = 16.0f;
constexpr int SCALE_ONE = 0x7f7f7f7f, SCALE_W8 = 0x79797979;
constexpr float QSCALE = 0.07216878364870322f * 1.4426950408889634f;

constexpr size_t MiB = 1u << 20;
constexpr size_t WS_MOD = 1 * MiB;
constexpr size_t WS_FMOD = 1 * MiB + 256 * 1024;
constexpr size_t WS_CS = 2 * MiB;
constexpr size_t WS_PSQQ = 10 * MiB;
constexpr size_t WS_PSQKV = 12 * MiB;
constexpr size_t WS_TKI = 13 * MiB;
constexpr size_t WS_TKW = 13 * MiB + 512 * 1024;
constexpr size_t WS_RANK = 14 * MiB;
constexpr size_t WS_SLOTROW = 14 * MiB + 512 * 1024;
constexpr size_t WS_COUNTS = 15 * MiB;
constexpr size_t WS_ROWW = 16 * MiB;
constexpr size_t WS_TILEE = 17 * MiB;
constexpr size_t WS_ROWTOK = 19 * MiB;
constexpr size_t WS_WIN8 = 22 * MiB;
constexpr size_t WS_HB8 = 864 * MiB;
constexpr size_t WS_X1B = 456 * MiB;
constexpr size_t WS_PSQX = 26 * MiB;
constexpr size_t WS_WKPE = 20 * MiB;
constexpr size_t WS_WR = 18 * MiB;
constexpr size_t WS_WIN = 32 * MiB;
constexpr size_t WS_WQ = 41 * MiB;
constexpr size_t WS_WK = 44 * MiB;
constexpr size_t WS_WV = 45 * MiB;
constexpr size_t WS_WGRP = 46 * MiB;
constexpr size_t WS_WPO = 47 * MiB;
constexpr size_t WS_WMO = 49 * MiB;
constexpr size_t WS_WOUT = 51 * MiB;
constexpr size_t WS_WGU = 54 * MiB;
constexpr size_t WS_WDN = 182 * MiB;
constexpr size_t WS_S0 = 256 * MiB;
constexpr size_t WS_S1 = 320 * MiB;
constexpr size_t WS_QLAT = 384 * MiB;
constexpr size_t WS_KVLAT = 432 * MiB;
constexpr size_t WS_KPE = 448 * MiB;
constexpr size_t WS_GATES = 452 * MiB;
constexpr size_t WS_Q = 580 * MiB;
constexpr size_t WS_KN = 676 * MiB;
constexpr size_t WS_VT = 740 * MiB;
constexpr size_t WS_O = 804 * MiB;
constexpr size_t WS_XS = 320 * MiB;
constexpr size_t WS_ACT = 592 * MiB;
constexpr size_t WS_END = 896 * MiB;

constexpr int LDS_BYTES = 148480;
constexpr int MODCNT_WORD = 8192;
constexpr int NTHREADS = 512;

__device__ __forceinline__ unsigned pk2(float lo, float hi) { f32x2 v = {lo, hi}; bf16x2_t b = __builtin_convertvector(v, bf16x2_t); return __builtin_bit_cast(unsigned, b); }
__device__ __forceinline__ float bflo(unsigned u) { return __uint_as_float(u << 16); }
__device__ __forceinline__ float bfhi(unsigned u) { return __uint_as_float(u & 0xffff0000u); }
__device__ __forceinline__ void unpack8(const u32x4 w, float (&f)[8]) { f[0] = bflo(w.x); f[1] = bfhi(w.x); f[2] = bflo(w.y); f[3] = bfhi(w.y); f[4] = bflo(w.z); f[5] = bfhi(w.z); f[6] = bflo(w.w); f[7] = bfhi(w.w); }
__device__ __forceinline__ u32x4 pack8(const float (&f)[8]) { u32x4 w; w.x = pk2(f[0], f[1]); w.y = pk2(f[2], f[3]); w.z = pk2(f[4], f[5]); w.w = pk2(f[6], f[7]); return w; }
__device__ __forceinline__ unsigned pk4_fp8(float a, float b, float c, float d) { int w = 0; w = __builtin_amdgcn_cvt_pk_fp8_f32(a, b, w, false); w = __builtin_amdgcn_cvt_pk_fp8_f32(c, d, w, true); return (unsigned)w; }
__device__ __forceinline__ float wave_sum(float v) {
#pragma unroll
    for (int o = 1; o < 64; o <<= 1) v += __shfl_xor(v, o);
    return v;
}
__device__ __forceinline__ int tid_fresh() { int t = threadIdx.x; asm volatile("" : "+v"(t)); return t; }
__device__ __forceinline__ float sigmoidf_(float x) { return __builtin_amdgcn_rcpf(1.0f + __builtin_amdgcn_exp2f(-1.4426950408889634f * x)); }

struct Args {
    const float* in[27]; float* out; unsigned char* ws; int ph_lo, ph_hi;
};
typedef const Args __attribute__((address_space(4)))* KArgP;
enum { I_X = 0, I_C, I_POS, I_WMOD, I_BMOD, I_GMIX, I_WIN, I_BGATE, I_WPG, I_PSCALE, I_WPO, I_GQA, I_WQB, I_GKVA, I_WKVB, I_WMO, I_WOUT, I_GFFN, I_WR, I_BR, I_WGU, I_BGU, I_WDN, I_BDN, I_GFIN, I_WFMOD, I_BFMOD };

struct Unit { int pm, pn, e; unsigned ao, bo; };
struct Gemm { const bf16_t* A; const bf16_t* Bt; int lda, ldb, K; const int* gather; int scaleA, scaleB; };
constexpr int NXCD = 8, WGM = 8;
__host__ __device__ __forceinline__ int perm32(int rho) { const int n = rho >> 4, i = rho & 15; return 8 * (i >> 2) + 4 * n + (i & 3); }

struct DenseSched {
    int nM, nN, nwg, G, c; unsigned a_tile, a_col, b_tile;
    __device__ void init(int nM_, int nN_, int G_, int c_, int lda, int ldb, unsigned a_col_, int eb = 2) { nM = nM_; nN = nN_; nwg = nM * nN; G = G_; c = c_; a_tile = 256u * lda * eb; b_tile = 256u * ldb * eb; a_col = a_col_; }
    __device__ bool next(int i, Unit& u) const {
        const long L = (long)i * G + c; if (L >= nwg) return false;
        int wgid = (int)L; { const int q = nwg / NXCD, r = nwg % NXCD, xcd = wgid % NXCD, off = wgid / NXCD; wgid = (xcd < r ? xcd * (q + 1) : r * (q + 1) + (xcd - r) * q) + off; }
        const int nig = WGM * nN, gid = wgid / nig, fm = gid * WGM, gsz = (nM - fm) < WGM ? (nM - fm) : WGM;
        u.pm = fm + ((wgid % nig) % gsz); u.pn = (wgid % nig) / gsz; u.e = 0;
        u.ao = (unsigned)u.pm * a_tile + (unsigned)u.pn * a_col; u.bo = (unsigned)u.pn * b_tile; return true;
    }
};
struct MoeSched {
    const LAS int* tile_e; int R, NT, G, c; unsigned a_tile, b_tile;
    __device__ void init(const LAS int* te, int NT_, int G_, int c_, int lda, int ldb, int eb) { tile_e = te; R = te[1023]; NT = NT_; G = G_; c = c_; a_tile = 256u * lda * eb; b_tile = 256u * ldb * eb; }
    __device__ bool next(int i, Unit& u) const {
        int rt, pn;
        if (G == 256) { const int x = c & 7, j = c >> 3, rpr = 256 / NT, pxc = rpr / 8; rt = i * rpr + x * pxc + j / NT; pn = j % NT; }
        else { const long L = (long)i * G + c; rt = (int)(L / NT); pn = (int)(L % NT); }
        if (rt >= R) return false;
        const int e = tile_e[rt];
        u.pm = rt; u.pn = pn; u.e = e; u.ao = (unsigned)rt * a_tile; u.bo = (unsigned)(e * NT + pn) * b_tile; return true;
    }
};
__device__ __forceinline__ const LAS int* moe_table_to_lds(const int* tile_e, LAS unsigned char* lds) {
    LAS int* t = (LAS int*)(lds + 131072 + 1024);
    for (int i = threadIdx.x; i < 1023; i += NTHREADS) t[i] = tile_e[i] & 31;
    if (threadIdx.x == 0) t[1023] = tile_e[1023];
    __syncthreads();
    return t;
}
struct DualSched {
    DenseSched B; unsigned a2, b2;
    __device__ bool next(int i, Unit& u) const { if (!B.next(i >> 1, u)) return false; if (i & 1) { u.ao += a2; u.bo += b2; u.e = 0; } else u.e = 1; return true; }
};
template <class Base> struct DupSched {
    Base B;
    __device__ bool next(int i, Unit& u) const { const bool r = B.next(i >> 1, u); if (!(i & 1)) u.e = -1; return r; }
};
struct NoPre {};
struct NoCtx {};
struct Ctx8 { float s[8]; };
__device__ __forceinline__ Ctx8 load8f(const float* p) { const f32x4 a = *(const f32x4*)p, b = *(const f32x4*)(p + 4); Ctx8 c; c.s[0] = a[0]; c.s[1] = a[1]; c.s[2] = a[2]; c.s[3] = a[3]; c.s[4] = b[0]; c.s[5] = b[1]; c.s[6] = b[2]; c.s[7] = b[3]; return c; }
__device__ __forceinline__ Ctx8 load8f_lds(const LAS float* p) { const f32x4 a = *(const LAS f32x4*)p, b = *(const LAS f32x4*)(p + 4); Ctx8 c; c.s[0] = a[0]; c.s[1] = a[1]; c.s[2] = a[2]; c.s[3] = a[3]; c.s[4] = b[0]; c.s[5] = b[1]; c.s[6] = b[2]; c.s[7] = b[3]; return c; }
__device__ __forceinline__ void ub4(unsigned w, float* f) { f[0] = (float)(w & 0xffu); f[1] = (float)((w >> 8) & 0xffu); f[2] = (float)((w >> 16) & 0xffu); f[3] = (float)(w >> 24); }
template <class E, class = void> struct EpiPaired { static constexpr bool value = false; };
template <class E> struct EpiPaired<E, decltype((void)E::PAIRED)> { static constexpr bool value = E::PAIRED; };
template <class Epi, bool BI = false>
__device__ __forceinline__ void run_epi(const Epi& E, const f32x4 (&acc)[2][2][4][2], const Unit& u, int wr, int wc, int fr, int fq, const LAS float* bslot = nullptr) {
    const int col0 = wc * 32 + 8 * fq, rowb = u.pm * 256 + wr * 64 + fr;
    if constexpr (Epi::COLMAJOR) {
#pragma unroll
        for (int bj = 0; bj < 2; ++bj) {
            const int col = bj * 128 + col0;
            const typename Epi::ColCtx cc = E.col_ctx(u, col);
            asm volatile("" ::: "memory");
#pragma unroll
            for (int ai = 0; ai < 2; ++ai)
#pragma unroll
                for (int m = 0; m < 4; ++m) {
                    float v[8];
#pragma unroll
                    for (int j = 0; j < 4; ++j) { v[j] = acc[ai][bj][m][0][j]; v[4 + j] = acc[ai][bj][m][1][j]; }
                    E.template apply<false>(u, rowb + ai * 128 + m * 16, col, v, 0.f, cc, NoPre{});
                }
            asm volatile("" ::: "memory");
        }
    } else {
        typename Epi::ColCtx cc[2];
        if constexpr (BI) { cc[0] = typename Epi::ColCtx{}; cc[1] = typename Epi::ColCtx{}; }
        else if constexpr (Epi::LDSBIAS) { if (bslot) { cc[0] = load8f_lds(bslot + col0); cc[1] = load8f_lds(bslot + 128 + col0); } else { cc[0] = E.col_ctx(u, col0); cc[1] = E.col_ctx(u, 128 + col0); } }
        else { cc[0] = E.col_ctx(u, col0); cc[1] = E.col_ctx(u, 128 + col0); }
        const bool wp = Epi::SUMSQ && E.want_partial(u);
        constexpr int DP = Epi::PRE_DEPTH, NS = DP + 1;
        typename Epi::RowPre rp[NS]; typename Epi::Pre pp[NS][2];
#define EPI_ROW(r_) (rowb + ((r_) >> 2) * 128 + ((r_) & 3) * 16)
#pragma unroll
        for (int r = 0; r < DP; ++r) { rp[r] = E.row_pre(u, EPI_ROW(r)); pp[r][0] = E.pre(u, EPI_ROW(r), col0); pp[r][1] = E.pre(u, EPI_ROW(r), 128 + col0); }
        asm volatile("" ::: "memory");
#pragma unroll
        for (int r = 0; r < 8; ++r) {
            const int ai = r >> 2, m = r & 3, row = EPI_ROW(r);
            if (r + DP < 8) { const int rn = EPI_ROW(r + DP);
                rp[(r + DP) % NS] = E.row_pre(u, rn); pp[(r + DP) % NS][0] = E.pre(u, rn, col0); pp[(r + DP) % NS][1] = E.pre(u, rn, 128 + col0); }
            asm volatile("" ::: "memory");
            const float rc = E.row_ctx(rp[r % NS]); float part = 0.f;
            if constexpr (EpiPaired<Epi>::value) {
                float v0[8], v1[8];
#pragma unroll
                for (int j = 0; j < 4; ++j) { v0[j] = acc[ai][0][m][0][j]; v0[4 + j] = acc[ai][0][m][1][j]; v1[j] = acc[ai][1][m][0][j]; v1[4 + j] = acc[ai][1][m][1][j]; }
                part += E.apply2(u, row, col0, v0, v1, rc);
            } else
#pragma unroll
            for (int bj = 0; bj < 2; ++bj) {
                float v[8];
#pragma unroll
                for (int j = 0; j < 4; ++j) { v[j] = acc[ai][bj][m][0][j]; v[4 + j] = acc[ai][bj][m][1][j]; }
                part += E.template apply<BI>(u, row, bj * 128 + col0, v, rc, cc[bj], pp[r % NS][bj]);
            }
            if constexpr (Epi::SUMSQ) { if (wp) { float sq = part; sq += __shfl_xor(sq, 16); sq += __shfl_xor(sq, 32); if (fq == 0) E.partial(u, row, wc, sq); } }
            asm volatile("" ::: "memory");
        }
#undef EPI_ROW
    }
}

template <class Epi>
__device__ __forceinline__ void run_mid(const Epi& E, f32x4 (&acc)[2][2][4][2], const Unit& u, int wr, int wc, int fr, int fq) {
    const int col0 = wc * 32 + 8 * fq, rowb = u.pm * 256 + wr * 64 + fr;
    u32x4 ga[3], gb[3];
#define EPI_ROW(r_) (rowb + ((r_) >> 2) * 128 + ((r_) & 3) * 16)
#pragma unroll
    for (int r = 0; r < 2; ++r) E.load_gates(u, EPI_ROW(r), col0, ga[r], gb[r]);
    asm volatile("" ::: "memory");
#pragma unroll
    for (int r = 0; r < 8; ++r) {
        const int ai = r >> 2, m = r & 3;
        if (r + 2 < 8) E.load_gates(u, EPI_ROW(r + 2), col0, ga[(r + 2) % 3], gb[(r + 2) % 3]);
        asm volatile("" ::: "memory");
#pragma unroll
        for (int bj = 0; bj < 2; ++bj) { float g0[8], g1[8];
            ub4(bj ? ga[r % 3].z : ga[r % 3].x, g0); ub4(bj ? ga[r % 3].w : ga[r % 3].y, g0 + 4); ub4(bj ? gb[r % 3].z : gb[r % 3].x, g1); ub4(bj ? gb[r % 3].w : gb[r % 3].y, g1 + 4);
#pragma unroll
            for (int j = 0; j < 4; ++j) { acc[ai][bj][m][0][j] *= g0[j] * __builtin_amdgcn_rcpf(g1[j]); acc[ai][bj][m][1][j] *= g0[4 + j] * __builtin_amdgcn_rcpf(g1[4 + j]); } }
        asm volatile("" ::: "memory");
    }
#undef EPI_ROW
}

template <class Epi, class Sched>
__device__ __forceinline__ void gemm_simple(LAS unsigned char* lds, const Gemm g, const Sched& S, const Epi& E) {
    const int tid = tid_fresh(), wid = __builtin_amdgcn_readfirstlane(tid >> 6), lane = tid & 63, wr = wid >> 2, wc = wid & 3, fr = lane & 15, fq = lane >> 4;
    const int nt = g.K / 64;
    Unit u;
    for (int ui = 0; S.next(ui, u); ++ui) {
        f32x4 acc[2][2][4][2];
#pragma unroll
        for (int a = 0; a < 2; ++a)
#pragma unroll
            for (int b = 0; b < 2; ++b)
#pragma unroll
                for (int m = 0; m < 4; ++m)
#pragma unroll
                    for (int n = 0; n < 2; ++n) acc[a][b][m][n] = (f32x4){0.f, 0.f, 0.f, 0.f};
        const char* cA = (const char*)g.A + u.ao; const char* cB = (const char*)g.Bt + u.bo;
#pragma unroll 1
        for (int kt = 0; kt < nt; ++kt) {
            __syncthreads();
#pragma unroll
            for (int i = 0; i < 4; ++i) { const int c = tid + 512 * i, row = c >> 3, kc = c & 7, rb = (row & ~31) + perm32(row & 31);
                const u32x4 va = g.gather ? *(const u32x4*)((const char*)g.A + (size_t)g.gather[u.pm * 256 + row] * g.lda * 2 + kt * 128 + kc * 16)
                                          : *(const u32x4*)(cA + (size_t)row * g.lda * 2 + kt * 128 + kc * 16);
                const u32x4 vb = *(const u32x4*)(cB + (size_t)rb * g.ldb * 2 + kt * 128 + kc * 16);
                *(LAS u32x4*)(lds + row * 144 + kc * 16) = va; *(LAS u32x4*)(lds + 36864 + row * 144 + kc * 16) = vb; }
            __syncthreads();
#pragma unroll
            for (int k = 0; k < 2; ++k) {
                bf16x8 Af[2][4], Bf[2][2];
#pragma unroll
                for (int ai = 0; ai < 2; ++ai)
#pragma unroll
                    for (int m = 0; m < 4; ++m) Af[ai][m] = *(const LAS bf16x8*)(lds + (ai * 128 + wr * 64 + m * 16 + fr) * 144 + (k * 32 + fq * 8) * 2);
#pragma unroll
                for (int bj = 0; bj < 2; ++bj)
#pragma unroll
                    for (int n = 0; n < 2; ++n) Bf[bj][n] = *(const LAS bf16x8*)(lds + 36864 + (bj * 128 + wc * 32 + n * 16 + fr) * 144 + (k * 32 + fq * 8) * 2);
#pragma unroll
                for (int ai = 0; ai < 2; ++ai)
#pragma unroll
                    for (int bj = 0; bj < 2; ++bj)
#pragma unroll
                        for (int m = 0; m < 4; ++m)
#pragma unroll
                            for (int n = 0; n < 2; ++n) acc[ai][bj][m][n] = __builtin_amdgcn_mfma_f32_16x16x32_bf16(Bf[bj][n], Af[ai][m], acc[ai][bj][m][n], 0, 0, 0);
            }
        }
        run_epi(E, acc, u, wr, wc, fr, fq);
    }
    __syncthreads();
}

template <class E, class = void> struct EpiNStore { static constexpr int value = 0; };
template <class E> struct EpiNStore<E, decltype((void)E::NSTORE)> { static constexpr int value = E::NSTORE; };
namespace pg8 {
template <int N> __device__ __forceinline__ void wait_vm() { asm volatile("s_waitcnt vmcnt(%0)" :: "n"(N) : "memory"); }
constexpr int BK = 64, HALF = 128, HTB = HALF * BK * 2  , STAGE_BYTES = 8 * HTB;
__device__ __forceinline__ int lds_byte(int r, int c) { const int st = (r >> 4) * 2 + (c >> 5), rr = r & 15, cc = c & 31, ob = rr * 64 + cc * 2; return st * 1024 + (ob ^ (((ob >> 9) & 1) << 5)); }
__device__ __forceinline__ void stage_rc(int b, int& R, int& C) { const int st = b / 1024, sb = b % 1024, swz = sb ^ (((sb >> 9) & 1) << 5); R = (st >> 1) * 16 + swz / 64; C = (st & 1) * 32 + (swz % 64) / 2; }

template <class Epi, class Sched, bool GATHER, bool FP8>
__device__ __forceinline__ void gemm_fast(LAS unsigned char* lds, const Gemm g, const Sched& S, const Epi& E, int skew_ticks) {
    const int tid = tid_fresh(), wid = __builtin_amdgcn_readfirstlane(tid >> 6), lane = tid & 63, wr = wid >> 2, wc = wid & 3, fr = lane & 15, fq = lane >> 4;
    constexpr int EB = FP8 ? 1 : 2;
    const int nt = g.K * EB / 128;
    unsigned voffA[2], voffB[2];
#pragma unroll
    for (int i = 0; i < 2; ++i) { int R, C; stage_rc(tid * 16 + i * 8192, R, C); const int Rb = (R & ~31) + perm32(R & 31);
        voffA[i] = (unsigned)(R * g.lda * EB + C * 2); voffB[i] = (unsigned)(Rb * g.ldb * EB + C * 2); }
    const size_t kstep = (size_t)(BK * 2);
    const size_t hstepA = GATHER ? (size_t)0 : (size_t)HALF * g.lda * EB, hstepB = (size_t)HALF * g.ldb * EB;
    unsigned cV0[2], cV1[2], nV0[2], nV1[2];
#define PG8_GATHER(pm_, V0, V1) do { _Pragma("unroll") for (int _i = 0; _i < 2; ++_i) { int R_, C_; stage_rc(tid * 16 + _i * 8192, R_, C_); \
        V0[_i] = (unsigned)(g.gather[(pm_) * 256 + R_] * g.lda * EB + C_ * 2); V1[_i] = (unsigned)(g.gather[(pm_) * 256 + 128 + R_] * g.lda * EB + C_ * 2); } } while (0)
    const unsigned ldsw = (unsigned)wid * 1024u;
    const int aoff = lds_byte(wr * 64 + fr, fq * 8), boff = lds_byte(wc * 32 + fr, fq * 8);
#define PG8_SA(b, h) (((b) * 2 + (h)) * HTB)
#define PG8_SB(b, h) ((4 + (b) * 2 + (h)) * HTB)
#define PG8_STAGE(bufoff, gbase, voff) do { _Pragma("unroll") for (int _i = 0; _i < 2; ++_i) \
        __builtin_amdgcn_global_load_lds((const unsigned*)((const char*)(gbase) + (voff)[_i]), (LAS unsigned*)(lds + (bufoff) + ldsw + _i * 8192), 16, 0, 0); } while (0)
#define PG8_LD8(p) __builtin_shufflevector(*(const LAS v4i32*)(p), *(const LAS v4i32*)((p) + 1024), 0, 1, 2, 3, 4, 5, 6, 7)
#define PG8_LDA(dst, b, h) do { _Pragma("unroll") for (int m = 0; m < 4; ++m) dst[m] = PG8_LD8(lds + PG8_SA(b, h) + aoff + m * 2048); } while (0)
#define PG8_LDB(dst, b, h) do { _Pragma("unroll") for (int n = 0; n < 2; ++n) dst[n] = PG8_LD8(lds + PG8_SB(b, h) + boff + n * 2048); } while (0)
#define PG8_HALF0(v) __builtin_bit_cast(bf16x8, __builtin_shufflevector(v, v, 0, 1, 2, 3))
#define PG8_HALF1(v) __builtin_bit_cast(bf16x8, __builtin_shufflevector(v, v, 4, 5, 6, 7))
#define PG8_MMA(ai, bj, At, Bt) do { __builtin_amdgcn_s_setprio(1); \
        if constexpr (FP8) { _Pragma("unroll") for (int m = 0; m < 4; ++m) _Pragma("unroll") for (int n = 0; n < 2; ++n) \
            asm volatile("v_mfma_scale_f32_16x16x128_f8f6f4 %0, %1, %2, %0, %3, %4 op_sel_hi:[0,0,0]" : "+v"(acc[ai][bj][m][n]) : "v"(Bt[n]), "v"(At[m]), "v"(sclW), "v"(sclX)); } \
        else { _Pragma("unroll") for (int m = 0; m < 4; ++m) _Pragma("unroll") for (int n = 0; n < 2; ++n) { \
            acc[ai][bj][m][n] = __builtin_amdgcn_mfma_f32_16x16x32_bf16(PG8_HALF0(Bt[n]), PG8_HALF0(At[m]), acc[ai][bj][m][n], 0, 0, 0); \
            acc[ai][bj][m][n] = __builtin_amdgcn_mfma_f32_16x16x32_bf16(PG8_HALF1(Bt[n]), PG8_HALF1(At[m]), acc[ai][bj][m][n], 0, 0, 0); } } \
        __builtin_amdgcn_s_setprio(0); } while (0)
#define PG8_WAIT_V(n) asm volatile("s_waitcnt vmcnt(" #n ")" ::: "memory")
#define PG8_WAIT_L(n) asm volatile("s_waitcnt lgkmcnt(" #n ")" ::: "memory")
#define PG8_BAR __builtin_amdgcn_s_barrier()
#define PG8_SCHED __builtin_amdgcn_sched_barrier(0)
    Unit cur, nxt; int ui = 0;
    constexpr int NSTR = EpiNStore<Epi>::value; bool stored_prev = false, pre11 = false;
    if (!S.next(0, cur)) return;
    if (skew_ticks > 0) {
        const unsigned long long t0 = __builtin_amdgcn_s_memrealtime(); const unsigned long long d = (unsigned long long)(((blockIdx.x * 167u + 13u) & 255u) * (unsigned)skew_ticks) >> 8;
        while (__builtin_amdgcn_s_memrealtime() - t0 < d) __builtin_amdgcn_s_sleep(8);
    }
    f32x4 acc[2][2][4][2];
#define PG8_INIT(un, slot_) do { const LAS float* bs0_ = nullptr; if constexpr (Epi::BIASINIT) { if (E.bias_ptr(un) != nullptr) bs0_ = (const LAS float*)(lds + 131072 + 8192 + (slot_) * 1024) + wc * 32 + 8 * fq; } \
        _Pragma("unroll") for (int b = 0; b < 2; ++b) { f32x4 lo_ = (f32x4){0.f, 0.f, 0.f, 0.f}, hi_ = lo_; \
            if constexpr (Epi::BIASINIT) { if (bs0_) { lo_ = *(const LAS f32x4*)(bs0_ + b * 128); hi_ = *(const LAS f32x4*)(bs0_ + b * 128 + 4); } } \
            _Pragma("unroll") for (int n = 0; n < 2; ++n) { f32x4 iv = (f32x4){0.f, 0.f, 0.f, 0.f}; if constexpr (Epi::BIASINIT) { if (bs0_) iv = E.init_vec(lo_, hi_, n); } \
                _Pragma("unroll") for (int a = 0; a < 2; ++a) _Pragma("unroll") for (int m = 0; m < 4; ++m) acc[a][b][m][n] = iv; } } } while (0)
    v8i32 At[4], B0[2], B1[2];
    const int sclW = g.scaleB, sclX = g.scaleA;
    const char* cA = (const char*)g.A + (GATHER ? 0u : cur.ao); const char* cB = (const char*)g.Bt + cur.bo;
#define PG8_BIAS(un, ui_) do { if constexpr (Epi::LDSBIAS) { const float* bp_ = E.bias_ptr(un); if (bp_ != nullptr && wid == 0) \
        __builtin_amdgcn_global_load_lds((const unsigned*)(bp_ + lane * 4), (LAS unsigned*)(lds + 131072 + 8192 + (ui_) * 1024), 16, 0, 0); } } while (0)
    int bsl = 0;
    PG8_BIAS(cur, 0);
    if constexpr (GATHER) { PG8_GATHER(cur.pm, cV0, cV1); } else { cV0[0] = cV1[0] = voffA[0]; cV0[1] = cV1[1] = voffA[1]; }
    nV0[0] = cV0[0]; nV0[1] = cV0[1]; nV1[0] = cV1[0]; nV1[1] = cV1[1];
    PG8_STAGE(PG8_SB(0, 0), cB, voffB); PG8_STAGE(PG8_SB(0, 1), cB + hstepB, voffB); PG8_STAGE(PG8_SA(0, 0), cA, cV0); PG8_STAGE(PG8_SA(0, 1), cA + hstepA, cV1);
    if (wr == 1) PG8_BAR;
    PG8_WAIT_V(2); PG8_BAR;
    PG8_STAGE(PG8_SB(1, 0), cB + kstep, voffB); PG8_STAGE(PG8_SA(1, 0), cA + kstep, cV0); PG8_STAGE(PG8_SB(1, 1), cB + hstepB + kstep, voffB);
    PG8_WAIT_V(6); PG8_BAR;
    PG8_INIT(cur, 0);
    for (;;) {
        const bool has_next = S.next(ui + 1, nxt);
        const int bsn = (bsl == 2) ? 0 : bsl + 1;
        if (has_next) PG8_BIAS(nxt, bsn);
        const char* nA = (has_next && !GATHER) ? (const char*)g.A + nxt.ao : cA; const char* nB = has_next ? (const char*)g.Bt + nxt.bo : cB;
        if constexpr (GATHER) { if (has_next) PG8_GATHER(nxt.pm, nV0, nV1); }
        if constexpr (!GATHER && FP8) {
        { int t = 0; asm volatile("" : "+s"(t));
            const bool last = (t == nt - 2);
            const char* a1 = cA + (size_t)(t + 1) * kstep;
            const char* a2 = last ? nA : cA + (size_t)(t + 2) * kstep; const char* b2 = last ? nB : cB + (size_t)(t + 2) * kstep;
            const char* a3 = a2 + kstep; const char* b3 = b2 + kstep;
            unsigned sV0[2], sV1[2];
            sV0[0] = last ? nV0[0] : cV0[0]; sV0[1] = last ? nV0[1] : cV0[1]; sV1[0] = last ? nV1[0] : cV1[0]; sV1[1] = last ? nV1[1] : cV1[1];
            const bool rlx = NSTR > 0 && stored_prev;
            PG8_LDB(B0, 0, 0); PG8_LDB(B1, 0, 1); PG8_SCHED; PG8_LDA(At, 0, 0); if (!pre11) PG8_STAGE(PG8_SA(1, 1), a1 + hstepA, cV1);
            if (rlx) wait_vm<8 + NSTR>(); else PG8_WAIT_V(8);
            PG8_WAIT_L(0); PG8_BAR; PG8_MMA(0, 0, At, B0); PG8_MMA(0, 1, At, B1); PG8_BAR; PG8_SCHED;
            PG8_LDA(At, 0, 1); PG8_STAGE(PG8_SB(0, 0), b2, voffB); PG8_STAGE(PG8_SB(0, 1), b2 + hstepB, voffB); PG8_STAGE(PG8_SA(0, 0), a2, sV0);
            if (rlx) wait_vm<8 + NSTR>(); else PG8_WAIT_V(8);
            PG8_WAIT_L(0); PG8_BAR; PG8_MMA(1, 0, At, B0); PG8_MMA(1, 1, At, B1); PG8_BAR; PG8_SCHED;
            PG8_LDB(B0, 1, 0); PG8_LDB(B1, 1, 1); PG8_SCHED; PG8_LDA(At, 1, 0); PG8_STAGE(PG8_SA(0, 1), a2 + hstepA, sV1);
            if (rlx && pre11) wait_vm<8 + NSTR>(); else PG8_WAIT_V(8);
            PG8_WAIT_L(0); PG8_BAR; PG8_MMA(0, 0, At, B0); PG8_MMA(0, 1, At, B1); PG8_BAR; PG8_SCHED;
            PG8_LDA(At, 1, 1); PG8_STAGE(PG8_SB(1, 0), b3, voffB); PG8_STAGE(PG8_SB(1, 1), b3 + hstepB, voffB); PG8_STAGE(PG8_SA(1, 0), a3, sV0);
            PG8_WAIT_V(8); PG8_WAIT_L(0); PG8_BAR; PG8_MMA(1, 0, At, B0); PG8_MMA(1, 1, At, B1); PG8_BAR; PG8_SCHED;
        }
#pragma unroll 1
        for (int t = 2; t < nt; t += 2) {
            const bool last = (t == nt - 2);
            const char* a1 = cA + (size_t)(t + 1) * kstep;
            const char* a2 = last ? nA : cA + (size_t)(t + 2) * kstep; const char* b2 = last ? nB : cB + (size_t)(t + 2) * kstep;
            const char* a3 = a2 + kstep; const char* b3 = b2 + kstep;
            unsigned sV0[2], sV1[2];
            sV0[0] = last ? nV0[0] : cV0[0]; sV0[1] = last ? nV0[1] : cV0[1]; sV1[0] = last ? nV1[0] : cV1[0]; sV1[1] = last ? nV1[1] : cV1[1];
            PG8_LDB(B0, 0, 0); PG8_LDB(B1, 0, 1); PG8_SCHED; PG8_LDA(At, 0, 0); PG8_STAGE(PG8_SA(1, 1), a1 + hstepA, cV1);
            PG8_WAIT_V(8);
            PG8_WAIT_L(0); PG8_BAR; PG8_MMA(0, 0, At, B0); PG8_MMA(0, 1, At, B1); PG8_BAR; PG8_SCHED;
            PG8_LDA(At, 0, 1); PG8_STAGE(PG8_SB(0, 0), b2, voffB); PG8_STAGE(PG8_SB(0, 1), b2 + hstepB, voffB); PG8_STAGE(PG8_SA(0, 0), a2, sV0);
            PG8_WAIT_V(8);
            PG8_WAIT_L(0); PG8_BAR; PG8_MMA(1, 0, At, B0); PG8_MMA(1, 1, At, B1); PG8_BAR; PG8_SCHED;
            PG8_LDB(B0, 1, 0); PG8_LDB(B1, 1, 1); PG8_SCHED; PG8_LDA(At, 1, 0); PG8_STAGE(PG8_SA(0, 1), a2 + hstepA, sV1);
            PG8_WAIT_V(8);
            PG8_WAIT_L(0); PG8_BAR; PG8_MMA(0, 0, At, B0); PG8_MMA(0, 1, At, B1); PG8_BAR; PG8_SCHED;
            PG8_LDA(At, 1, 1); PG8_STAGE(PG8_SB(1, 0), b3, voffB); PG8_STAGE(PG8_SB(1, 1), b3 + hstepB, voffB); PG8_STAGE(PG8_SA(1, 0), a3, sV0);
            PG8_WAIT_V(8); PG8_WAIT_L(0); PG8_BAR; PG8_MMA(1, 0, At, B0); PG8_MMA(1, 1, At, B1); PG8_BAR; PG8_SCHED;
        }
        } else {
#pragma unroll 1
        for (int t = 0; t < nt; t += 2) {
            const bool last = (t == nt - 2);
            const char* a1 = cA + (size_t)(t + 1) * kstep;
            const char* a2 = last ? nA : cA + (size_t)(t + 2) * kstep; const char* b2 = last ? nB : cB + (size_t)(t + 2) * kstep;
            const char* a3 = a2 + kstep; const char* b3 = b2 + kstep;
            unsigned sV0[2], sV1[2];
            sV0[0] = last ? nV0[0] : cV0[0]; sV0[1] = last ? nV0[1] : cV0[1]; sV1[0] = last ? nV1[0] : cV1[0]; sV1[1] = last ? nV1[1] : cV1[1];
            const bool rlx = NSTR > 0 && t == 0 && stored_prev;
            PG8_LDB(B0, 0, 0); PG8_LDB(B1, 0, 1); PG8_SCHED; PG8_LDA(At, 0, 0); if (!(pre11 && t == 0)) PG8_STAGE(PG8_SA(1, 1), a1 + hstepA, cV1);
            if (rlx) wait_vm<8 + NSTR>(); else PG8_WAIT_V(8);
            PG8_WAIT_L(0); PG8_BAR; PG8_MMA(0, 0, At, B0); PG8_MMA(0, 1, At, B1); PG8_BAR; PG8_SCHED;
            PG8_LDA(At, 0, 1); PG8_STAGE(PG8_SB(0, 0), b2, voffB); PG8_STAGE(PG8_SB(0, 1), b2 + hstepB, voffB); PG8_STAGE(PG8_SA(0, 0), a2, sV0);
            if (rlx) wait_vm<8 + NSTR>(); else PG8_WAIT_V(8);
            PG8_WAIT_L(0); PG8_BAR; PG8_MMA(1, 0, At, B0); PG8_MMA(1, 1, At, B1); PG8_BAR; PG8_SCHED;
            PG8_LDB(B0, 1, 0); PG8_LDB(B1, 1, 1); PG8_SCHED; PG8_LDA(At, 1, 0); PG8_STAGE(PG8_SA(0, 1), a2 + hstepA, sV1);
            if (rlx && pre11) wait_vm<8 + NSTR>(); else PG8_WAIT_V(8);
            PG8_WAIT_L(0); PG8_BAR; PG8_MMA(0, 0, At, B0); PG8_MMA(0, 1, At, B1); PG8_BAR; PG8_SCHED;
            PG8_LDA(At, 1, 1); PG8_STAGE(PG8_SB(1, 0), b3, voffB); PG8_STAGE(PG8_SB(1, 1), b3 + hstepB, voffB); PG8_STAGE(PG8_SA(1, 0), a3, sV0);
            PG8_WAIT_V(8); PG8_WAIT_L(0); PG8_BAR; PG8_MMA(1, 0, At, B0); PG8_MMA(1, 1, At, B1); PG8_BAR; PG8_SCHED;
        }
        }
        if (wr == 0) PG8_BAR;
        const bool pre11n = has_next;
        if (has_next) PG8_STAGE(PG8_SA(1, 1), nA + kstep + hstepA, nV1);
        if constexpr (FP8) asm volatile("s_nop 15\n\ts_nop 15" ::: "memory");
        stored_prev = Epi::DUAL ? cur.e != 1 : cur.e >= 0;
        if constexpr (Epi::DUAL) { if (cur.e == 1) run_mid(E, acc, cur, wr, wc, fr, fq); else run_epi<Epi, false>(E, acc, cur, wr, wc, fr, fq); }
        else if (cur.e >= 0) { const LAS float* bs_ = nullptr; if constexpr (Epi::LDSBIAS) { if (E.bias_ptr(cur) != nullptr) bs_ = (const LAS float*)(lds + 131072 + 8192 + bsl * 1024); }
            run_epi<Epi, Epi::BIASINIT>(E, acc, cur, wr, wc, fr, fq, bs_); }
        if (!has_next) break;
        { const bool keep_ = Epi::DUAL && cur.e == 1;
            cur = nxt; cA = nA; cB = nB; ++ui; bsl = bsn; pre11 = pre11n;
            if (!keep_) PG8_INIT(cur, bsl); }
        cV0[0] = nV0[0]; cV0[1] = nV0[1]; cV1[0] = nV1[0]; cV1[1] = nV1[1];
        if (wr == 1) PG8_BAR;
    }
    PG8_WAIT_V(0);
    PG8_BAR;
#undef PG8_GATHER
#undef PG8_BIAS
#undef PG8_INIT
#undef PG8_SA
#undef PG8_SB
#undef PG8_STAGE
#undef PG8_LD8
#undef PG8_HALF0
#undef PG8_HALF1
#undef PG8_LDA
#undef PG8_LDB
#undef PG8_MMA
#undef PG8_WAIT_V
#undef PG8_WAIT_L
#undef PG8_BAR
#undef PG8_SCHED
}
}

template <class Epi, class Sched, bool GATHER = false, bool FP8 = false>
__device__ __forceinline__ void gemm_phase(LAS unsigned char* lds, const Gemm g, const Sched& S, const Epi& E, int skew_ticks = 0) {
#if FAST_GEMM
    pg8::gemm_fast<Epi, Sched, GATHER, FP8>(lds, g, S, E, skew_ticks);
#else
    gemm_simple<Epi, Sched>(lds, g, S, E);
#endif
}

#define EPI_DEFAULTS_NOROW typedef NoPre RowPre; __device__ __forceinline__ NoPre row_pre(const Unit&, int) const { return NoPre{}; } __device__ __forceinline__ float row_ctx(const NoPre&) const { return 0.f; }
#define EPI_DEFAULTS_NOPRE typedef NoPre Pre; __device__ __forceinline__ NoPre pre(const Unit&, int, int) const { return NoPre{}; }
#define EPI_INITVEC_PLAIN __device__ __forceinline__ f32x4 init_vec(f32x4 lo, f32x4 hi, int n) const { return n ? hi : lo; }
#define EPI_NOBIAS static constexpr bool LDSBIAS = false, BIASINIT = false; EPI_INITVEC_PLAIN __device__ __forceinline__ const float* bias_ptr(const Unit&) const { return nullptr; }
#define EPI_DEFAULTS_NOPART static constexpr bool DUAL = false; __device__ __forceinline__ bool want_partial(const Unit&) const { return false; } __device__ __forceinline__ void partial(const Unit&, int, int, float) const {}
struct EpiIn {
    static constexpr int NSTORE = 8; static constexpr bool PAIRED = true;
    static constexpr int PRE_DEPTH = 1; static constexpr bool SUMSQ = true, COLMAJOR = false, LDSBIAS = true, BIASINIT = true; typedef Ctx8 ColCtx; EPI_DEFAULTS_NOROW EPI_DEFAULTS_NOPRE
    EPI_INITVEC_PLAIN
    __device__ __forceinline__ int ltile(const Unit& u) const { return u.pn; }
    __device__ __forceinline__ const float* bias_ptr(const Unit& u) const { return u.pn >= 8 ? bgate + (u.pn - 8) * 256 : nullptr; }
    static constexpr bool DUAL = false;
    bf16_t *U, *QLp, *KVLp, *KPE, *GATES; float *PSQQ, *PSQKV; const float* bgate; const f32x2* CS; int pn0;
    __device__ __forceinline__ Ctx8 col_ctx(const Unit& u, int col) const { if (u.pn >= 8) return load8f(bgate + (u.pn - 8) * 256 + col); Ctx8 c;
#pragma unroll
        for (int j = 0; j < 8; ++j) c.s[j] = 0.f;
        return c; }
    __device__ __forceinline__ bool want_partial(const Unit& u) const { return u.pn >= 4 && u.pn < 8; }
    __device__ __forceinline__ void partial(const Unit& u, int row, int wc, float s) const {
        if (u.pn < 7) PSQQ[(size_t)row * 12 + (u.pn - 4) * 4 + wc] = s; else PSQKV[(size_t)row * 4 + wc] = s; }
    __device__ __forceinline__ unsigned gate4(const float* v, bool floor1) const { unsigned w = 0u;
#pragma unroll
        for (int i = 0; i < 4; ++i) { float q = __builtin_amdgcn_rcpf(__builtin_fmaf(__builtin_amdgcn_exp2f(-1.4426950408889634f * v[i]), 1.0f / 255.0f, 1.0f / 255.0f));
            if (floor1) q = fmaxf(q, 1.0f);
            w = __builtin_amdgcn_cvt_pk_u8_f32(q, i, w); }
        return w; }
    __device__ __forceinline__ float apply2(const Unit& u, int row, int col0, const float (&v0)[8], const float (&v1)[8], float) const {
        const int pn = ltile(u);
        if (pn < 4) { *(u32x4*)(U + (size_t)row * D + pn * 256 + col0) = pack8(v0); *(u32x4*)(U + (size_t)row * D + pn * 256 + 128 + col0) = pack8(v1); return 0.f; }
        if (pn < 8) { float s = 0.f;
#pragma unroll
            for (int j = 0; j < 8; ++j) s += v0[j] * v0[j] + v1[j] * v1[j];
            u32x2 w0, w1; w0.x = pk4_fp8(v0[0], v0[1], v0[2], v0[3]); w0.y = pk4_fp8(v0[4], v0[5], v0[6], v0[7]); w1.x = pk4_fp8(v1[0], v1[1], v1[2], v1[3]); w1.y = pk4_fp8(v1[4], v1[5], v1[6], v1[7]);
            unsigned char* p = pn < 7 ? (unsigned char*)QLp + (size_t)row * QL + (pn - 4) * 256 + col0 : (unsigned char*)KVLp + (size_t)row * KVL + col0;
            *(u32x2*)p = w0; *(u32x2*)(p + 128) = w1; return s; }
        const bool fl = pn >= 12;
        u32x4 w; w.x = gate4(v0, fl); w.y = gate4(v0 + 4, fl); w.z = gate4(v1, fl); w.w = gate4(v1 + 4, fl);
        *(u32x4*)((unsigned char*)GATES + (size_t)row * 2048 + (pn - 8) * 256 + 2 * col0) = w; return 0.f; }
    template <bool BI> __device__ __forceinline__ float apply(const Unit& u, int row, int col, float (&v)[8], float, const Ctx8& cc, NoPre) const {
        const int pn = ltile(u);
        if (pn < 4) { *(u32x4*)(U + (size_t)row * D + pn * 256 + col) = pack8(v); return 0.f; }
        if (pn < 8) {
            float s = 0.f;
#pragma unroll
            for (int j = 0; j < 8; ++j) s += v[j] * v[j];
            if (pn < 7) { u32x2 w; w.x = pk4_fp8(v[0], v[1], v[2], v[3]); w.y = pk4_fp8(v[4], v[5], v[6], v[7]); *(u32x2*)((unsigned char*)QLp + (size_t)row * QL + (pn - 4) * 256 + col) = w; }
            else { u32x2 w; w.x = pk4_fp8(v[0], v[1], v[2], v[3]); w.y = pk4_fp8(v[4], v[5], v[6], v[7]); *(u32x2*)((unsigned char*)KVLp + (size_t)row * KVL + col) = w; }
            return s;
        }
        {
            float o[8];
#pragma unroll
            for (int j = 0; j < 8; ++j) o[j] = sigmoidf_(BI ? v[j] : v[j] + cc.s[j]);
            *(u32x4*)(GATES + (size_t)row * 2048 + (pn - 8) * 256 + col) = pack8(o);
        }
        return 0.f;
    }
};
struct Pre12 { f32x4 a, b, c; };
struct EpiQ {
    static constexpr int NSTORE = 16;
    static constexpr int PRE_DEPTH = 2; static constexpr bool SUMSQ = false, COLMAJOR = false; typedef NoCtx ColCtx; typedef Pre12 RowPre; typedef Ctx8 Pre; EPI_DEFAULTS_NOPART EPI_NOBIAS
    bf16_t* Q; const float* PSQQ; const f32x2* CS;
    __device__ __forceinline__ Pre12 row_pre(const Unit&, int row) const { const f32x4* p = (const f32x4*)(PSQQ + (size_t)row * 12); Pre12 r; r.a = p[0]; r.b = p[1]; r.c = p[2]; return r; }
    __device__ __forceinline__ float row_ctx(const Pre12& r) const {
        const float s = ((r.a[0] + r.a[1]) + (r.a[2] + r.a[3])) + ((r.b[0] + r.b[1]) + (r.b[2] + r.b[3])) + ((r.c[0] + r.c[1]) + (r.c[2] + r.c[3]));
        return rsqrtf(s * (1.0f / QL) + EPS) * (QSCALE * Q8SCALE); }
    __device__ __forceinline__ NoCtx col_ctx(const Unit&, int) const { return NoCtx{}; }
    __device__ __forceinline__ Ctx8 pre(const Unit& u, int row, int col) const {
        if (u.pn >= 4) { const int g = (((u.pn - 4) * 256 + col) & 63) >> 3; return load8f((const float*)(CS + (size_t)row * 32 + 4 * g)); }
        Ctx8 c;
#pragma unroll
        for (int j = 0; j < 8; ++j) c.s[j] = 0.f;
        return c; }
    template <bool BI> __device__ __forceinline__ float apply(const Unit& u, int row, int col, float (&v)[8], float rs, NoCtx, const Ctx8& cs) const {
#pragma unroll
        for (int j = 0; j < 8; ++j) v[j] *= rs;
        unsigned char* Q8 = (unsigned char*)Q + (size_t)row * (NH * QKD);
        if (u.pn < 4) { const int p = u.pn * 256 + col, hh = p >> 7, d = p & 127; u32x2 w; w.x = pk4_fp8(v[0], v[1], v[2], v[3]); w.y = pk4_fp8(v[4], v[5], v[6], v[7]); *(u32x2*)(Q8 + hh * QKD + d) = w; }
        else { const int r = (u.pn - 4) * 256 + col, hh = r >> 6, g = (r & 63) >> 3; float y1[4], y2[4];
#pragma unroll
            for (int i = 0; i < 4; ++i) { const float c = cs.s[2 * i], sn = cs.s[2 * i + 1]; y1[i] = v[i] * c - v[4 + i] * sn; y2[i] = v[4 + i] * c + v[i] * sn; }
            unsigned char* q = Q8 + hh * QKD + NOPE; *(unsigned*)(q + 4 * g) = pk4_fp8(y1[0], y1[1], y1[2], y1[3]); *(unsigned*)(q + 32 + 4 * g) = pk4_fp8(y2[0], y2[1], y2[2], y2[3]); }
        return 0.f;
    }
};
__device__ __forceinline__ float rstd_kv4(const f32x4 a) { return rsqrtf(((a[0] + a[1]) + (a[2] + a[3])) * (1.0f / KVL) + EPS); }
struct Pre4 { f32x4 a; };
struct EpiK {
    static constexpr int NSTORE = 16;
    static constexpr int PRE_DEPTH = 4; static constexpr bool SUMSQ = false, COLMAJOR = false; typedef NoCtx ColCtx; typedef Pre4 RowPre; EPI_DEFAULTS_NOPRE EPI_DEFAULTS_NOPART EPI_NOBIAS
    bf16_t* KN; const float* PSQKV;
    __device__ __forceinline__ Pre4 row_pre(const Unit&, int row) const { Pre4 r; r.a = *(const f32x4*)(PSQKV + (size_t)row * 4); return r; }
    __device__ __forceinline__ float row_ctx(const Pre4& r) const { return rstd_kv4(r.a); }
    __device__ __forceinline__ NoCtx col_ctx(const Unit&, int) const { return NoCtx{}; }
    template <bool BI> __device__ __forceinline__ float apply(const Unit& u, int row, int col, float (&v)[8], float rs, NoCtx, NoPre) const {
#pragma unroll
        for (int j = 0; j < 8; ++j) v[j] *= rs;
        u32x2 w; w.x = pk4_fp8(v[0], v[1], v[2], v[3]); w.y = pk4_fp8(v[4], v[5], v[6], v[7]);
        *(u32x2*)((unsigned char*)KN + (size_t)row * D + u.pn * 256 + col) = w; return 0.f; }
};
struct EpiVT {
    static constexpr int NSTORE = 16;
    static constexpr int PRE_DEPTH = 1; static constexpr bool SUMSQ = false, COLMAJOR = true; typedef Ctx8 ColCtx; EPI_NOBIAS static constexpr bool DUAL = false;
    bf16_t* VT; const float* PSQKV;
    __device__ __forceinline__ Ctx8 col_ctx(const Unit& u, int col) const { Ctx8 c; const int t0 = u.pn * 256 + col;
#pragma unroll
        for (int j = 0; j < 8; ++j) c.s[j] = rstd_kv4(*(const f32x4*)(PSQKV + (size_t)(t0 + j) * 4));
        return c; }
    template <bool BI> __device__ __forceinline__ float apply(const Unit& u, int row, int col, float (&v)[8], float, const Ctx8& cc, NoPre) const {
#pragma unroll
        for (int j = 0; j < 8; ++j) v[j] *= cc.s[j];
        u32x2 w; w.x = pk4_fp8(v[0], v[1], v[2], v[3]); w.y = pk4_fp8(v[4], v[5], v[6], v[7]);
        *(u32x2*)((unsigned char*)VT + (size_t)row * T + u.pn * 256 + col) = w; return 0.f; }
};
struct EpiPlain {
    static constexpr int PRE_DEPTH = 1; static constexpr bool SUMSQ = false, COLMAJOR = false; typedef NoCtx ColCtx; EPI_DEFAULTS_NOROW EPI_DEFAULTS_NOPRE EPI_DEFAULTS_NOPART EPI_NOBIAS
    bf16_t* O; int ldc;
    __device__ __forceinline__ NoCtx col_ctx(const Unit&, int) const { return NoCtx{}; }
    template <bool BI> __device__ __forceinline__ float apply(const Unit& u, int row, int col, float (&v)[8], float, NoCtx, NoPre) const {
        *(u32x4*)(O + (size_t)row * ldc + u.pn * 256 + col) = pack8(v); return 0.f; }
};
struct PreG { u32x2 g; };
struct EpiMergeDual {
    static constexpr int NSTORE = 16;
    static constexpr int PRE_DEPTH = 3; static constexpr bool SUMSQ = false, COLMAJOR = false, DUAL = true; typedef NoCtx ColCtx; typedef PreG Pre; EPI_DEFAULTS_NOROW EPI_NOBIAS
    __device__ __forceinline__ bool want_partial(const Unit&) const { return false; } __device__ __forceinline__ void partial(const Unit&, int, int, float) const {}
    bf16_t* MG; const unsigned char* GATES;
    __device__ __forceinline__ NoCtx col_ctx(const Unit&, int) const { return NoCtx{}; }
    __device__ __forceinline__ void load_gates(const Unit& u, int row, int col0, u32x4& ga, u32x4& gb) const { const unsigned char* p = GATES + (size_t)row * 2048 + u.pn * 256 + 2 * col0; ga = *(const u32x4*)p; gb = *(const u32x4*)(p + 1024); }
    __device__ __forceinline__ PreG pre(const Unit& u, int row, int col) const { PreG p; p.g = *(const u32x2*)(GATES + (size_t)row * 2048 + 1024 + u.pn * 256 + 2 * (col & 127) + 8 * (col >> 7)); return p; }
    template <bool BI> __device__ __forceinline__ float apply(const Unit& u, int row, int col, float (&v)[8], float, NoCtx, const PreG& pr) const {
        float g[8]; ub4(pr.g.x, g); ub4(pr.g.y, g + 4);
#pragma unroll
        for (int j = 0; j < 8; ++j) v[j] *= g[j] * (1.0f / 255.0f);
        *(u32x4*)(MG + (size_t)row * D + u.pn * 256 + col) = pack8(v); return 0.f; }
};
struct PreX { f32x4 a, b; };
struct EpiOut {
    static constexpr int NSTORE = 16;
    static constexpr int PRE_DEPTH = 3; static constexpr bool SUMSQ = true, COLMAJOR = false, LDSBIAS = true, BIASINIT = false, DUAL = false; typedef Ctx8 ColCtx; typedef PreX Pre; EPI_DEFAULTS_NOROW
    __device__ __forceinline__ bool want_partial(const Unit&) const { return true; }
    __device__ __forceinline__ void partial(const Unit& u, int row, int wc, float sq) const { PSQX[(size_t)row * 16 + u.pn * 4 + wc] = sq; }
    EPI_INITVEC_PLAIN
    __device__ __forceinline__ const float* bias_ptr(const Unit& u) const { return MOD + ((u.pm * 256) >> 12) * 6144 + 2 * 1024 + u.pn * 256; }
    const float* X; bf16_t* X1; const float* MOD; float* PSQX;
    __device__ __forceinline__ Ctx8 col_ctx(const Unit& u, int col) const { return load8f(MOD + ((u.pm * 256) >> 12) * 6144 + 2 * 1024 + u.pn * 256 + col); }
    __device__ __forceinline__ PreX pre(const Unit& u, int row, int col) const { const float* xr = X + (size_t)row * D + u.pn * 256 + col; PreX p; p.a = *(const f32x4*)xr; p.b = *(const f32x4*)(xr + 4); return p; }
    template <bool BI> __device__ __forceinline__ float apply(const Unit& u, int row, int col, float (&v)[8], float, const Ctx8& g1, const PreX& x) const {
        float o[8];
#pragma unroll
        for (int j = 0; j < 4; ++j) { o[j] = x.a[j] + g1.s[j] * v[j]; o[4 + j] = x.b[j] + g1.s[4 + j] * v[4 + j]; }
        *(u32x4*)(X1 + (size_t)row * D + u.pn * 256 + col) = pack8(o);
        float sq = 0.f;
#pragma unroll
        for (int j = 0; j < 8; ++j) sq += o[j] * o[j];
        return sq; }
};
__device__ __forceinline__ constexpr int ACT_SRC(int pos) { return ((pos >> 2) & 1) * 64 + (pos >> 5) * 16 + ((pos >> 3) & 3) * 4 + (pos & 3); }
struct EpiGU {
    static constexpr int NSTORE = 8; static constexpr bool PAIRED = true;
    __device__ __forceinline__ unsigned swiglu4(const float (&v)[8]) const { float a[4];
#pragma unroll
        for (int i = 0; i < 4; ++i) { const float gt = fminf(v[i], 7.0f * GUC), up1 = __builtin_amdgcn_fmed3f(v[4 + i], -6.0f * GUCI, 8.0f * GUCI);
            a[i] = up1 * (gt * __builtin_amdgcn_rcpf(1.0f + __builtin_amdgcn_exp2f(-gt))); }
        return pk4_fp8(a[0], a[1], a[2], a[3]); }
    __device__ __forceinline__ float apply2(const Unit& u, int row, int col0, const float (&v0)[8], const float (&v1)[8], float) const {
        u32x2 w; w.x = swiglu4(v0); w.y = swiglu4(v1);
        *(u32x2*)((unsigned char*)ACT + (size_t)row * DE + u.pn * 128 + col0) = w; return 0.f; }
    static constexpr int PRE_DEPTH = 1; static constexpr bool SUMSQ = false, COLMAJOR = false, LDSBIAS = true, BIASINIT = true; typedef Ctx8 ColCtx; EPI_DEFAULTS_NOROW EPI_DEFAULTS_NOPRE EPI_DEFAULTS_NOPART
    __device__ __forceinline__ const float* bias_ptr(const Unit& u) const { return bgu + (size_t)u.e * 2048 + u.pn * 256; }
    __device__ __forceinline__ f32x4 init_vec(f32x4 lo, f32x4 hi, int n) const { return n ? (f32x4){lo[1] + 1.0f, lo[3] + 1.0f, hi[1] + 1.0f, hi[3] + 1.0f} * GUCI : (f32x4){lo[0], lo[2], hi[0], hi[2]} * GUC; }
    bf16_t* ACT; const float* bgu;
    __device__ __forceinline__ Ctx8 col_ctx(const Unit& u, int col) const { return load8f(bgu + (size_t)u.e * 2048 + u.pn * 256 + col); }
    template <bool BI> __device__ __forceinline__ float apply(const Unit& u, int row, int col, float (&v)[8], float, const Ctx8& bb, NoPre) const {
        const int p = u.pn * 256 + col; float a[4];
#pragma unroll
        for (int i = 0; i < 4; ++i) { float gt = BI ? v[i] : v[i] + bb.s[2 * i] * GUC, up1 = BI ? v[4 + i] : v[4 + i] + (bb.s[2 * i + 1] + 1.0f) * GUCI;
            gt = fminf(gt, 7.0f * GUC); up1 = __builtin_amdgcn_fmed3f(up1, -6.0f * GUCI, 8.0f * GUCI);
            a[i] = up1 * (gt * __builtin_amdgcn_rcpf(1.0f + __builtin_amdgcn_exp2f(-gt))); }
        *(unsigned*)((unsigned char*)ACT + (size_t)row * DE + (p >> 1)) = pk4_fp8(a[0], a[1], a[2], a[3]); return 0.f; }
};
struct Pre1 { float w; };
struct EpiDown {
    static constexpr int NSTORE = 8; static constexpr bool PAIRED = true;
    __device__ __forceinline__ float apply2(const Unit& u, int row, int col0, const float (&v0)[8], const float (&v1)[8], float rw) const {
        const float rs = rw * YSCALE;
        u32x4 w; w.x = pk4_fp8(v0[0] * rs, v0[1] * rs, v0[2] * rs, v0[3] * rs); w.y = pk4_fp8(v0[4] * rs, v0[5] * rs, v0[6] * rs, v0[7] * rs);
        w.z = pk4_fp8(v1[0] * rs, v1[1] * rs, v1[2] * rs, v1[3] * rs); w.w = pk4_fp8(v1[4] * rs, v1[5] * rs, v1[6] * rs, v1[7] * rs);
        *(u32x4*)((unsigned char*)Y + (size_t)row * D + u.pn * 256 + 2 * col0) = w; return 0.f; }
    static constexpr int PRE_DEPTH = 7; static constexpr bool SUMSQ = false, COLMAJOR = false, LDSBIAS = true, BIASINIT = true; typedef Ctx8 ColCtx; typedef Pre1 RowPre; EPI_DEFAULTS_NOPRE EPI_DEFAULTS_NOPART EPI_INITVEC_PLAIN
    __device__ __forceinline__ const float* bias_ptr(const Unit& u) const { return bdn + (size_t)u.e * D + u.pn * 256; }
    bf16_t* Y; const float* bdn; const float* ROWW;
    __device__ __forceinline__ Pre1 row_pre(const Unit&, int row) const { Pre1 r; r.w = ROWW[row]; return r; }
    __device__ __forceinline__ float row_ctx(const Pre1& r) const { return r.w; }
    __device__ __forceinline__ Ctx8 col_ctx(const Unit& u, int col) const { return load8f(bdn + (size_t)u.e * D + u.pn * 256 + col); }
    template <bool BI> __device__ __forceinline__ float apply(const Unit& u, int row, int col, float (&v)[8], float rw, const Ctx8& bb, NoPre) const {
        const float rs = rw * YSCALE;
#pragma unroll
        for (int j = 0; j < 8; ++j) v[j] = (BI ? v[j] : v[j] + bb.s[j]) * rs;
        u32x2 w; w.x = pk4_fp8(v[0], v[1], v[2], v[3]); w.y = pk4_fp8(v[4], v[5], v[6], v[7]);
        *(u32x2*)((unsigned char*)Y + (size_t)row * D + u.pn * 256 + col) = w; return 0.f; }
};

struct TrItem { const float* src; unsigned char* dst; const float* rs; const float* cs; int Nsrc, K, kb, pb, lb, perm; bool fp8, valid, kperm; };
__device__ __forceinline__ void tr_load(const TrItem& t, f32x4 (&R)[16], int lane) {
    if (t.kperm) {
        const float* p = t.src + (size_t)((t.kb >> 1) * 128 + ACT_SRC(16 * (lane >> 3))) * t.Nsrc + t.lb + 32 * (t.kb & 1) + 4 * (lane & 7);
#pragma unroll
        for (int it = 0; it < 16; ++it) R[it] = __builtin_nontemporal_load((const f32x4*)(p + (size_t)ACT_SRC(it) * t.Nsrc));
        return; }
    const float* p = t.src + (size_t)((t.kb >> 1) * 128 + 16 * (lane >> 3)) * t.Nsrc + t.lb + 32 * (t.kb & 1) + 4 * (lane & 7);
#pragma unroll
    for (int it = 0; it < 16; ++it) R[it] = __builtin_nontemporal_load((const f32x4*)(p + (size_t)it * t.Nsrc));
}
__device__ __forceinline__ void tr_process(const TrItem& t, const f32x4 (&R)[16], int lane) {
    const int k0 = (t.kb >> 1) * 128 + 16 * (lane >> 3), o4 = 32 * (t.kb & 1) + 4 * (lane & 7);
    f32x4 csv = (f32x4){1.f, 1.f, 1.f, 1.f}; if (t.cs) csv = *(const f32x4*)(t.cs + t.lb + o4);
    if (t.fp8) csv *= W8SCALE;
    f32x4 rs[4];
#pragma unroll
    for (int q = 0; q < 4; ++q) rs[q] = (f32x4){1.f, 1.f, 1.f, 1.f};
    if (t.rs) {
#pragma unroll
        for (int q = 0; q < 4; ++q) rs[q] = *(const f32x4*)(t.rs + k0 + 4 * q); }
#pragma unroll
    for (int e = 0; e < 4; ++e) {
        const int o = o4 + e;
        int ph;
        if (t.perm == 1) ph = 8 * ((o & 31) >> 2) + 4 * (o >> 5) + (o & 3);
        else if (t.perm == 2) ph = 8 * (o >> 3) + 4 * (o & 1) + ((o & 7) >> 1);
        else ph = o;
        float v[16];
        const float ce = csv[e] * (t.perm == 2 ? ((e & 1) ? GUCI : GUC) : 1.0f);
#pragma unroll
        for (int it = 0; it < 16; ++it) v[it] = R[it][e] * ce * rs[it >> 2][it & 3];
        const size_t off = (size_t)(t.pb * 64 + ph) * t.K + k0;
        if (t.fp8) { u32x4 w; w.x = pk4_fp8(v[0], v[1], v[2], v[3]); w.y = pk4_fp8(v[4], v[5], v[6], v[7]); w.z = pk4_fp8(v[8], v[9], v[10], v[11]); w.w = pk4_fp8(v[12], v[13], v[14], v[15]);
            *(u32x4*)(t.dst + off) = w; }
        else { u32x4 w0, w1; w0.x = pk2(v[0], v[1]); w0.y = pk2(v[2], v[3]); w0.z = pk2(v[4], v[5]); w0.w = pk2(v[6], v[7]); w1.x = pk2(v[8], v[9]); w1.y = pk2(v[10], v[11]); w1.z = pk2(v[12], v[13]); w1.w = pk2(v[14], v[15]);
            *(u32x4*)(t.dst + off * 2) = w0; *(u32x4*)(t.dst + off * 2 + 16) = w1; }
    }
}
constexpr int TR_N_IN = 16 * 65, TR_N_Q = 12 * 24, TR_N_K = 4 * 16, TR_N_V = 4 * 16, TR_N_SQ = 16 * 16, TR_N_GU = 32 * 16 * 32, TR_N_DN = 32 * 16 * 16;
constexpr int TR_NITEMS = TR_N_IN + TR_N_Q + TR_N_K + TR_N_V + 2 * TR_N_SQ + TR_N_GU + TR_N_DN;
__device__ __forceinline__ TrItem tr_decode(KArgP a, int it, int last) {
    unsigned char* ws = a->ws; TrItem t; t.rs = nullptr; t.cs = nullptr; t.perm = 0; t.fp8 = false; t.kperm = false; t.valid = it < last;
    if (!t.valid) it = 0;
    int r = it;
    if (r < TR_N_IN) { const int pb = r % 65; t.kb = r / 65; t.src = a->in[I_WIN]; t.Nsrc = IN_W; t.K = 1024;
        if (pb < 32) { t.dst = ws + WS_WIN8; t.pb = pb; t.lb = pb * 64; t.fp8 = true; }
        else if (pb < 64) { t.dst = ws + WS_WIN8; t.pb = pb; t.lb = pb * 64 + 64; t.fp8 = true; }
        else { t.dst = ws + WS_WKPE; t.pb = 0; t.lb = 2048; t.fp8 = true; }
        return t; } r -= TR_N_IN;
    if (r < TR_N_Q) { const int pb = r % 24; t.kb = r / 24; t.src = a->in[I_WQB]; t.Nsrc = NH * QKD; t.K = QL; t.dst = ws + WS_WQ; t.pb = pb; t.rs = a->in[I_GQA]; t.fp8 = true;
        if (pb < 16) t.lb = (pb >> 1) * QKD + (pb & 1) * 64; else { t.lb = (pb - 16) * QKD + NOPE; t.perm = 1; }
        return t; } r -= TR_N_Q;
    if (r < TR_N_K) { const int pb = r % 16; t.kb = r / 16; t.src = a->in[I_WKVB]; t.Nsrc = NH * 256; t.K = KVL; t.dst = ws + WS_WK; t.pb = pb; t.rs = a->in[I_GKVA]; t.lb = (pb >> 1) * 256 + (pb & 1) * 64; t.fp8 = true; return t; } r -= TR_N_K;
    if (r < TR_N_V) { const int pb = r % 16; t.kb = r / 16; t.src = a->in[I_WKVB]; t.Nsrc = NH * 256; t.K = KVL; t.dst = ws + WS_WV; t.pb = pb; t.rs = a->in[I_GKVA]; t.lb = (pb >> 1) * 256 + 128 + (pb & 1) * 64; t.fp8 = true; return t; } r -= TR_N_V;
    if (r < 2 * TR_N_SQ) { const int which = r / TR_N_SQ, q = r % TR_N_SQ; t.pb = q % 16; t.kb = q / 16; t.src = which == 0 ? a->in[I_WMO] : a->in[I_WOUT];
        t.dst = ws + (which == 0 ? WS_WMO : WS_WOUT); t.Nsrc = 1024; t.K = 1024; t.lb = t.pb * 64; return t; } r -= 2 * TR_N_SQ;
    if (r < TR_N_GU) { const int e = r / 512, q = r % 512; t.pb = q % 32; t.kb = q / 32; t.src = a->in[I_WGU] + (size_t)e * 1024 * 2048; t.Nsrc = 2048; t.K = 1024; t.dst = ws + WS_WGU + (size_t)e * 2048 * 1024; t.lb = t.pb * 64; t.perm = 2; t.fp8 = true; return t; } r -= TR_N_GU;
    { const int e = r / 256, q = r % 256; t.pb = q % 16; t.kb = q / 16; t.src = a->in[I_WDN] + (size_t)e * 1024 * 1024; t.Nsrc = 1024; t.K = 1024; t.dst = ws + WS_WDN + (size_t)e * 1024 * 1024; t.lb = t.pb * 64; t.fp8 = true; t.kperm = true; }
    return t;
}

constexpr int TR_EARLY = TR_NITEMS - TR_N_GU - TR_N_DN;
__device__ __forceinline__ void tr_range(KArgP a, LAS unsigned char* lds, int vcu, int G, int first, int last) {
    const int tid = tid_fresh(), lane = tid & 63, wave = __builtin_amdgcn_readfirstlane(tid >> 6);
    const int gw = first + vcu * 8 + wave, NGW = G * 8;
    f32x4 R0[16], R1[16];
    TrItem c0 = tr_decode(a, gw, last);
    if (c0.valid) tr_load(c0, R0, lane);
#pragma unroll 1
    for (int it = gw; it < last; it += 2 * NGW) {
        const TrItem c1 = tr_decode(a, it + NGW, last);
        if (c1.valid) tr_load(c1, R1, lane);
        tr_process(c0, R0, lane);
        c0 = tr_decode(a, it + 2 * NGW, last);
        if (c0.valid) tr_load(c0, R0, lane);
        if (c1.valid) tr_process(c1, R1, lane);
    }
}
__device__ __forceinline__ void p0_prep(KArgP a, LAS unsigned char* lds, int vcu, int G) {
    const int tid = tid_fresh(), lane = tid & 63, wave = __builtin_amdgcn_readfirstlane(tid >> 6);
    unsigned char* ws = a->ws;
    __syncthreads();
    for (int item = vcu; item < 128; item += G) {
        LAS float* cact = (LAS float*)lds;
        LAS float* part = (LAS float*)(lds + 32768);
        for (int i = tid; i < 8 * 1024; i += NTHREADS) { const float cv = a->in[I_C][i]; cact[i] = cv / (1.0f + __expf(-cv)); }
        __syncthreads();
        const bool isf = item >= 96; const float* W = isf ? a->in[I_WFMOD] : a->in[I_WMOD]; const int N = isf ? 2048 : 6144, j0 = (isf ? item - 96 : item) * 64;
        float acc[8];
#pragma unroll
        for (int b = 0; b < 8; ++b) acc[b] = 0.f;
        for (int k0 = wave * 128; k0 < wave * 128 + 128; k0 += 32) {
            float wv[32];
#pragma unroll
            for (int q = 0; q < 32; ++q) wv[q] = W[(size_t)(k0 + q) * N + j0 + lane];
#pragma unroll
            for (int q = 0; q < 32; ++q)
#pragma unroll
                for (int b = 0; b < 8; ++b) acc[b] += cact[b * 1024 + k0 + q] * wv[q]; }
#pragma unroll
        for (int b = 0; b < 8; ++b) part[(wave * 8 + b) * 64 + lane] = acc[b];
        __syncthreads();
        { const int b = tid >> 6, col = tid & 63; float s = 0.f;
#pragma unroll
            for (int w = 0; w < 8; ++w) s += part[(w * 8 + b) * 64 + col];
            if (isf) ((float*)(ws + WS_FMOD))[b * 2048 + j0 + col] = s + a->in[I_BFMOD][j0 + col];
            else ((float*)(ws + WS_MOD))[b * 6144 + j0 + col] = s + a->in[I_BMOD][j0 + col]; }
        asm volatile("s_waitcnt vmcnt(0)" ::: "memory");
        __syncthreads();
        if (item < 32 && tid == 0) { __builtin_amdgcn_fence(__ATOMIC_RELEASE, "agent"); asm volatile("s_waitcnt vmcnt(0)" ::: "memory");
            __hip_atomic_fetch_add((unsigned*)ws + MODCNT_WORD, 1u, __ATOMIC_RELAXED, __HIP_MEMORY_SCOPE_AGENT); }
    }
    { const int* pos = (const int*)a->in[I_POS]; f32x2* CS = (f32x2*)(ws + WS_CS);
        for (int idx = vcu * NTHREADS + tid; idx < T * 32; idx += G * NTHREADS) { const int t = idx >> 5, i = idx & 31;
            const double invf = exp(-(double)i * (9.210340371976184 / 32.0));
            const double ang = (double)pos[t] * invf; const double n = rint(ang * 0.15915494309189535); const float r = (float)(ang - n * 6.283185307179586);
            CS[idx] = (f32x2){__cosf(r), __sinf(r)}; } }
    { int* RT = (int*)(ws + WS_ROWTOK); for (int idx = vcu * NTHREADS + tid; idx < RT_MAX * 256; idx += G * NTHREADS) RT[idx] = 0; }
    { bf16_t* WR = (bf16_t*)(ws + WS_WR);
        for (int idx = vcu * NTHREADS + tid; idx < 1024 * 32; idx += G * NTHREADS) { const int e = idx & 31, k = idx >> 5; const float v = a->in[I_WR][idx];
            const unsigned h = pk2(v, 0.f) & 0xffffu; const float lo = v - bflo(h); WR[e * 1024 + k] = (bf16_t)h; WR[32768 + e * 1024 + k] = (bf16_t)(pk2(lo, 0.f) & 0xffffu); } }
    for (int item = vcu; item < 256; item += G) {
        const int kg8 = item >> 1, nb = (item & 1) * 512, g = kg8 >> 5, kl0 = (kg8 & 31) * 8;
        LAS float* wg8 = (LAS float*)lds;
        __syncthreads();
        for (int i = tid; i < 2048; i += NTHREADS) { const int kk = i >> 8, j = i & 255; wg8[j * 8 + kk] = a->in[I_WPG][(size_t)g * 65536 + (size_t)(kl0 + kk) * 256 + j] * a->in[I_PSCALE][g * 256 + j]; }
        __syncthreads();
        const int n = nb + tid; const float* wp = a->in[I_WPO] + (size_t)(g * 256) * 1024 + n;
        float acc[8];
#pragma unroll
        for (int i = 0; i < 8; ++i) acc[i] = 0.f;
        for (int j0 = 0; j0 < 256; j0 += 32) {
            float wv[32];
#pragma unroll
            for (int q = 0; q < 32; ++q) wv[q] = wp[(size_t)(j0 + q) * 1024];
#pragma unroll
            for (int q = 0; q < 32; ++q) { const f32x4 c0 = *(const LAS f32x4*)(wg8 + (j0 + q) * 8), c1 = *(const LAS f32x4*)(wg8 + (j0 + q) * 8 + 4);
#pragma unroll
                for (int i = 0; i < 4; ++i) { acc[i] += wv[q] * c0[i]; acc[4 + i] += wv[q] * c1[i]; } }
        }
        *(u32x4*)((bf16_t*)(ws + WS_WPO) + (size_t)n * 1024 + g * 256 + kl0) = pack8(acc);
        __syncthreads();
    }
    tr_range(a, lds, vcu, G, 0, TR_EARLY);
}

__device__ __forceinline__ void quad_transpose4(unsigned (&w)[4], int lane) {
    const bool o1 = lane & 1, o2 = lane & 2;
    { const unsigned s0 = o1 ? w[0] : w[1], s1 = o1 ? w[2] : w[3];
        const unsigned t0 = (unsigned)__builtin_amdgcn_mov_dpp((int)s0, 0xB1, 0xF, 0xF, true), t1 = (unsigned)__builtin_amdgcn_mov_dpp((int)s1, 0xB1, 0xF, 0xF, true);
        if (o1) { w[0] = t0; w[2] = t1; } else { w[1] = t0; w[3] = t1; } }
    { const unsigned s0 = o2 ? w[0] : w[2], s1 = o2 ? w[1] : w[3];
        const unsigned t0 = (unsigned)__builtin_amdgcn_mov_dpp((int)s0, 0x4E, 0xF, 0xF, true), t1 = (unsigned)__builtin_amdgcn_mov_dpp((int)s1, 0x4E, 0xF, 0xF, true);
        if (o2) { w[0] = t0; w[1] = t1; } else { w[2] = t0; w[3] = t1; } }
}
__device__ __forceinline__ void p1_hb(KArgP a, int vcu, int G) {
    const int tid = tid_fresh(), lane = tid & 63, wave = tid >> 6;
    const float* MOD = (const float*)(a->ws + WS_MOD);
    const int ng = (G == 256) ? (vcu < 128 ? 3 : 5) : 4, g0 = (G == 256) ? (vcu < 128 ? 3 * vcu : 384 + 5 * (vcu - 128)) : 4 * vcu, gstep = (G == 256) ? T / 32 : 4 * G;
    for (int gb = g0; gb < T / 32; gb += gstep) {
#pragma unroll 1
        for (int k = 0; k < ng; ++k) {
            const int rb = 32 * (gb + k), b = rb >> 12;
            f32x4 gs[4], sh[4];
#pragma unroll
            for (int j = 0; j < 4; ++j) { const int c = 4 * lane + 256 * j; const f32x4 g = *(const f32x4*)(a->in[I_GMIX] + c), sc = *(const f32x4*)(MOD + b * 6144 + 1024 + c);
                gs[j] = g * (sc + 1.0f); sh[j] = *(const f32x4*)(MOD + b * 6144 + c); }
            f32x4 v[4][4];
#pragma unroll
            for (int q = 0; q < 4; ++q) { const f32x4* xr = (const f32x4*)(a->in[I_X] + (size_t)(rb + wave * 4 + q) * D) + lane;
#pragma unroll
                for (int j = 0; j < 4; ++j) v[q][j] = __builtin_nontemporal_load(xr + 64 * j); }
#pragma unroll
            for (int q = 0; q < 4; ++q) { const int r = rb + wave * 4 + q; float s = 0.f;
#pragma unroll
                for (int j = 0; j < 4; ++j) s += (v[q][j][0] * v[q][j][0] + v[q][j][1] * v[q][j][1]) + (v[q][j][2] * v[q][j][2] + v[q][j][3] * v[q][j][3]);
                const float rstd = rsqrtf(wave_sum(s) * (1.0f / D) + EPS);
                unsigned w[4];
#pragma unroll
                for (int j = 0; j < 4; ++j) { const f32x4 h = v[q][j] * rstd * gs[j] + sh[j]; w[j] = pk4_fp8(h[0], h[1], h[2], h[3]); }
                quad_transpose4(w, lane);
                *(u32x4*)(a->ws + WS_HB8 + (size_t)r * D + 16 * (lane >> 2) + 256 * (lane & 3)) = (u32x4){w[0], w[1], w[2], w[3]}; } }
    }
}

__device__ __forceinline__ void p3_kpe(KArgP a, LAS unsigned char* lds, int vcu, int G) {
    const int tid = tid_fresh(), lane = tid & 63, wave = tid >> 6, rr = lane & 15, g = lane >> 4;
    const unsigned char* HB8 = a->ws + WS_HB8; unsigned char* KPE = a->ws + WS_KPE; const f32x2* CS = (const f32x2*)(a->ws + WS_CS);
    __syncthreads();
    { const u32x4* src = (const u32x4*)(a->ws + WS_WKPE);
        for (int ch = tid; ch < 4096; ch += NTHREADS) { const int e = ch >> 6, kc = ch & 63; *(LAS u32x4*)(lds + e * 1024 + ((kc ^ (e & 15)) << 4)) = src[ch]; } }
    __syncthreads();
    const int sclX = SCALE_ONE, sclW = SCALE_W8;
    for (int rb = vcu * 128; rb < T; rb += G * 128) {
        const int r0 = rb + wave * 16;
        const unsigned char* hr = HB8 + (size_t)(r0 + rr) * D + 32 * g;
        f32x4 acc[4];
#pragma unroll
        for (int c = 0; c < 4; ++c) acc[c] = (f32x4){0.f, 0.f, 0.f, 0.f};
        v8i32 Ah[8];
#pragma unroll
        for (int s = 0; s < 8; ++s) Ah[s] = __builtin_shufflevector(*(const v4i32*)(hr + 128 * s), *(const v4i32*)(hr + 128 * s + 16), 0, 1, 2, 3, 4, 5, 6, 7);
#pragma unroll
        for (int s = 0; s < 8; ++s) { const int kc = 8 * s + 2 * g;
#pragma unroll
            for (int c = 0; c < 4; ++c) { const LAS unsigned char* wr = lds + (16 * c + rr) * 1024;
                const v8i32 Bw = __builtin_shufflevector(*(const LAS v4i32*)(wr + ((kc ^ rr) << 4)), *(const LAS v4i32*)(wr + (((kc + 1) ^ rr) << 4)), 0, 1, 2, 3, 4, 5, 6, 7);
                asm volatile("v_mfma_scale_f32_16x16x128_f8f6f4 %0, %1, %2, %0, %3, %4 op_sel_hi:[0,0,0]" : "+v"(acc[c]) : "v"(Ah[s]), "v"(Bw), "v"(sclX), "v"(sclW)); } }
        asm volatile("s_nop 15\n\ts_nop 15" : "+v"(acc[0]), "+v"(acc[1]), "+v"(acc[2]), "+v"(acc[3]));
#pragma unroll
        for (int reg = 0; reg < 4; ++reg) { const int t = r0 + 4 * g + reg;
#pragma unroll
            for (int c = 0; c < 2; ++c) { const int f = 16 * c + rr; const f32x2 cs = CS[(size_t)t * 32 + f]; const float x1 = acc[c][reg], x2 = acc[c + 2][reg];
                unsigned char* kp8 = KPE + (size_t)t * 64; kp8[f] = (unsigned char)(pk4_fp8(x1 * cs.x - x2 * cs.y, 0.f, 0.f, 0.f) & 0xffu); kp8[32 + f] = (unsigned char)(pk4_fp8(x2 * cs.x + x1 * cs.y, 0.f, 0.f, 0.f) & 0xffu); } }
    }
    __syncthreads();
}

__device__ __forceinline__ void p3_mixed(KArgP a, int vcu, int G) {
    const int tid = tid_fresh(); const bf16_t* U = (const bf16_t*)(a->ws + WS_S1); bf16_t* MX = (bf16_t*)(a->ws + WS_S0);
    for (int rb = vcu * 128; rb < T; rb += G * 128) {
        for (int q = 0; q < 2; ++q) { const int item = tid + NTHREADS * q, cgi = item & 127, seg = item >> 7;
            const int w = 2 << (cgi >> 5), row0 = rb + seg * 16, s0 = row0 & (SEQ - 1);
            const bf16_t* up = U + (size_t)row0 * D + cgi * 8;
            u32x4 R[31];
#pragma unroll
            for (int i = 0; i < 15; ++i) { R[i] = (u32x4){0u, 0u, 0u, 0u}; if (15 - i < w && s0 - (15 - i) >= 0) R[i] = *(const u32x4*)(up - (size_t)(15 - i) * D); }
#pragma unroll
            for (int i = 0; i < 16; ++i) R[15 + i] = *(const u32x4*)(up + (size_t)i * D);
            float sum[8];
#pragma unroll
            for (int j = 0; j < 8; ++j) sum[j] = 0.f;
#pragma unroll
            for (int i = 0; i < 15; ++i) { float f[8]; unpack8(R[i], f);
#pragma unroll
                for (int j = 0; j < 8; ++j) sum[j] += f[j]; }
#pragma unroll
            for (int i = 0; i < 16; ++i) { const int s = s0 + i; float cur[8]; unpack8(R[15 + i], cur);
                const float inv = 1.0f / (float)(s + 1 < w ? s + 1 : w); float o[8];
#pragma unroll
                for (int j = 0; j < 8; ++j) { sum[j] += cur[j]; o[j] = sum[j] * inv - cur[j]; }
                *(u32x4*)(MX + (size_t)(row0 + i) * D + cgi * 8) = pack8(o);
                const u32x4 dr = w == 2 ? R[15 + i - 1] : w == 4 ? R[15 + i - 3] : w == 8 ? R[15 + i - 7] : R[i]; float fd[8]; unpack8(dr, fd);
#pragma unroll
                for (int j = 0; j < 8; ++j) sum[j] -= fd[j]; }
        }
    }
}

typedef float f32x16 __attribute__((ext_vector_type(16)));
__device__ __forceinline__ float max3f(float a, float b, float c) { float r; asm("v_max3_f32 %0, %1, %2, %3" : "=v"(r) : "v"(a), "v"(b), "v"(c)); return r; }
constexpr int CV_NLOOP = 70;
constexpr float ATT_THR = 8.0f;
__device__ __forceinline__ int kperm(int r) { return (r & ~36) | ((r & 4) << 3) | ((r & 32) >> 3); }
__device__ __forceinline__ void attn_fast(KArgP a, LAS unsigned char* lds, int vcu, int G) {
    const int tid = tid_fresh(), lane = tid & 63, wid = __builtin_amdgcn_readfirstlane(tid >> 6), i32 = lane & 31, hi = lane >> 5;
    const bool isB = wid >= 4;
    const unsigned char* Q8 = a->ws + WS_Q; const unsigned char* KN8 = a->ws + WS_KN; const unsigned char* KPE8 = a->ws + WS_KPE; const unsigned char* VT = a->ws + WS_VT; bf16_t* O = (bf16_t*)(a->ws + WS_O);
    constexpr int KBUF = 12288, KP_OFF = 8192, KPAIR = 2 * KBUF, V_BASE = 2 * KPAIR, VBUF = 8192, VPAIR = 2 * VBUF;
    const int rK = 8 * wid + (lane >> 3); const unsigned srcK = (unsigned)(kperm(rK) * 1024 + (((lane & 7) ^ ((rK >> 1) & 7)) * 16));
    const int rP = 16 * (wid & 3) + (lane >> 2); const unsigned srcP = (unsigned)(kperm(rP) * 64 + (((lane & 3) ^ ((rP >> 2) & 3)) * 16));
    const int dV = 16 * wid + (lane >> 2); const size_t srcV = (size_t)dV * T + (size_t)(((lane & 3) ^ ((dV >> 2) & 3)) * 16);
    const int xk = (i32 >> 1) & 7, xq = (i32 >> 2) & 3;
    int koff[2][2], poff[2], voff[2];
#pragma unroll
    for (int s2 = 0; s2 < 2; ++s2)
#pragma unroll
        for (int c = 0; c < 2; ++c) koff[s2][c] = i32 * 128 + (((4 * s2 + 2 * hi + c) ^ xk) << 4);
#pragma unroll
    for (int c = 0; c < 2; ++c) { poff[c] = KP_OFF + i32 * 64 + (((2 * hi + c) ^ xq) << 4); voff[c] = V_BASE + i32 * 64 + (((2 * hi + c) ^ xq) << 4); }
    const unsigned lds0 = (unsigned)(size_t)lds;
    const int sclK = SCALE_ONE, sclQ = SCALE_Q8;
    const int nun = (G == 256) ? 4 : (NB * NH * 16 + G - 1) / G;
    const int trslot = (vcu >> 2) & 3;
    const int ncl = (G == 256) ? CV_NLOOP : 0;
    constexpr int CV_BASE = 98304;
    int cst = 0, cpr = 0;
#define CV_DECODE(n_) int r_ = (n_) * G + vcu; const bool gu_ = r_ < TR_N_GU; if (!gu_) r_ -= TR_N_GU; \
        const int e_ = gu_ ? r_ >> 9 : r_ >> 8, q_ = gu_ ? r_ & 511 : r_ & 255, pb_ = gu_ ? q_ & 31 : q_ & 15, kb_ = gu_ ? q_ >> 5 : q_ >> 4
#define CV_LANE() int ln_ = lane; asm volatile("" : "+v"(ln_)); const int cvp = 8 * wid + (ln_ >> 3), cvc = ln_ & 7
#define CV_READ() do { CV_LANE(); const int cvrd = (8 * cvc) * 256 + (((cvp >> 2) ^ (2 * cvc)) << 4) + (cvp & 3) * 4; const LAS float* sp_ = (const LAS float*)(lds + CV_BASE + (cpr % 3) * 16384 + cvrd); \
        _Pragma("unroll") for (int i_ = 0; i_ < 8; ++i_) cv[i_] = sp_[i_ * 64]; cvpend = true; } while (0)
#define CV_STORE() do { CV_DECODE(cpr); CV_LANE(); \
        const int ph_ = gu_ ? (cvp & ~7) + 4 * (cvp & 1) + ((cvp & 7) >> 1) : cvp; \
        unsigned char* dp_ = ws_b + (gu_ ? WS_WGU + (size_t)e_ * 2048 * 1024 : WS_WDN + (size_t)e_ * 1024 * 1024) + (size_t)(pb_ * 64 + ph_) * 1024 + kb_ * 64 + 8 * cvc; \
        const float f_ = gu_ ? ((cvp & 1) ? W8SCALE * GUCI : W8SCALE * GUC) : W8SCALE; \
        u32x2 w_; w_.x = pk4_fp8(cv[0] * f_, cv[1] * f_, cv[2] * f_, cv[3] * f_); w_.y = pk4_fp8(cv[4] * f_, cv[5] * f_, cv[6] * f_, cv[7] * f_); \
        *(u32x2*)dp_ = w_; ++cpr; cvpend = false; } while (0)
    const float* const wgu_s = a->in[I_WGU]; const float* const wdn_s = a->in[I_WDN]; unsigned char* const ws_b = a->ws;
    float cv[8]; bool cvpend = false;
#pragma unroll
    for (int i_ = 0; i_ < 8; ++i_) cv[i_] = 0.f;
    for (int ui = 0; ui < nun; ++ui) {
        if (ui == trslot && ui < 3) tr_range(a, lds, vcu, G, TR_EARLY + G * ncl, TR_NITEMS);
        int bh, qb;
        if (G == 256) { const int s4 = vcu & 3; bh = vcu >> 2; qb = ui == 0 ? 15 - s4 : ui == 1 ? 11 - s4 : ui == 2 ? s4 : 4 + s4; }
        else { const int it = vcu + ui * G; if (it >= NB * NH * 16) break; bh = it >> 4; qb = 15 - (it & 15); }
        const int b = bh >> 3, h = bh & 7, t0 = b * SEQ + qb * 256, NT = 4 * qb + 4, myjmax = 4 * qb + (wid >> 1);
        const unsigned char* gK = KN8 + (size_t)b * SEQ * 1024 + h * 128 + srcK; const unsigned char* gP = KPE8 + (size_t)b * SEQ * 64 + srcP; const unsigned char* gV = VT + (size_t)(h * 128) * T + (size_t)b * SEQ + srcV;
#define ATT_GLDS(gp, ldsoff) do { unsigned keep_; const unsigned dst_ = (unsigned)__builtin_amdgcn_readfirstlane((int)(lds0 + (unsigned)(ldsoff))); \
        asm volatile("s_mov_b32 %0, m0\n\ts_mov_b32 m0, %2\n\ts_nop 0\n\tglobal_load_lds_dwordx4 %1, off\n\ts_mov_b32 m0, %0" : "=&s"(keep_) : "v"(gp), "s"(dst_) : "memory"); } while (0)
#define ATT_STAGE(jp_, ko, vo) do { const size_t j0_ = (size_t)(2 * (jp_)); \
        ATT_GLDS(gK + j0_ * 65536, (ko) + wid * 1024); ATT_GLDS(gK + (j0_ + 1) * 65536, (ko) + KBUF + wid * 1024); \
        ATT_GLDS(gP + (j0_ + (wid >> 2)) * 4096, (ko) + (wid >> 2) * KBUF + KP_OFF + (wid & 3) * 1024); \
        ATT_GLDS(gV + j0_ * 64, V_BASE + (vo) + wid * 1024); ATT_GLDS(gV + (j0_ + 1) * 64, V_BASE + (vo) + VBUF + wid * 1024); } while (0)
#define ATT_LD2(p0_, p1_) __builtin_shufflevector(*(const LAS v4i32*)(p0_), *(const LAS v4i32*)(p1_), 0, 1, 2, 3, 4, 5, 6, 7)
#define ATT_PV(vo) do { const LAS unsigned char* vb_ = lds + (vo); \
        _Pragma("unroll") for (int d = 0; d < 4; ++d) { const v8i32 va_ = ATT_LD2(vb_ + voff[0] + d * 2048, vb_ + voff[1] + d * 2048); \
            asm volatile("s_nop 1\n\tv_mfma_scale_f32_32x32x64_f8f6f4 %0, %1, %2, %0, %3, %3 op_sel_hi:[0,0,0]" : "+v"(o[d]) : "v"(va_), "v"(pq), "v"(sclK)); } } while (0)
        ATT_STAGE(0, 0, 0);
        v8i32 qf[3];
        { const unsigned char* qp = Q8 + (size_t)(t0 + 32 * wid + i32) * (NH * QKD) + h * QKD + 32 * hi;
#pragma unroll
            for (int s2 = 0; s2 < 3; ++s2) qf[s2] = __builtin_shufflevector(*(const v4i32*)(qp + 64 * s2), *(const v4i32*)(qp + 64 * s2 + 16), 0, 1, 2, 3, 4, 5, 6, 7); }
        { const int qtouch = qf[0][0] ^ qf[0][4] ^ qf[1][0] ^ qf[1][4] ^ qf[2][0] ^ qf[2][4]; asm volatile("" :: "v"(qtouch)); }
        f32x16 o[4];
#pragma unroll
        for (int d = 0; d < 4; ++d)
#pragma unroll
            for (int r = 0; r < 16; ++r) o[d][r] = 0.f;
        v8i32 pq = (v8i32){0, 0, 0, 0, 0, 0, 0, 0};
        f32x16 negm;
#pragma unroll
        for (int r = 0; r < 16; ++r) negm[r] = 0.f;
        float m = 0.f, l = 0.f;
        int vprev = 0, vcur = 0, vnext = VPAIR;
        asm volatile("s_waitcnt vmcnt(0)" ::: "memory");
        __syncthreads();
        const int NP = NT >> 1;
        for (int jp = 0; jp <= NP; ++jp) {
            const int kop = (jp & 1) * KPAIR;
            if (jp + 1 < NP) ATT_STAGE(jp + 1, KPAIR - kop, vnext);
            if (cpr + 1 < cst) CV_READ();
            const bool cvnow = cst < ncl;
            if (cvnow) { CV_DECODE(cst); const int ns_ = gu_ ? 2048 : 1024;
                const float* gp_ = (gu_ ? wgu_s + (size_t)e_ * 1024 * 2048 : wdn_s + (size_t)e_ * 1024 * 1024) + (size_t)(gu_ ? kb_ * 64 + 8 * wid + (lane >> 4) : (kb_ >> 1) * 128 + ACT_SRC((kb_ & 1) * 64 + 8 * wid + (lane >> 4))) * ns_ + pb_ * 64 + 4 * ((lane & 15) ^ (2 * wid));
                const int so_ = CV_BASE + (cst % 3) * 16384 + wid * 2048;
                ATT_GLDS(gp_, so_); ATT_GLDS(gp_ + (gu_ ? 4 : 64) * ns_, so_ + 1024); ++cst; }
#pragma unroll
            for (int sub = 0; sub < 2; ++sub) {
                const int j = 2 * jp + sub, ko = kop + sub * KBUF;
                if (isB && j >= 1 && j - 1 <= myjmax && j - 1 < NT) ATT_PV(sub == 0 ? vprev + VBUF : vcur);
                if (j < NT && j <= myjmax) {
                    const LAS unsigned char* kb = lds + ko;
                    f32x16 p0, p1;
                    {   const v8i32 k00 = ATT_LD2(kb + koff[0][0], kb + koff[0][1]), k01 = ATT_LD2(kb + koff[0][0] + 4096, kb + koff[0][1] + 4096);
                        const v8i32 k10 = ATT_LD2(kb + koff[1][0], kb + koff[1][1]), k11 = ATT_LD2(kb + koff[1][0] + 4096, kb + koff[1][1] + 4096);
                        const v8i32 k20 = ATT_LD2(kb + poff[0], kb + poff[1]), k21 = ATT_LD2(kb + poff[0] + 2048, kb + poff[1] + 2048);
                        asm volatile("v_mfma_scale_f32_32x32x64_f8f6f4 %0, %1, %2, %3, %4, %5 op_sel_hi:[0,0,0]" : "=&v"(p0) : "v"(k00), "v"(qf[0]), "v"(negm), "v"(sclK), "v"(sclQ));
                        asm volatile("v_mfma_scale_f32_32x32x64_f8f6f4 %0, %1, %2, %3, %4, %5 op_sel_hi:[0,0,0]" : "=&v"(p1) : "v"(k01), "v"(qf[0]), "v"(negm), "v"(sclK), "v"(sclQ));
                        asm volatile("v_mfma_scale_f32_32x32x64_f8f6f4 %0, %1, %2, %0, %3, %4 op_sel_hi:[0,0,0]" : "+v"(p0) : "v"(k10), "v"(qf[1]), "v"(sclK), "v"(sclQ));
                        asm volatile("v_mfma_scale_f32_32x32x64_f8f6f4 %0, %1, %2, %0, %3, %4 op_sel_hi:[0,0,0]" : "+v"(p1) : "v"(k11), "v"(qf[1]), "v"(sclK), "v"(sclQ));
                        asm volatile("v_mfma_scale_f32_32x32x64_f8f6f4 %0, %1, %2, %0, %3, %4 op_sel_hi:[0,0,0]" : "+v"(p0) : "v"(k20), "v"(qf[2]), "v"(sclK), "v"(sclQ));
                        asm volatile("v_mfma_scale_f32_32x32x64_f8f6f4 %0, %1, %2, %0, %3, %4 op_sel_hi:[0,0,0]" : "+v"(p1) : "v"(k21), "v"(qf[2]), "v"(sclK), "v"(sclQ));
                    }
                    if (cvpend) CV_STORE();
                    asm volatile("s_nop 15\n\ts_nop 15" : "+v"(p0), "+v"(p1));
                    float mx;
                    { float ma = max3f(p0[0], p0[1], p1[0]), mb = max3f(p0[2], p0[3], p1[1]); ma = max3f(ma, p1[2], p1[3]);
    #pragma unroll
                        for (int r = 4; r < 16; r += 4) { ma = max3f(ma, p0[r], p0[r + 1]); mb = max3f(mb, p0[r + 2], p0[r + 3]); ma = max3f(ma, p1[r], p1[r + 1]); mb = max3f(mb, p1[r + 2], p1[r + 3]); }
                        mx = max3f(ma, mb, mb); }
                    mx = max3f(mx, __shfl_xor(mx, 32), mx);
                    if (j == 0) {
                        m = mx;
    #pragma unroll
                        for (int r = 0; r < 16; ++r) { p0[r] -= mx; p1[r] -= mx; negm[r] = -mx; }
                    } else if (__any(mx > ATT_THR)) {
                        const float dl = max3f(mx, 0.f, 0.f), alpha = __builtin_amdgcn_exp2f(-dl); m += dl; l *= alpha;
    #pragma unroll
                        for (int r = 0; r < 16; ++r) { p0[r] -= dl; p1[r] -= dl; negm[r] = -m; }
    #pragma unroll
                        for (int d = 0; d < 4; ++d)
    #pragma unroll
                            for (int r = 0; r < 16; ++r) o[d][r] *= alpha;
                    }
                    float ls = 0.f;
    #pragma unroll
                    for (int r = 0; r < 16; ++r) { p0[r] = __builtin_amdgcn_exp2f(p0[r]); p1[r] = __builtin_amdgcn_exp2f(p1[r]); ls += p0[r] + p1[r]; }
                    l += ls;
    #pragma unroll
                    for (int g4 = 0; g4 < 4; ++g4) {
                        pq[2 * g4] = (int)pk4_fp8(p0[4 * g4], p0[4 * g4 + 1], p0[4 * g4 + 2], p0[4 * g4 + 3]);
                        pq[2 * g4 + 1] = (int)pk4_fp8(p1[4 * g4], p1[4 * g4 + 1], p1[4 * g4 + 2], p1[4 * g4 + 3]); }
                    if (!isB) ATT_PV(vcur + sub * VBUF);
                }
            }
            if (cvpend) CV_STORE();
            vprev = vcur; vcur = vnext; vnext = (vnext == 2 * VPAIR) ? 0 : vnext + VPAIR;
            if (cvnow) asm volatile("s_waitcnt vmcnt(2)" ::: "memory");
            else asm volatile("s_waitcnt vmcnt(0)" ::: "memory");
            __syncthreads();
        }
#undef ATT_STAGE
#undef ATT_PV
#undef ATT_LD2
        l += __shfl_xor(l, 32);
        const float il = __builtin_amdgcn_rcpf(l);
        bf16_t* op = O + (size_t)(t0 + 32 * wid + i32) * D + h * 128 + 8 * hi;
#pragma unroll
        for (int d = 0; d < 4; ++d) {
            u32x2 wv[4];
#pragma unroll
            for (int g4 = 0; g4 < 4; ++g4) { wv[g4].x = pk2(o[d][4 * g4] * il, o[d][4 * g4 + 1] * il); wv[g4].y = pk2(o[d][4 * g4 + 2] * il, o[d][4 * g4 + 3] * il); }
#pragma unroll
            for (int k = 0; k < 4; k += 2) {
                const auto r0 = __builtin_amdgcn_permlane32_swap(wv[k].x, wv[k + 1].x, false, false), r1 = __builtin_amdgcn_permlane32_swap(wv[k].y, wv[k + 1].y, false, false);
                *(u32x4*)(op + 32 * d + 8 * k) = (u32x4){(unsigned)r0[0], (unsigned)r1[0], (unsigned)r0[1], (unsigned)r1[1]}; } }
    }
    asm volatile("s_waitcnt vmcnt(0)" ::: "memory");
    __syncthreads();
    while (cpr < cst) { CV_READ(); CV_STORE(); }
#undef CV_READ
#undef CV_LANE
#undef CV_STORE
#undef CV_DECODE
#undef ATT_GLDS
    if (trslot >= 3 || trslot >= nun) tr_range(a, lds, vcu, G, TR_EARLY + G * ncl, TR_NITEMS);
    __syncthreads();
}

__device__ __forceinline__ void p7_router(KArgP a, LAS unsigned char* lds, int vcu, int G) {
    const int tid = tid_fresh(), lane = tid & 63, wave = tid >> 6, rr = lane & 15, g = lane >> 4;
    const float* MOD = (const float*)(a->ws + WS_MOD); const bf16_t* X1 = (const bf16_t*)(a->ws + WS_X1B); bf16_t* H2 = (bf16_t*)(a->ws + WS_S0);
    int* TKI = (int*)(a->ws + WS_TKI); float* TKW = (float*)(a->ws + WS_TKW); int* RANK = (int*)(a->ws + WS_RANK); int* COUNTS = (int*)(a->ws + WS_COUNTS);
    LAS int* cnt = (LAS int*)(lds + 131072);
    __syncthreads();
    { const u32x4* src = (const u32x4*)(a->ws + WS_WR);
        for (int ch = tid; ch < 8192; ch += NTHREADS) { const int hl = ch >> 12, e = (ch >> 7) & 31, kc = ch & 127;
            *(LAS u32x4*)(lds + hl * 65536 + e * 2048 + ((kc ^ (e & 15)) << 4)) = src[ch]; } }
    for (int rb = vcu * 128; rb < T; rb += G * 128) {
        if (tid < 32) cnt[tid] = 0;
        __syncthreads();
        const int r0 = rb + wave * 16, b = rb >> 12, row = r0 + rr;
        const bf16_t* xr = X1 + (size_t)row * D + 16 * g;
        float ss;
        { const f32x4* pq = (const f32x4*)((const float*)(a->ws + WS_PSQX) + (size_t)row * 16); const f32x4 q0 = pq[0], q1 = pq[1], q2 = pq[2], q3 = pq[3];
            ss = (((q0[0] + q0[1]) + (q0[2] + q0[3])) + ((q1[0] + q1[1]) + (q1[2] + q1[3]))) + (((q2[0] + q2[1]) + (q2[2] + q2[3])) + ((q3[0] + q3[1]) + (q3[2] + q3[3]))); }
        const float rstd = rsqrtf(ss * (1.0f / D) + EPS);
        f32x4 acc0 = (f32x4){0.f, 0.f, 0.f, 0.f}, acc1 = acc0;
        LAS float* mgs = (LAS float*)(lds + 131072 + 1024); LAS float* msh = mgs + 1024;
        for (int i = tid; i < 1024; i += NTHREADS) { mgs[i] = a->in[I_GFFN][i] * (MOD[b * 6144 + 4 * 1024 + i] + 1.0f); msh[i] = MOD[b * 6144 + 3 * 1024 + i]; }
        __syncthreads();
#pragma unroll 1
        for (int sh_ = 0; sh_ < 2; ++sh_) {
        u32x4 xv[16]; u32x4 h2w = (u32x4){0u, 0u, 0u, 0u};
#pragma unroll
        for (int q = 0; q < 16; ++q) xv[q] = *(const u32x4*)(xr + 64 * (8 * sh_ + (q >> 1)) + 8 * (q & 1));
#pragma unroll
        for (int q = 0; q < 16; ++q) { const int s = 16 * sh_ + q;
            float xf[8]; unpack8(xv[q], xf); const f32x4 x0 = (f32x4){xf[0], xf[1], xf[2], xf[3]}, x1 = (f32x4){xf[4], xf[5], xf[6], xf[7]};
            const int c0_ = 64 * (s >> 1) + 16 * g + 8 * (s & 1);
            const LAS float* gp = mgs + c0_; const LAS float* sp = msh + c0_;
            const f32x4 h0 = x0 * rstd * *(const LAS f32x4*)gp + *(const LAS f32x4*)sp, h1 = x1 * rstd * *(const LAS f32x4*)(gp + 4) + *(const LAS f32x4*)(sp + 4);
            u32x4 hi; hi.x = pk2(h0[0], h0[1]); hi.y = pk2(h0[2], h0[3]); hi.z = pk2(h1[0], h1[1]); hi.w = pk2(h1[2], h1[3]);
            { const unsigned qa = pk4_fp8(h0[0], h0[1], h0[2], h0[3]), qb = pk4_fp8(h1[0], h1[1], h1[2], h1[3]);
                if (q & 1) { h2w.z = qa; h2w.w = qb; *(u32x4*)((unsigned char*)H2 + (size_t)row * D + 64 * (s >> 1) + 16 * g) = h2w; } else { h2w.x = qa; h2w.y = qb; } }
            float hf[8]; unpack8(hi, hf);
            u32x4 lo; lo.x = pk2(h0[0] - hf[0], h0[1] - hf[1]); lo.y = pk2(h0[2] - hf[2], h0[3] - hf[3]); lo.z = pk2(h1[0] - hf[4], h1[1] - hf[5]); lo.w = pk2(h1[2] - hf[6], h1[3] - hf[7]);
            const bf16x8 Ah = __builtin_bit_cast(bf16x8, hi), Al = __builtin_bit_cast(bf16x8, lo);
            const int kc = 8 * (s >> 1) + 2 * g + (s & 1);
            const bf16x8 Bh0 = *(const LAS bf16x8*)(lds + rr * 2048 + ((kc ^ rr) << 4)), Bh1 = *(const LAS bf16x8*)(lds + (16 + rr) * 2048 + ((kc ^ rr) << 4));
            const bf16x8 Bl0 = *(const LAS bf16x8*)(lds + 65536 + rr * 2048 + ((kc ^ rr) << 4)), Bl1 = *(const LAS bf16x8*)(lds + 65536 + (16 + rr) * 2048 + ((kc ^ rr) << 4));
            acc0 = __builtin_amdgcn_mfma_f32_16x16x32_bf16(Ah, Bh0, acc0, 0, 0, 0); acc0 = __builtin_amdgcn_mfma_f32_16x16x32_bf16(Al, Bh0, acc0, 0, 0, 0); acc0 = __builtin_amdgcn_mfma_f32_16x16x32_bf16(Ah, Bl0, acc0, 0, 0, 0);
            acc1 = __builtin_amdgcn_mfma_f32_16x16x32_bf16(Ah, Bh1, acc1, 0, 0, 0); acc1 = __builtin_amdgcn_mfma_f32_16x16x32_bf16(Al, Bh1, acc1, 0, 0, 0); acc1 = __builtin_amdgcn_mfma_f32_16x16x32_bf16(Ah, Bl1, acc1, 0, 0, 0);
        }
        }
        const float br0 = a->in[I_BR][rr], br1 = a->in[I_BR][16 + rr];
#pragma unroll
        for (int reg = 0; reg < 4; ++reg) {
            float v0 = acc0[reg] + br0, v1 = acc1[reg] + br1; float tv[4]; int ti[4];
#pragma unroll
            for (int k = 0; k < 4; ++k) {
                float bv = v0; int bi = rr; if (v1 > bv) { bv = v1; bi = 16 + rr; }
#pragma unroll
                for (int o = 1; o < 16; o <<= 1) { const float ov = __shfl_xor(bv, o); const int oi = __shfl_xor(bi, o); if (ov > bv || (ov == bv && oi < bi)) { bv = ov; bi = oi; } }
                tv[k] = bv; ti[k] = bi; if (bi == rr) v0 = -INFINITY; if (bi == 16 + rr) v1 = -INFINITY;
            }
            if (rr == 0) { const int t = r0 + 4 * g + reg;
                const float e1 = __expf(tv[1] - tv[0]), e2 = __expf(tv[2] - tv[0]), e3 = __expf(tv[3] - tv[0]), inv = 1.0f / (1.0f + e1 + e2 + e3);
                *(f32x4*)(TKW + (size_t)t * 4) = (f32x4){inv, e1 * inv, e2 * inv, e3 * inv};
                int rk[4];
#pragma unroll
                for (int k = 0; k < 4; ++k) rk[k] = __hip_atomic_fetch_add(cnt + ti[k], 1, __ATOMIC_RELAXED, __HIP_MEMORY_SCOPE_WORKGROUP);
                *(u32x4*)(TKI + (size_t)t * 4) = (u32x4){(unsigned)ti[0], (unsigned)ti[1], (unsigned)ti[2], (unsigned)ti[3]};
                *(u32x4*)(RANK + (size_t)t * 4) = (u32x4){(unsigned)rk[0], (unsigned)rk[1], (unsigned)rk[2], (unsigned)rk[3]}; }
        }
        __syncthreads();
        if (tid < 32) COUNTS[(rb >> 7) * 32 + tid] = cnt[tid];
        __syncthreads();
    }
}

__device__ __forceinline__ void p8_scatter(KArgP a, LAS unsigned char* lds, int vcu, int G) {
    const int tid = tid_fresh(), lane = tid & 63, wave = tid >> 6;
    const int* COUNTS = (const int*)(a->ws + WS_COUNTS); const int* TKI = (const int*)(a->ws + WS_TKI); const float* TKW = (const float*)(a->ws + WS_TKW); const int* RANK = (const int*)(a->ws + WS_RANK);
    int* SLOTROW = (int*)(a->ws + WS_SLOTROW); float* ROWW = (float*)(a->ws + WS_ROWW); int* TILEE = (int*)(a->ws + WS_TILEE);
    int* ROWTOK = (int*)(a->ws + WS_ROWTOK);
    LAS int* ptot = (LAS int*)lds;
    LAS int* pbef = ptot + 512;
    LAS int* base = pbef + 512;
    for (int rb = vcu * 128; rb < T; rb += G * 128) {
        const int blk = rb >> 7;
        __syncthreads();
        { const int e = tid & 31, pt = tid >> 5; int st = 0, sb = 0;
            for (int bb = pt * 16; bb < pt * 16 + 16; ++bb) { const int cv = COUNTS[bb * 32 + e]; st += cv; if (bb < blk) sb += cv; }
            ptot[pt * 32 + e] = st; pbef[pt * 32 + e] = sb; }
        __syncthreads();
        if (tid < 64) {
            const int e = tid & 31; int tot = 0, bef = 0;
#pragma unroll
            for (int pt = 0; pt < 16; ++pt) { tot += ptot[pt * 32 + e]; bef += pbef[pt * 32 + e]; }
            const int ntl = (tot + 255) >> 8; int inc = ntl << 8;
#pragma unroll
            for (int d = 1; d < 32; d <<= 1) { const int o = __shfl_up(inc, d, 32); if (e >= d) inc += o; }
            const int ps = inc - (ntl << 8);
            if (tid < 32) { base[e] = ps + bef;
                if (blk == 0) { for (int q = 0; q < ntl; ++q) TILEE[(ps >> 8) + q] = e;
                    if (e == 31) TILEE[1023] = inc >> 8; } } }
        __syncthreads();
        { const int t = rb + (tid >> 2), k = tid & 3;
            const int e = TKI[(size_t)t * 4 + k], dest = base[e] + RANK[(size_t)t * 4 + k];
            SLOTROW[(size_t)t * 4 + k] = dest; ROWW[dest] = TKW[(size_t)t * 4 + k]; ROWTOK[dest] = t; }
    }
    __syncthreads();
}

__device__ __forceinline__ void p11_final(KArgP a, int vcu, int G) {
    const int tid = tid_fresh(), lane = tid & 63, wave = tid >> 6;
    const float* MOD = (const float*)(a->ws + WS_MOD); const float* FMOD = (const float*)(a->ws + WS_FMOD); const int* SLOTROW = (const int*)(a->ws + WS_SLOTROW);
    const unsigned char* Y = (const unsigned char*)(a->ws + WS_XS); float* OUT = a->out; const bf16_t* X1 = (const bf16_t*)(a->ws + WS_X1B);
    const int cA = 256 * (lane >> 4) + 32 * ((lane >> 2) & 3) + 8 * (lane & 3);
    for (int rb = vcu * 128; rb < T; rb += G * 128) {
        const int b = rb >> 12;
        f32x4 g2[4], gs[4], sh[4];
#pragma unroll
        for (int g = 0; g < 4; ++g) { const int c = cA + 128 * (g >> 1) + 4 * (g & 1); g2[g] = *(const f32x4*)(MOD + b * 6144 + 5 * 1024 + c) * (1.0f / YSCALE);
            gs[g] = *(const f32x4*)(a->in[I_GFIN] + c) * (*(const f32x4*)(FMOD + b * 2048 + 1024 + c) + 1.0f); sh[g] = *(const f32x4*)(FMOD + b * 2048 + c); }
        u32x4 srl = (u32x4){0u, 0u, 0u, 0u};
        if (lane < 16) srl = *(const u32x4*)(SLOTROW + (size_t)(rb + wave * 16 + lane) * 4);
#pragma unroll 1
        for (int i0 = 0; i0 < 16; i0 += 2) {
            u32x4 yw[2][4], xw[2][2];
#pragma unroll
            for (int q = 0; q < 2; ++q) { const int t = rb + wave * 16 + i0 + q;
#pragma unroll
                for (int k = 0; k < 4; ++k) { const unsigned sr = (unsigned)__builtin_amdgcn_readlane((int)srl[k], i0 + q); yw[q][k] = *(const u32x4*)(Y + (size_t)sr * D + 16 * lane); }
                xw[q][0] = *(const u32x4*)(X1 + (size_t)t * D + cA); xw[q][1] = *(const u32x4*)(X1 + (size_t)t * D + cA + 128); }
#pragma unroll
            for (int q = 0; q < 2; ++q) { const int t = rb + wave * 16 + i0 + q; float* orow = OUT + (size_t)t * D + cA; f32x4 v[4]; float s = 0.f;
#pragma unroll
                for (int g = 0; g < 4; ++g) { f32x4 mo = (f32x4){0.f, 0.f, 0.f, 0.f};
#pragma unroll
                    for (int k = 0; k < 4; ++k) { const int w = (int)yw[q][k][g]; const f32x2 lo = __builtin_amdgcn_cvt_pk_f32_fp8(w, false), hi2 = __builtin_amdgcn_cvt_pk_f32_fp8(w, true);
                        mo[0] += lo.x; mo[1] += lo.y; mo[2] += hi2.x; mo[3] += hi2.y; }
                    const unsigned xa = xw[q][g >> 1][2 * (g & 1)], xb = xw[q][g >> 1][2 * (g & 1) + 1];
                    v[g] = (f32x4){bflo(xa), bfhi(xa), bflo(xb), bfhi(xb)} + g2[g] * mo; s += (v[g][0] * v[g][0] + v[g][1] * v[g][1]) + (v[g][2] * v[g][2] + v[g][3] * v[g][3]); }
                const float rstd = rsqrtf(wave_sum(s) * (1.0f / D) + EPS);
#pragma unroll
                for (int g = 0; g < 4; ++g) __builtin_nontemporal_store(v[g] * rstd * gs[g] + sh[g], (f32x4*)(orow + 128 * (g >> 1) + 4 * (g & 1))); } }
    }
}

#define RLX_AGENT __ATOMIC_RELAXED, __HIP_MEMORY_SCOPE_AGENT
#define XB_TMO      128
#define XB_XCNT(j)  (256  + 64 * (j))
#define XB_XSUB(j)  (1280 + 64 * (j))
#define XB_XGEN(j)  (2304 + 64 * (j))
#define XB_TOP      3328
#define XB_TOPGEN   3392
#define XCD_BAR_WORDS 3456
#define XB_SPIN_CAP (1u << 18)
__device__ __forceinline__ unsigned xb_ld(unsigned* p)              { return __hip_atomic_load(p, __ATOMIC_RELAXED, __HIP_MEMORY_SCOPE_AGENT); }
__device__ __forceinline__ unsigned xb_add(unsigned* p, unsigned v) { return __hip_atomic_fetch_add(p, v, __ATOMIC_RELAXED, __HIP_MEMORY_SCOPE_AGENT); }
__device__ __forceinline__ unsigned xb_xcc_id() { return (unsigned)__builtin_amdgcn_s_getreg((3 << 11) | 20) & 0xFu; }
#define XB_SPIN(cond, bar) do { unsigned _sp = 0; while (cond) { __builtin_amdgcn_s_sleep(1); \
    if ((++_sp & 255u) == 0u) { if (xb_ld(&(bar)[XB_TMO])) break; if (_sp > XB_SPIN_CAP) { atomicAdd(&(bar)[XB_TMO], 1u); break; } } } } while (0)
struct XcdBarrier { unsigned* bar; unsigned x; volatile LAS unsigned* st; };
__device__ __forceinline__ XcdBarrier xcd_barrier_post(unsigned* bar, volatile LAS unsigned* st) {
    XcdBarrier b; b.bar = bar; b.x = xb_xcc_id(); b.st = st;
    if (threadIdx.x == 0) (void)xb_add(&bar[XB_XCNT(b.x)], 1u);
    return b;
}
__device__ __forceinline__ void xcd_barrier_complete(unsigned* bar, unsigned x, unsigned& nloc, unsigned& nx) {
    const unsigned G = gridDim.x * gridDim.y * gridDim.z;
    unsigned sum, cnt, mine, sp = 0u;
    for (;;) {
        sum = 0u; cnt = 0u; mine = 0u;
#pragma unroll
        for (unsigned j = 0; j < 16; ++j) { const unsigned c = xb_ld(&bar[XB_XCNT(j)]); sum += c; cnt += (c > 0u) ? 1u : 0u; mine = (j == x) ? c : mine; }
        if (sum == G) break;
        __builtin_amdgcn_s_sleep(1);
        if ((++sp & 255u) == 0u) { if (xb_ld(&bar[XB_TMO])) break; if (sp > XB_SPIN_CAP) { atomicAdd(&bar[XB_TMO], 1u); break; } }
    }
    nloc = mine > 0u ? mine : 1u; nx = cnt > 0u ? cnt : 1u;
}
__device__ __forceinline__ void xcd_barrier(const XcdBarrier& b) {
    asm volatile("s_waitcnt vmcnt(0)" ::: "memory");
    __syncthreads();
    if (threadIdx.x == 0) {
        unsigned* bar = b.bar;
        __builtin_amdgcn_s_waitcnt(0);
        unsigned nloc = b.st[0], nx = b.st[1];
        if (nloc == 0u) { xcd_barrier_complete(bar, b.x, nloc, nx); b.st[0] = nloc; b.st[1] = nx; }
        const unsigned old = xb_add(&bar[XB_XSUB(b.x)], 1u);
        const unsigned gen = old / nloc;
        if (old + 1u == (gen + 1u) * nloc) {
            __builtin_amdgcn_fence(__ATOMIC_RELEASE, "agent");
            asm volatile("s_waitcnt vmcnt(0)" ::: "memory");
            const unsigned og = xb_add(&bar[XB_TOP], 1u);
            const unsigned tg = og / nx;
            if (og + 1u == (tg + 1u) * nx) xb_add(&bar[XB_TOPGEN], 1u);
            else XB_SPIN(xb_ld(&bar[XB_TOPGEN]) == tg, bar);
            __builtin_amdgcn_fence(__ATOMIC_ACQUIRE, "agent");
            xb_add(&bar[XB_XGEN(b.x)], 1u);
            asm volatile("s_waitcnt vmcnt(0)" ::: "memory");
        } else {
            XB_SPIN(xb_ld(&bar[XB_XGEN(b.x)]) == gen, bar);
            __builtin_amdgcn_fence(__ATOMIC_ACQUIRE, "agent");
            asm volatile("s_waitcnt vmcnt(0)" ::: "memory");
        }
    }
    __syncthreads();
}

__global__ void __launch_bounds__(NTHREADS, 2) mk_fwd(Args a_) {
    extern __shared__ __attribute__((aligned(16))) unsigned char lds_raw[];
    LAS unsigned char* lds = (LAS unsigned char*)lds_raw;
    const int G = gridDim.x, bx = blockIdx.x; const int vcu = (G % 8 == 0) ? (bx % 8) * (G / 8) + bx / 8 : bx;
    KArgP a = (KArgP)__builtin_amdgcn_kernarg_segment_ptr();
    const int lo = a->ph_lo, hi = a->ph_hi;
    volatile LAS unsigned* misc = (volatile LAS unsigned*)(lds + LDS_BYTES - 64);
    if (threadIdx.x < 16) misc[threadIdx.x] = 0u;
    __syncthreads();
    XcdBarrier xbar; xbar.bar = (unsigned*)a->ws + 1024; xbar.x = 0; xbar.st = misc;
#if ONE_LAUNCH
    xbar = xcd_barrier_post((unsigned*)a->ws + 1024, misc);
    if (lo < 0) cg::this_grid().sync();
#endif
#define PHASE_ARGS() asm volatile("" : "+s"(a)); unsigned char* ws = a->ws; (void)ws
#ifndef REPEAT_MASK
#define REPEAT_MASK 0
#endif
#define REPS(k) ((((REPEAT_MASK) >> (k)) & 1) ? 2 : 1)
#ifndef PHASE_MASK
#define PHASE_MASK 0xFFF
#endif
#define IN(k) ((((PHASE_MASK) >> (k)) & 1) && lo <= (k) && (k) < hi)
#if ONE_LAUNCH
#ifndef SYNC_REPEAT
#define SYNC_REPEAT 1
#endif
#define SEAM(k) do { if (IN(k) && IN((k) + 1)) { for (int _r = 0; _r < SYNC_REPEAT; ++_r) { xcd_barrier(xbar); } } } while (0)
#else
#define SEAM(k) do { } while (0)
#endif
    for (int _rep = 0; _rep < REPS(0); ++_rep) if (IN(0)) { PHASE_ARGS(); p0_prep(a, lds, vcu, G); }
    if (IN(1)) { PHASE_ARGS();
        if (threadIdx.x == 0) { unsigned* mc = (unsigned*)ws + MODCNT_WORD; unsigned sp_ = 0;
            while (__hip_atomic_load(mc, __ATOMIC_RELAXED, __HIP_MEMORY_SCOPE_AGENT) < 32u && ++sp_ < (1u << 22)) __builtin_amdgcn_s_sleep(2);
            __builtin_amdgcn_fence(__ATOMIC_ACQUIRE, "agent"); asm volatile("s_waitcnt vmcnt(0)" ::: "memory"); }
        __syncthreads(); }
    for (int _rep = 0; _rep < REPS(1); ++_rep) if (IN(1)) { PHASE_ARGS(); p1_hb(a, vcu, G); } SEAM(1);
    for (int _rep = 0; _rep < REPS(2); ++_rep) if (IN(2)) { PHASE_ARGS();
        EpiIn E{(bf16_t*)(ws + WS_S1), (bf16_t*)(ws + WS_QLAT), (bf16_t*)(ws + WS_KVLAT), (bf16_t*)(ws + WS_KPE), (bf16_t*)(ws + WS_GATES), (float*)(ws + WS_PSQQ), (float*)(ws + WS_PSQKV), a->in[I_BGATE], (const f32x2*)(ws + WS_CS), 0};
        { Gemm g{(const bf16_t*)(ws + WS_HB8), (const bf16_t*)(ws + WS_WIN8), D, D, D, nullptr, SCALE_ONE, SCALE_W8}; DenseSched S; S.init(T / 256, 16, G, bx, D, D, 0, 1);
            gemm_phase<EpiIn, DenseSched, false, true>(lds, g, S, E); }
    } SEAM(2);
    for (int _rep = 0; _rep < REPS(3); ++_rep) if (IN(3)) { PHASE_ARGS();
        for (int _q = 0; _q < ((P3REP & 1) ? 2 : 1); ++_q) p3_kpe(a, lds, vcu, G);
        { Gemm g{(const bf16_t*)(ws + WS_QLAT), (const bf16_t*)(ws + WS_WQ), QL, QL, QL, nullptr, SCALE_ONE, SCALE_W8}; DenseSched S; S.init(T / 256, 6, G, bx, QL, QL, 0, 1);
            EpiQ E{(bf16_t*)(ws + WS_Q), (const float*)(ws + WS_PSQQ), (const f32x2*)(ws + WS_CS)}; for (int _q = 0; _q < ((P3REP & 4) ? 2 : 1); ++_q) gemm_phase<EpiQ, DenseSched, false, true>(lds, g, S, E); }
        { Gemm g{(const bf16_t*)(ws + WS_KVLAT), (const bf16_t*)(ws + WS_WK), KVL, KVL, KVL, nullptr, SCALE_ONE, SCALE_W8}; DenseSched S; S.init(T / 256, 4, G, bx, KVL, KVL, 0, 1);
            EpiK E{(bf16_t*)(ws + WS_KN), (const float*)(ws + WS_PSQKV)}; for (int _q = 0; _q < ((P3REP & 8) ? 2 : 1); ++_q) gemm_phase<EpiK, DenseSched, false, true>(lds, g, S, E); }
        { Gemm g{(const bf16_t*)(ws + WS_WV), (const bf16_t*)(ws + WS_KVLAT), KVL, KVL, KVL, nullptr, SCALE_W8, SCALE_ONE}; DenseSched S; S.init(4, T / 256, G, bx, KVL, KVL, 0, 1);
            EpiVT E{(bf16_t*)(ws + WS_VT), (const float*)(ws + WS_PSQKV)}; for (int _q = 0; _q < ((P3REP & 16) ? 2 : 1); ++_q) gemm_phase<EpiVT, DenseSched, false, true>(lds, g, S, E); }
    } SEAM(3);
    for (int _rep = 0; _rep < REPS(4); ++_rep) if (IN(4)) { PHASE_ARGS();
#pragma unroll 1
        for (int half_ = 0; half_ < 2; ++half_) { if (half_ == (vcu & 1)) p3_mixed(a, vcu, G); if (half_ == 0) attn_fast(a, lds, vcu, G); }
    } SEAM(4);
    for (int _rep = 0; _rep < REPS(5); ++_rep) if (IN(5)) { PHASE_ARGS();
        DualSched S; S.B.init(T / 256, 4, G, bx, D, D, 0); S.a2 = (unsigned)(WS_O - WS_S0); S.b2 = (unsigned)(WS_WMO - WS_WPO);
        Gemm g{(const bf16_t*)(ws + WS_S0), (const bf16_t*)(ws + WS_WPO), D, D, D, nullptr, 0, 0}; EpiMergeDual E{(bf16_t*)(ws + WS_S1), (const unsigned char*)(ws + WS_GATES)}; gemm_phase(lds, g, S, E);
    } SEAM(5);
    for (int _rep = 0; _rep < REPS(6); ++_rep) if (IN(6)) { PHASE_ARGS();
        Gemm g{(const bf16_t*)(ws + WS_S1), (const bf16_t*)(ws + WS_WOUT), D, D, D, nullptr, 0, 0}; DenseSched S; S.init(T / 256, 4, G, bx, D, D, 0);
        EpiOut E{a->in[I_X], (bf16_t*)(ws + WS_X1B), (const float*)(ws + WS_MOD), (float*)(ws + WS_PSQX)}; gemm_phase(lds, g, S, E);
    } SEAM(6);
    for (int _rep = 0; _rep < REPS(7); ++_rep) if (IN(7)) { PHASE_ARGS(); p7_router(a, lds, vcu, G); } SEAM(7);
    for (int _rep = 0; _rep < REPS(8); ++_rep) if (IN(8)) { PHASE_ARGS(); p8_scatter(a, lds, vcu, G); } SEAM(8);
    for (int _rep = 0; _rep < REPS(9); ++_rep) if (IN(9)) { PHASE_ARGS();
        Gemm g{(const bf16_t*)(ws + WS_S0), (const bf16_t*)(ws + WS_WGU), D, D, D, (const int*)(ws + WS_ROWTOK), SCALE_ONE, SCALE_W8}; MoeSched S; S.init(moe_table_to_lds((const int*)(ws + WS_TILEE), lds), 8, G, bx, D, D, 1);
        EpiGU E{(bf16_t*)(ws + WS_ACT), a->in[I_BGU]}; gemm_phase<EpiGU, MoeSched, true, true>(lds, g, S, E, SKEW_MOE);
    } SEAM(9);
    for (int _rep = 0; _rep < REPS(10); ++_rep) if (IN(10)) { PHASE_ARGS();
        Gemm g{(const bf16_t*)(ws + WS_ACT), (const bf16_t*)(ws + WS_WDN), D, D, D, nullptr, SCALE_ONE, SCALE_W8}; MoeSched S; S.init(moe_table_to_lds((const int*)(ws + WS_TILEE), lds), 4, G, bx, D, D, 1);
        EpiDown E{(bf16_t*)(ws + WS_XS), a->in[I_BDN], (const float*)(ws + WS_ROWW)}; gemm_phase<EpiDown, MoeSched, false, true>(lds, g, S, E, SKEW_MOE);
        if (G == 256) { const int R_ = ((const LAS int*)(lds + 131072 + 1024))[1023]; if ((R_ / 64) * 64 + (bx & 7) * 8 + (bx >> 5) >= R_) { const u32x4* xp = (const u32x4*)((const bf16_t*)(ws + WS_X1B) + (size_t)vcu * 128 * D) + threadIdx.x; u32x4 acc_ = (u32x4){0u, 0u, 0u, 0u};
#pragma unroll 8
                for (int i_ = 0; i_ < 32; ++i_) { const u32x4 v_ = xp[i_ * NTHREADS]; acc_ ^= v_; }
                asm volatile("" :: "v"(acc_)); } }
    } SEAM(10);
    for (int _rep = 0; _rep < REPS(11); ++_rep) if (IN(11)) { PHASE_ARGS(); p11_final(a, vcu, G); }
#undef IN
#undef SEAM
}

constexpr int NPHASES = 12;
extern "C" void kernel_launch(void* const* d_in, const int* in_sizes, int n_in, void* d_out, int out_size, void* d_ws, size_t ws_size, hipStream_t stream) {
    static int grid = 0;
    if (grid == 0) {
        if (n_in != 27 || out_size != T * D || ws_size < WS_END) { fprintf(stderr, "kernel_launch: unexpected problem (n_in %d out %d ws %zu)\n", n_in, out_size, ws_size); grid = -1; return; }
        int dev = 0, cus = 0, per_cu = 0;
        hipGetDevice(&dev); hipDeviceGetAttribute(&cus, hipDeviceAttributeMultiprocessorCount, dev);
        hipFuncSetAttribute((const void*)mk_fwd, hipFuncAttributeMaxDynamicSharedMemorySize, LDS_BYTES);
        hipOccupancyMaxActiveBlocksPerMultiprocessor(&per_cu, (const void*)mk_fwd, NTHREADS, LDS_BYTES);
        (void)hipGetLastError();
        if (per_cu < 1) { fprintf(stderr, "kernel_launch: occupancy query says %d blocks per CU\n", per_cu); per_cu = 1; }
        grid = cus;
    }
    if (grid < 0) return;
    Args a{};
    for (int i = 0; i < 27; ++i) a.in[i] = (const float*)d_in[i];
    a.out = (float*)d_out; a.ws = (unsigned char*)d_ws;
#if ONE_LAUNCH
    if (hipMemsetAsync(d_ws, 0, 65536, stream) != hipSuccess) { fprintf(stderr, "kernel_launch: memset of the barrier words failed\n"); return; }
    a.ph_lo = 0; a.ph_hi = NPHASES;
    void* args[] = {&a};
    hipError_t e = hipLaunchCooperativeKernel((const void*)mk_fwd, dim3(grid), dim3(NTHREADS), args, LDS_BYTES, stream);
    if (e != hipSuccess) fprintf(stderr, "cooperative launch failed: %s (grid %d)\n", hipGetErrorString(e), grid);
#else
    for (int p = 0; p < NPHASES; ++p) { a.ph_lo = p; a.ph_hi = p + 1; hipLaunchKernelGGL(mk_fwd, dim3(grid), dim3(NTHREADS), LDS_BYTES, stream, a); }
#endif
}
```
